# Optimizing an MI355X kernel written in HIP

```python
import math
import jax, jax.numpy as jnp
from jax import lax
import numpy as np

D_MODEL = 1024
BATCH = 32
SEQ = 2048
DEPTH = 2

HEAD_DIM = 64
A_HEADS = 8
IDX_HEADS = 4
IDX_DIM = 64
TOPK_MAX = 256
B_HEADS = 4
B_VDIM = 2 * HEAD_DIM
D_A = A_HEADS * HEAD_DIM
D_B = B_HEADS * B_VDIM
FFN_HIDDEN = -(-8 * D_MODEL // (3 * 256)) * 256
ROPE_THETA = 10000.0
EPS = 1e-6
DENSE_Q_BLOCK = 128
SPARSE_Q_BLOCK = 32
POS_OFFSET_MAX = 4096
IN_WIDTHS = (D_A, D_A, D_A,
             IDX_HEADS * IDX_DIM, IDX_DIM, IDX_HEADS,
             B_HEADS * 2 * HEAD_DIM, B_HEADS * 2 * HEAD_DIM, D_B,
             2 * D_MODEL)
D_IN = sum(IN_WIDTHS)

kernel_name = "hybrid_dsa_diffattn_gated_swiglu"


def rms_norm(x, g):
    x32 = x.astype(jnp.float32)
    y = x32 * lax.rsqrt(jnp.mean(x32 * x32, axis=-1, keepdims=True) + EPS)
    return (y * g.astype(jnp.float32)).astype(x.dtype)


def rope_tables(positions):
    inv_freq = 1.0 / (ROPE_THETA ** (jnp.arange(0, HEAD_DIM, 2, dtype=jnp.float32) / HEAD_DIM))
    ang = positions.astype(jnp.float32)[..., None] * inv_freq
    return jnp.cos(ang)[:, :, None, :], jnp.sin(ang)[:, :, None, :]


def apply_rope(x, cos, sin):
    x32 = x.astype(jnp.float32)
    x1, x2 = jnp.split(x32, 2, axis=-1)
    out = jnp.concatenate([x1 * cos - x2 * sin, x2 * cos + x1 * sin], axis=-1)
    return out.astype(x.dtype)


def split_cols(proj):
    offs = np.cumsum(np.array(IN_WIDTHS))[:-1].tolist()
    return jnp.split(proj, offs, axis=-1)


def sparse_attention(q, k, v, q_idx, k_idx, w_idx, k_sel):
    B, S, H, dh = q.shape
    n_blk = S // SPARSE_Q_BLOCK
    key_pos = jnp.arange(S)
    k_idx32 = k_idx.astype(jnp.float32)

    def block(i):
        start = i * SPARSE_Q_BLOCK
        qb = lax.dynamic_slice_in_dim(q, start, SPARSE_Q_BLOCK, axis=1)
        qib = lax.dynamic_slice_in_dim(q_idx, start, SPARSE_Q_BLOCK, axis=1)
        wb = lax.dynamic_slice_in_dim(w_idx, start, SPARSE_Q_BLOCK, axis=1)
        q_pos = start + jnp.arange(SPARSE_Q_BLOCK)
        causal = key_pos[None, :] <= q_pos[:, None]
        dots = jnp.einsum('bqhd,bsd->bqhs', qib.astype(jnp.float32), k_idx32) * (IDX_DIM ** -0.5)
        score = jnp.einsum('bqh,bqhs->bqs', wb.astype(jnp.float32), jax.nn.relu(dots))
        score = jnp.where(causal[None], score, -jnp.inf)
        _, top_idx = lax.top_k(score, k_sel)
        valid = top_idx <= q_pos[None, :, None]
        kg = jax.vmap(lambda kb, ib: kb[ib])(k, top_idx)
        vg = jax.vmap(lambda vb, ib: vb[ib])(v, top_idx)
        logits = jnp.einsum('bqhd,bqkhd->bqhk', qb.astype(jnp.float32),
                            kg.astype(jnp.float32)) * (dh ** -0.5)
        logits = jnp.where(valid[:, :, None, :], logits, -jnp.inf)
        p = jax.nn.softmax(logits, axis=-1).astype(v.dtype)
        return jnp.einsum('bqhk,bqkhd->bqhd', p, vg)

    out = lax.map(block, jnp.arange(n_blk))
    return jnp.moveaxis(out, 0, 1).reshape(B, S, H, dh)


def diff_attention(q, k, v, lam):
    B, S, H, _, dh = q.shape
    n_blk = S // DENSE_Q_BLOCK
    key_pos = jnp.arange(S)
    k32 = k.astype(jnp.float32)

    def block(i):
        start = i * DENSE_Q_BLOCK
        qb = lax.dynamic_slice_in_dim(q, start, DENSE_Q_BLOCK, axis=1)
        q_pos = start + jnp.arange(DENSE_Q_BLOCK)
        causal = key_pos[None, :] <= q_pos[:, None]
        logits = jnp.einsum('bqhcd,bshcd->bhcqs', qb.astype(jnp.float32), k32) * (dh ** -0.5)
        logits = jnp.where(causal[None, None, None], logits, -jnp.inf)
        p = jax.nn.softmax(logits, axis=-1)
        attn = (p[:, :, 0] - lam * p[:, :, 1]).astype(v.dtype)
        return jnp.einsum('bhqs,bshe->bqhe', attn, v)

    out = lax.map(block, jnp.arange(n_blk))
    return jnp.moveaxis(out, 0, 1).reshape(B, S, H, 2 * dh)


def hybrid_layer(x, cos, sin, layer_idx, attn_norm, w_in, gate_bias, a_q_norm, a_k_norm,
                 idx_k_norm, b_q_norm, b_k_norm, diff_lambda, b_subln, w_up_a, w_up_b,
                 w_out, ffn_norm, w_ffn_in, w_ffn_out):
    B, S, _ = x.shape
    k_sel = min(TOPK_MAX, S // 4)
    h = rms_norm(x, attn_norm)
    proj = h @ w_in
    aq, ak, av, iq, ik, iw, bq, bk, bv, gates = split_cols(proj)

    aq = apply_rope(rms_norm(aq.reshape(B, S, A_HEADS, HEAD_DIM), a_q_norm), cos, sin)
    ak = apply_rope(rms_norm(ak.reshape(B, S, A_HEADS, HEAD_DIM), a_k_norm), cos, sin)
    av = av.reshape(B, S, A_HEADS, HEAD_DIM)
    iq = apply_rope(iq.reshape(B, S, IDX_HEADS, IDX_DIM), cos, sin)
    ik = apply_rope(rms_norm(ik, idx_k_norm)[:, :, None, :], cos, sin)[:, :, 0, :]
    iw = iw * (IDX_HEADS ** -0.5)
    ya = sparse_attention(aq, ak, av, iq, ik, iw, k_sel).reshape(B, S, D_A)

    bq = apply_rope(rms_norm(bq.reshape(B, S, 2 * B_HEADS, HEAD_DIM), b_q_norm), cos, sin)
    bk = apply_rope(rms_norm(bk.reshape(B, S, 2 * B_HEADS, HEAD_DIM), b_k_norm), cos, sin)
    bq = bq.reshape(B, S, B_HEADS, 2, HEAD_DIM)
    bk = bk.reshape(B, S, B_HEADS, 2, HEAD_DIM)
    bv = bv.reshape(B, S, B_HEADS, B_VDIM)
    lam_init = 0.8 - 0.6 * math.exp(-0.3 * layer_idx)
    dl = diff_lambda.astype(jnp.float32)
    lam = jnp.exp(jnp.sum(dl[0] * dl[1])) - jnp.exp(jnp.sum(dl[2] * dl[3])) + lam_init
    yb = diff_attention(bq, bk, bv, lam)
    yb = (rms_norm(yb, b_subln) * (1.0 - lam_init)).reshape(B, S, D_B)

    g = jax.nn.sigmoid((gates + gate_bias).astype(jnp.float32)).astype(x.dtype)
    g_a, g_b = jnp.split(g, 2, axis=-1)
    merged = g_a * (ya @ w_up_a) + g_b * (yb @ w_up_b)
    x = x + merged @ w_out

    h = rms_norm(x, ffn_norm)
    gate, up = jnp.split(h @ w_ffn_in, 2, axis=-1)
    return x + (jax.nn.silu(gate) * up) @ w_ffn_out


def setup_inputs(seed: int = 0) -> dict:
    key = jax.random.key(seed)
    ks = jax.random.split(key, 20)
    f32 = jnp.float32

    def dense(k, shape, fan_in):
        return jax.random.normal(k, shape, f32) * (fan_in ** -0.5)

    def gain(k, shape):
        return 1.0 + 0.02 * jax.random.normal(k, shape, f32)

    x = jax.random.normal(ks[0], (BATCH, SEQ, D_MODEL), f32)
    offset = jax.random.randint(ks[1], (BATCH, 1), 0, POS_OFFSET_MAX, dtype=jnp.int32)
    positions = (offset + jnp.arange(SEQ, dtype=jnp.int32)[None, :]).astype(jnp.int32)
    return {
        "x": x,
        "positions": positions,
        "attn_norm": gain(ks[2], (DEPTH, D_MODEL)),
        "w_in": dense(ks[3], (DEPTH, D_MODEL, D_IN), D_MODEL),
        "gate_bias": 0.1 * jax.random.normal(ks[4], (DEPTH, 2 * D_MODEL), f32),
        "a_q_norm": gain(ks[5], (DEPTH, HEAD_DIM)),
        "a_k_norm": gain(ks[6], (DEPTH, HEAD_DIM)),
        "idx_k_norm": gain(ks[7], (DEPTH, IDX_DIM)),
        "b_q_norm": gain(ks[8], (DEPTH, HEAD_DIM)),
        "b_k_norm": gain(ks[9], (DEPTH, HEAD_DIM)),
        "diff_lambda": 0.1 * jax.random.normal(ks[10], (DEPTH, 4, HEAD_DIM), f32),
        "b_subln": gain(ks[11], (DEPTH, B_VDIM)),
        "w_up_a": dense(ks[12], (DEPTH, D_A, D_MODEL), D_A),
        "w_up_b": dense(ks[13], (DEPTH, D_B, D_MODEL), D_B),
        "w_out": dense(ks[14], (DEPTH, D_MODEL, D_MODEL), D_MODEL),
        "ffn_norm": gain(ks[15], (DEPTH, D_MODEL)),
        "w_ffn_in": dense(ks[16], (DEPTH, D_MODEL, 2 * FFN_HIDDEN), D_MODEL),
        "w_ffn_out": dense(ks[17], (DEPTH, FFN_HIDDEN, D_MODEL), FFN_HIDDEN),
    }


def reference(x, positions, attn_norm, w_in, gate_bias, a_q_norm, a_k_norm, idx_k_norm,
              b_q_norm, b_k_norm, diff_lambda, b_subln, w_up_a, w_up_b, w_out,
              ffn_norm, w_ffn_in, w_ffn_out):
    cos, sin = rope_tables(positions)
    for l in range(DEPTH):
        x = hybrid_layer(x, cos, sin, l, attn_norm[l], w_in[l], gate_bias[l], a_q_norm[l],
                         a_k_norm[l], idx_k_norm[l], b_q_norm[l], b_k_norm[l],
                         diff_lambda[l], b_subln[l], w_up_a[l], w_up_b[l], w_out[l],
                         ffn_norm[l], w_ffn_in[l], w_ffn_out[l])
    return x
```

```cpp
#include <hip/hip_runtime.h>
#include <cstdio>
#include <cstdint>
namespace pg8 {
#define PG8_LAS __attribute__((address_space(3)))
typedef unsigned short bf16_t;
typedef short bf16x8 __attribute__((ext_vector_type(8)));
typedef float f32x4 __attribute__((ext_vector_type(4)));
typedef unsigned u32x4 __attribute__((ext_vector_type(4)));
constexpr int BM = 256, BK = 64, HALF = 128, HTB = HALF * BK * 2  , STAGE_BYTES = 8 * HTB, NXCD = 8, WGM = 8;

__host__ __device__ __forceinline__ int lds_byte(int r, int c) { const int st = (r >> 4) * 2 + (c >> 5), rr = r & 15, cc = c & 31, ob = rr * 64 + cc * 2; return st * 1024 + (ob ^ (((ob >> 9) & 1) << 5)); }
__host__ __device__ __forceinline__ void stage_rc(int b, int& R, int& C) { const int st = b / 1024, sb = b % 1024, swz = sb ^ (((sb >> 9) & 1) << 5); R = (st >> 1) * 16 + swz / 64; C = (st & 1) * 32 + (swz % 64) / 2; }
__host__ __device__ __forceinline__ int perm32(int rho) { const int n = rho >> 4, i = rho & 15; return 8 * (i >> 2) + 4 * n + (i & 3); }

struct Unit { int pm, pn; };
struct Gemm { const bf16_t* A; const bf16_t* Bt; int M, N, K; };

struct StaticOrder {
    int nM, nN, nwg, G, c;
    __host__ __device__ void init(int M, int N, int G_, int c_) { nM = M / BM; nN = N / BM; nwg = nM * nN; G = G_; c = c_; }
    __host__ __device__ bool next(int i, Unit& u) const {
        const long L = (long)i * G + c; if (L >= nwg) return false;
        int wgid = (int)L; { const int q = nwg / NXCD, r = nwg % NXCD, xcd = wgid % NXCD, off = wgid / NXCD; wgid = (xcd < r ? xcd * (q + 1) : r * (q + 1) + (xcd - r) * q) + off; }
        const int nig = WGM * nN, gid = wgid / nig, fm = gid * WGM, gsz = (nM - fm) < WGM ? (nM - fm) : WGM;
        u.pm = fm + ((wgid % nig) % gsz); u.pn = (wgid % nig) / gsz; return true;
    }
    __device__ __forceinline__ void a_ready(const Unit&) const {}
    __device__ __forceinline__ void done(const Unit&) const {}
};

__device__ __forceinline__ unsigned cvt_pk_bf16(float lo, float hi) { unsigned r; asm volatile("v_cvt_pk_bf16_f32 %0, %1, %2" : "=v"(r) : "v"(lo), "v"(hi)); return r; }
typedef float f32x2 __attribute__((ext_vector_type(2)));
template <class Epi, class Sched, bool ALIGN_EPI = false, bool SP2 = false>
__device__ __forceinline__ void gemm_phase(PG8_LAS unsigned char* lds, const Gemm g, const Sched& S, const Epi& E) {
    int tid_ = threadIdx.x; asm volatile("" : "+v"(tid_));
    const int tid = tid_, wid = __builtin_amdgcn_readfirstlane(tid >> 6), lane = tid & 63, wr = wid >> 2, wc = wid & 3, fr = lane & 15, fq = lane >> 4;
    const int K = g.K, nt = K / BK;
    unsigned voffA[2], voffB[2];
#pragma unroll
    for (int i = 0; i < 2; ++i) { int R, C; stage_rc(tid * 16 + i * 8192, R, C); const int Rb = Epi::PERM ? ((R & ~31) + perm32(R & 31)) : R;
        voffA[i] = (unsigned)(R * K + C) * 2u; voffB[i] = (unsigned)(Rb * K + C) * 2u; }
    const size_t kstep = (size_t)(BK * 2);
    const size_t hstep = (size_t)HALF * K * 2;
    const size_t tstep = 2 * hstep;
    const unsigned ldsw = (unsigned)wid * 1024u;
    const int aoff = lds_byte(wr * 64 + fr, fq * 8), boff = lds_byte(wc * 32 + fr, fq * 8);
#define PG8_SA(b, h) (((b) * 2 + (h)) * HTB)
#define PG8_SB(b, h) ((4 + (b) * 2 + (h)) * HTB)
#define PG8_STAGE(bufoff, gbase, voff) do { _Pragma("unroll") for (int _i = 0; _i < 2; ++_i) \
        __builtin_amdgcn_global_load_lds((const unsigned*)((const char*)(gbase) + (voff)[_i]), (PG8_LAS unsigned*)(lds + (bufoff) + ldsw + _i * 8192), 16, 0, 0); } while (0)
#define PG8_LDA(dst, b, h) do { _Pragma("unroll") for (int m = 0; m < 4; ++m) _Pragma("unroll") for (int k = 0; k < 2; ++k) dst[m][k] = *(const PG8_LAS bf16x8*)(lds + PG8_SA(b, h) + aoff + m * 2048 + k * 1024); } while (0)
#define PG8_LDB(dst, b, h) do { _Pragma("unroll") for (int n = 0; n < 2; ++n) _Pragma("unroll") for (int k = 0; k < 2; ++k) dst[n][k] = *(const PG8_LAS bf16x8*)(lds + PG8_SB(b, h) + boff + n * 2048 + k * 1024); } while (0)
#define PG8_MMA(ai, bj, At, Bt) do { __builtin_amdgcn_s_setprio(1); _Pragma("unroll") for (int m = 0; m < 4; ++m) _Pragma("unroll") for (int n = 0; n < 2; ++n) _Pragma("unroll") for (int k = 0; k < 2; ++k) \
        acc[ai][bj][m][n] = __builtin_amdgcn_mfma_f32_16x16x32_bf16(Bt[n][k], At[m][k], acc[ai][bj][m][n], 0, 0, 0); __builtin_amdgcn_s_setprio(0); } while (0)
#define PG8_WAIT_V(n) asm volatile("s_waitcnt vmcnt(" #n ")" ::: "memory")
#define PG8_WAIT_L(n) asm volatile("s_waitcnt lgkmcnt(" #n ")" ::: "memory")
#define PG8_BAR __builtin_amdgcn_s_barrier()
#define PG8_SCHED __builtin_amdgcn_sched_barrier(0)
    Unit cur, nxt; int ui = 0;
    if (!S.next(0, cur)) return;
    f32x4 acc[2][2][4][2];
#pragma unroll
    for (int a = 0; a < 2; ++a)
#pragma unroll
        for (int b = 0; b < 2; ++b)
#pragma unroll
            for (int m = 0; m < 4; ++m)
#pragma unroll
                for (int n = 0; n < 2; ++n) acc[a][b][m][n] = (f32x4){0.f, 0.f, 0.f, 0.f};
    bf16x8 At[4][2], B0[2][2], B1[2][2];
    const char* cA = (const char*)g.A + (size_t)cur.pm * tstep; const char* cB = (const char*)g.Bt + (size_t)cur.pn * tstep;
    S.a_ready(cur);
    if constexpr (SP2) {
        PG8_STAGE(PG8_SB(0, 0), cB, voffB); PG8_STAGE(PG8_SB(0, 1), cB + hstep, voffB); PG8_STAGE(PG8_SA(0, 0), cA, voffA); PG8_STAGE(PG8_SA(0, 1), cA + hstep, voffA);
        if (wr == 1) PG8_BAR;
        PG8_WAIT_V(2); PG8_BAR;
        PG8_STAGE(PG8_SB(1, 0), cB + kstep, voffB); PG8_STAGE(PG8_SA(1, 0), cA + kstep, voffA); PG8_STAGE(PG8_SB(1, 1), cB + hstep + kstep, voffB);
        PG8_WAIT_V(6); PG8_BAR;
    } else {
        PG8_STAGE(PG8_SB(0, 0), cB, voffB); PG8_STAGE(PG8_SA(0, 0), cA, voffA); PG8_STAGE(PG8_SB(0, 1), cB + hstep, voffB); PG8_STAGE(PG8_SA(0, 1), cA + hstep, voffA);
        if (wr == 1) PG8_BAR;
        PG8_WAIT_V(4); PG8_BAR;
        PG8_STAGE(PG8_SB(1, 0), cB + kstep, voffB); PG8_STAGE(PG8_SA(1, 0), cA + kstep, voffA); PG8_STAGE(PG8_SB(1, 1), cB + hstep + kstep, voffB);
        PG8_WAIT_V(6); PG8_BAR;
    }
    for (;;) {
        const bool has_next = S.next(ui + 1, nxt);
        const char* nA = has_next ? (const char*)g.A + (size_t)nxt.pm * tstep : cA; const char* nB = has_next ? (const char*)g.Bt + (size_t)nxt.pn * tstep : cB;
        for (int t = 0; t < nt; t += 2) {
            const bool last = (t == nt - 2);
            const char* a1 = cA + (size_t)(t + 1) * kstep;
            const char* a2 = last ? nA : cA + (size_t)(t + 2) * kstep; const char* b2 = last ? nB : cB + (size_t)(t + 2) * kstep;
            const char* a3 = a2 + kstep; const char* b3 = b2 + kstep;
            if (last && has_next) S.a_ready(nxt);
            if constexpr (SP2) {
            PG8_LDB(B0, 0, 0); PG8_LDB(B1, 0, 1); PG8_SCHED; PG8_LDA(At, 0, 0); PG8_STAGE(PG8_SA(1, 1), a1 + hstep, voffA);
            PG8_WAIT_V(8); PG8_WAIT_L(0); PG8_BAR; PG8_MMA(0, 0, At, B0); PG8_MMA(0, 1, At, B1); PG8_BAR; PG8_SCHED;
            PG8_LDA(At, 0, 1); PG8_STAGE(PG8_SB(0, 0), b2, voffB); PG8_STAGE(PG8_SB(0, 1), b2 + hstep, voffB); PG8_STAGE(PG8_SA(0, 0), a2, voffA);
            PG8_WAIT_V(8); PG8_WAIT_L(0); PG8_BAR; PG8_MMA(1, 0, At, B0); PG8_MMA(1, 1, At, B1); PG8_BAR; PG8_SCHED;
            PG8_LDB(B0, 1, 0); PG8_LDB(B1, 1, 1); PG8_SCHED; PG8_LDA(At, 1, 0); PG8_STAGE(PG8_SA(0, 1), a2 + hstep, voffA);
            PG8_WAIT_V(8); PG8_WAIT_L(0); PG8_BAR; PG8_MMA(0, 0, At, B0); PG8_MMA(0, 1, At, B1); PG8_BAR; PG8_SCHED;
            PG8_LDA(At, 1, 1); PG8_STAGE(PG8_SB(1, 0), b3, voffB); PG8_STAGE(PG8_SB(1, 1), b3 + hstep, voffB); PG8_STAGE(PG8_SA(1, 0), a3, voffA);
            PG8_WAIT_V(8); PG8_WAIT_L(0); PG8_BAR; PG8_MMA(1, 0, At, B0); PG8_MMA(1, 1, At, B1); PG8_BAR; PG8_SCHED;
            } else {
            PG8_LDB(B0, 0, 0); PG8_SCHED; PG8_LDA(At, 0, 0); PG8_STAGE(PG8_SA(1, 1), a1 + hstep, voffA);
            PG8_WAIT_L(8); PG8_BAR; PG8_WAIT_L(0); PG8_MMA(0, 0, At, B0); PG8_BAR; PG8_SCHED;
            PG8_LDB(B1, 0, 1); PG8_STAGE(PG8_SB(0, 0), b2, voffB);
            PG8_BAR; PG8_WAIT_L(0); PG8_MMA(0, 1, At, B1); PG8_BAR;
            PG8_LDA(At, 0, 1); PG8_STAGE(PG8_SA(0, 0), a2, voffA);
            PG8_BAR; PG8_WAIT_L(0); PG8_MMA(1, 0, At, B0); PG8_BAR; PG8_SCHED;
            PG8_STAGE(PG8_SB(0, 1), b2 + hstep, voffB);
            PG8_WAIT_V(6); PG8_BAR; PG8_MMA(1, 1, At, B1); PG8_BAR;
            PG8_LDB(B0, 1, 0); PG8_SCHED; PG8_LDA(At, 1, 0); PG8_STAGE(PG8_SA(0, 1), a2 + hstep, voffA);
            PG8_WAIT_L(8); PG8_BAR; PG8_WAIT_L(0); PG8_MMA(0, 0, At, B0); PG8_BAR; PG8_SCHED;
            PG8_LDB(B1, 1, 1); PG8_STAGE(PG8_SB(1, 0), b3, voffB);
            PG8_BAR; PG8_WAIT_L(0); PG8_MMA(0, 1, At, B1); PG8_BAR;
            PG8_LDA(At, 1, 1); PG8_STAGE(PG8_SA(1, 0), a3, voffA);
            PG8_BAR; PG8_WAIT_L(0); PG8_MMA(1, 0, At, B0); PG8_BAR; PG8_SCHED;
            PG8_STAGE(PG8_SB(1, 1), b3 + hstep, voffB);
            PG8_WAIT_V(6); PG8_BAR; PG8_MMA(1, 1, At, B1); PG8_BAR;
            }
        }
        if constexpr (ALIGN_EPI) { if (wr == 0) PG8_BAR; }
        if constexpr (!Epi::AFTER_DRAIN) { E(acc, cur, wr, wc, fr, fq); S.done(cur); }
        if (!has_next) break;
#pragma unroll
        for (int a = 0; a < 2; ++a)
#pragma unroll
            for (int b = 0; b < 2; ++b)
#pragma unroll
                for (int m = 0; m < 4; ++m)
#pragma unroll
                    for (int n = 0; n < 2; ++n) acc[a][b][m][n] = (f32x4){0.f, 0.f, 0.f, 0.f};
        cur = nxt; cA = nA; cB = nB; ++ui;
        if constexpr (ALIGN_EPI) { if (wr == 1) PG8_BAR; }
    }
    PG8_WAIT_V(0);
    if constexpr (!ALIGN_EPI) { if (wr == 0) PG8_BAR; }
    PG8_BAR;
    if constexpr (Epi::AFTER_DRAIN) { E.fused(acc, cur, wr, wc, fr, fq, lds, wid, lane); S.done(cur); }
#undef PG8_SA
#undef PG8_SB
#undef PG8_STAGE
#undef PG8_LDA
#undef PG8_LDB
#undef PG8_MMA
#undef PG8_WAIT_V
#undef PG8_WAIT_L
#undef PG8_BAR
#undef PG8_SCHED
}
}
namespace epi {
using pg8::f32x4; using pg8::u32x4; using pg8::Unit; using pg8::bf16_t;
typedef float f32x2_t __attribute__((ext_vector_type(2))); typedef __bf16 bf16x2_t __attribute__((ext_vector_type(2)));
__device__ __forceinline__ unsigned cvt_pk_bf16(float lo, float hi) { const f32x2_t v = {lo, hi}; const bf16x2_t b = __builtin_convertvector(v, bf16x2_t); return __builtin_bit_cast(unsigned, b); }
constexpr float EPSN = 1e-6f;
constexpr float QSCALE = 0.125f * 1.4426950408889634f;
__device__ __forceinline__ float bflo(unsigned w) { return __uint_as_float(w << 16); }
__device__ __forceinline__ float bfhi(unsigned w) { return __uint_as_float(w & 0xffff0000u); }
__device__ __forceinline__ float rstd_row(const float* ss, int row, int fq) {
    const f32x4 a = ((const f32x4*)(ss + (size_t)row * 16))[fq];
    float s = (a[0] + a[1]) + (a[2] + a[3]);
    s += __shfl_xor(s, 16); s += __shfl_xor(s, 32);
    return 1.0f / sqrtf(s * (1.0f / 1024.0f) + EPSN);
}
__device__ __forceinline__ float sigm(float v) { return __builtin_amdgcn_rcpf(1.0f + __expf(-v)); }

constexpr int PTR_OFF = 131072 + 1024;
__device__ __forceinline__ const float* lds_inptr(PG8_LAS unsigned char* ldsb, int i) {
    const PG8_LAS unsigned* t = (const PG8_LAS unsigned*)(ldsb + PTR_OFF) + 2 * i;
    const unsigned lo = __builtin_amdgcn_readfirstlane(t[0]), hi = __builtin_amdgcn_readfirstlane(t[1]);
    return (const float*)(const __attribute__((address_space(1))) float*)(((unsigned long long)hi << 32) | lo);
}
constexpr size_t EMiB = 1u << 20;
constexpr size_t EI_SS = 66 * EMiB, EI_ROPE = 74 * EMiB, EI_IW = 122 * EMiB, EI_IK = 124 * EMiB, EI_IQ = 132 * EMiB, EI_AQ = 292 * EMiB, EI_AK = 356 * EMiB, EI_AV = 420 * EMiB, EI_BQ = 484 * EMiB, EI_BK = 548 * EMiB, EI_BV = 612 * EMiB, EI_G = 676 * EMiB;
struct EpiIn {
    static constexpr bool PERM = true, AFTER_DRAIN = false;
    unsigned char* ws; PG8_LAS unsigned char* ldsb; int layer;
    __device__ __forceinline__ void operator()(const f32x4 (&acc)[2][2][4][2], const Unit& u, int wr, int wc, int fr, int fq) const {
        const int pn = u.pn, rowb = u.pm * 256 + wr * 64 + fr;
        const float* ss = (const float*)(ws + EI_SS); const float* rope = (const float*)(ws + EI_ROPE);
        if (pn >= 14) {
            const int colb = (pn - 14) * 256 + wc * 64 + 8 * fq;
            const float* gbias = lds_inptr(ldsb, 4) + layer * 2048; bf16_t* G = (bf16_t*)(ws + EI_G);
            f32x4 bia[2][2];
#pragma unroll
            for (int bj = 0; bj < 2; ++bj)
#pragma unroll
                for (int n = 0; n < 2; ++n) bia[bj][n] = *(const f32x4*)(gbias + colb + 32 * bj + 4 * n);
#pragma unroll
            for (int ai = 0; ai < 2; ++ai)
#pragma unroll
                for (int m = 0; m < 4; ++m) { const int row = rowb + ai * 128 + m * 16; const float r = rstd_row(ss, row, fq);
#pragma unroll
                    for (int bj = 0; bj < 2; ++bj) { const f32x4 v0 = acc[ai][bj][m][0] * r + bia[bj][0], v1 = acc[ai][bj][m][1] * r + bia[bj][1];
                        u32x4 w; w.x = cvt_pk_bf16(sigm(v0[0]), sigm(v0[1])); w.y = cvt_pk_bf16(sigm(v0[2]), sigm(v0[3])); w.z = cvt_pk_bf16(sigm(v1[0]), sigm(v1[1])); w.w = cvt_pk_bf16(sigm(v1[2]), sigm(v1[3]));
                        *(u32x4*)(G + (size_t)row * 2048 + colb + 32 * bj) = w; } }
            return;
        }
        size_t doff; int gi = -1; int pitch = 512; bool rp = false; float sc = 1.f;
        if (pn < 2)       { doff = EI_AQ + (size_t)((pn * 4 + wc) * 64) * 2; gi = 5; rp = true; sc = QSCALE; }
        else if (pn < 4)  { doff = EI_AK + (size_t)(((pn - 2) * 4 + wc) * 64) * 2; gi = 6; rp = true; }
        else if (pn < 6)  { doff = EI_AV + (size_t)(((pn - 4) * 4 + wc) * 64) * 2; }
        else if (pn == 6) { doff = EI_IQ + (size_t)(wc * 64) * 2; pitch = 256; rp = true; }
        else if (pn == 7) {
            if (wc == 0) { doff = EI_IK; pitch = 64; gi = 7; rp = true; }
            else { if (wc == 1) {
                    float* IW = (float*)(ws + EI_IW);
#pragma unroll
                    for (int ai = 0; ai < 2; ++ai)
#pragma unroll
                        for (int m = 0; m < 4; ++m) { const int row = rowb + ai * 128 + m * 16; const float r = rstd_row(ss, row, fq) * 0.5f; if (fq == 0) *(f32x4*)(IW + (size_t)row * 4) = acc[ai][0][m][0] * r; } }
                return; } }
        else if (pn < 10) { doff = EI_BQ + (size_t)(((pn - 8) * 4 + wc) * 64) * 2; gi = 8; rp = true; sc = QSCALE; }
        else if (pn < 12) { doff = EI_BK + (size_t)(((pn - 10) * 4 + wc) * 64) * 2; gi = 9; rp = true; }
        else              { doff = EI_BV + (size_t)(((pn - 12) * 4 + wc) * 64) * 2; }
        bf16_t* dst = (bf16_t*)(ws + doff);
        const float* gn = (gi >= 0) ? lds_inptr(ldsb, gi) + layer * 64 : nullptr;
        float gv[2][8];
#pragma unroll
        for (int bj = 0; bj < 2; ++bj)
#pragma unroll
            for (int j = 0; j < 8; ++j) gv[bj][j] = 1.f;
        if (gn) {
#pragma unroll
            for (int bj = 0; bj < 2; ++bj) { const f32x4 a = *(const f32x4*)(gn + 32 * bj + 8 * fq), b = *(const f32x4*)(gn + 32 * bj + 8 * fq + 4);
                gv[bj][0] = a[0]; gv[bj][1] = a[1]; gv[bj][2] = a[2]; gv[bj][3] = a[3]; gv[bj][4] = b[0]; gv[bj][5] = b[1]; gv[bj][6] = b[2]; gv[bj][7] = b[3]; } }
#pragma unroll
        for (int ai = 0; ai < 2; ++ai)
#pragma unroll
            for (int m = 0; m < 4; ++m) { const int row = rowb + ai * 128 + m * 16; const float r = rstd_row(ss, row, fq);
                float v[2][8];
#pragma unroll
                for (int bj = 0; bj < 2; ++bj)
#pragma unroll
                    for (int n = 0; n < 2; ++n)
#pragma unroll
                        for (int i = 0; i < 4; ++i) v[bj][4 * n + i] = acc[ai][bj][m][n][i] * r;
                if (gn) {
                    float q = 0.f;
#pragma unroll
                    for (int bj = 0; bj < 2; ++bj)
#pragma unroll
                        for (int j = 0; j < 8; ++j) q += v[bj][j] * v[bj][j];
                    q += __shfl_xor(q, 16); q += __shfl_xor(q, 32);
                    const float rn = 1.0f / sqrtf(q * (1.0f / 64.0f) + EPSN);
#pragma unroll
                    for (int bj = 0; bj < 2; ++bj)
#pragma unroll
                        for (int j = 0; j < 8; ++j) v[bj][j] = (v[bj][j] * rn) * gv[bj][j];
                }
                if (rp) {
                    const f32x4* cp = (const f32x4*)(rope + ((size_t)row * 32 + 8 * fq) * 2);
                    const f32x4 c0 = cp[0], c1 = cp[1], c2 = cp[2], c3 = cp[3];
                    const float cs[8] = {c0[0], c0[2], c1[0], c1[2], c2[0], c2[2], c3[0], c3[2]}, sn[8] = {c0[1], c0[3], c1[1], c1[3], c2[1], c2[3], c3[1], c3[3]};
#pragma unroll
                    for (int j = 0; j < 8; ++j) { const float a = v[0][j], b = v[1][j]; v[0][j] = a * cs[j] - b * sn[j]; v[1][j] = b * cs[j] + a * sn[j]; }
                }
#pragma unroll
                for (int bj = 0; bj < 2; ++bj) { u32x4 w; w.x = cvt_pk_bf16(v[bj][0] * sc, v[bj][1] * sc); w.y = cvt_pk_bf16(v[bj][2] * sc, v[bj][3] * sc); w.z = cvt_pk_bf16(v[bj][4] * sc, v[bj][5] * sc); w.w = cvt_pk_bf16(v[bj][6] * sc, v[bj][7] * sc);
                    *(u32x4*)(dst + (size_t)row * pitch + 32 * bj + 8 * fq) = w; }
            }
    }
};

template <bool SECOND> struct EpiGate {
    static constexpr bool PERM = true, AFTER_DRAIN = false;
    const bf16_t* G; bf16_t* T; bf16_t* O;
    __device__ __forceinline__ void operator()(const f32x4 (&acc)[2][2][4][2], const Unit& u, int wr, int wc, int fr, int fq) const {
        const int rowb = u.pm * 256 + wr * 64 + fr, colb = u.pn * 256 + wc * 32 + 8 * fq;
#pragma unroll
        for (int ai = 0; ai < 2; ++ai)
#pragma unroll
            for (int m = 0; m < 4; ++m) { const int row = rowb + ai * 128 + m * 16;
#pragma unroll
                for (int bj = 0; bj < 2; ++bj) { const int col = colb + 128 * bj;
#if defined(DBG_NO_G)
                    const u32x4 gw = {0x3f803f80u, 0x3f803f80u, 0x3f803f80u, 0x3f803f80u};
#else
                    const u32x4 gw = *(const u32x4*)(G + (size_t)row * 2048 + (SECOND ? 1024 : 0) + col);
#endif
                    const f32x4 a0 = acc[ai][bj][m][0], a1 = acc[ai][bj][m][1];
                    float v[8] = {a0[0] * bflo(gw.x), a0[1] * bfhi(gw.x), a0[2] * bflo(gw.y), a0[3] * bfhi(gw.y), a1[0] * bflo(gw.z), a1[1] * bfhi(gw.z), a1[2] * bflo(gw.w), a1[3] * bfhi(gw.w)};
                    if (SECOND) { const u32x4 tw = *(const u32x4*)(T + (size_t)row * 1024 + col);
                        v[0] += bflo(tw.x); v[1] += bfhi(tw.x); v[2] += bflo(tw.y); v[3] += bfhi(tw.y); v[4] += bflo(tw.z); v[5] += bfhi(tw.z); v[6] += bflo(tw.w); v[7] += bfhi(tw.w); }
                    u32x4 w; w.x = cvt_pk_bf16(v[0], v[1]); w.y = cvt_pk_bf16(v[2], v[3]); w.z = cvt_pk_bf16(v[4], v[5]); w.w = cvt_pk_bf16(v[6], v[7]);
                    *(u32x4*)((SECOND ? O : T) + (size_t)row * 1024 + col) = w; } }
    }
};

struct EpiRes {
    static constexpr bool PERM = true, AFTER_DRAIN = false;
    const float* base; float* out; bf16_t* XB; float* ssout;
    __device__ __forceinline__ void operator()(const f32x4 (&acc)[2][2][4][2], const Unit& u, int wr, int wc, int fr, int fq) const {
        const int rowb = u.pm * 256 + wr * 64 + fr, colb = u.pn * 256 + wc * 32 + 8 * fq;
#pragma unroll
        for (int ai = 0; ai < 2; ++ai)
#pragma unroll
            for (int m = 0; m < 4; ++m) { const int row = rowb + ai * 128 + m * 16; float q = 0.f;
#pragma unroll
                for (int bj = 0; bj < 2; ++bj) { const size_t off = (size_t)row * 1024 + colb + 128 * bj;
                    const f32x4 b0 = *(const f32x4*)(base + off), b1 = *(const f32x4*)(base + off + 4);
                    const f32x4 o0 = b0 + acc[ai][bj][m][0], o1 = b1 + acc[ai][bj][m][1];
                    *(f32x4*)(out + off) = o0; *(f32x4*)(out + off + 4) = o1;
                    u32x4 w; w.x = cvt_pk_bf16(o0[0], o0[1]); w.y = cvt_pk_bf16(o0[2], o0[3]); w.z = cvt_pk_bf16(o1[0], o1[1]); w.w = cvt_pk_bf16(o1[2], o1[3]);
                    *(u32x4*)(XB + off) = w;
                    q += ((o0[0] * o0[0] + o0[1] * o0[1]) + (o0[2] * o0[2] + o0[3] * o0[3])) + ((o1[0] * o1[0] + o1[1] * o1[1]) + (o1[2] * o1[2] + o1[3] * o1[3])); }
                q += __shfl_xor(q, 16); q += __shfl_xor(q, 32);
                if (fq == 0) ssout[(size_t)row * 16 + u.pn * 4 + wc] = q; }
    }
};

struct EpiSwiglu {
    static constexpr bool PERM = true, AFTER_DRAIN = false;
    const float* ss; bf16_t* ACT;
    __device__ __forceinline__ void operator()(const f32x4 (&acc)[2][2][4][2], const Unit& u, int wr, int wc, int fr, int fq) const {
        const int rowb = u.pm * 256 + wr * 64 + fr, colb = u.pn * 128 + wc * 32 + 8 * fq;
#pragma unroll
        for (int ai = 0; ai < 2; ++ai)
#pragma unroll
            for (int m = 0; m < 4; ++m) { const int row = rowb + ai * 128 + m * 16; const float r = rstd_row(ss, row, fq);
                float a[8];
#pragma unroll
                for (int n = 0; n < 2; ++n)
#pragma unroll
                    for (int i = 0; i < 4; ++i) { const float g = acc[ai][0][m][n][i] * r, up = acc[ai][1][m][n][i] * r; a[4 * n + i] = (g * sigm(g)) * up; }
                u32x4 w; w.x = cvt_pk_bf16(a[0], a[1]); w.y = cvt_pk_bf16(a[2], a[3]); w.z = cvt_pk_bf16(a[4], a[5]); w.w = cvt_pk_bf16(a[6], a[7]);
                *(u32x4*)(ACT + (size_t)row * 2816 + colb) = w; }
    }
};
}
#include <hip/hip_bf16.h>
#include <cmath>
namespace attn_body {
using bf16=__hip_bfloat16;
using bf16x8=__attribute__((ext_vector_type(8)))short;
using s16x4=__attribute__((ext_vector_type(4)))short;
using f32x16=__attribute__((ext_vector_type(16)))float;
using u32x4=__attribute__((ext_vector_type(4)))unsigned;
constexpr int SEQ=2048,D=64,DM=512;
constexpr int NW=8,QBLK=32,QB=QBLK*NW,KVBLK=64,NQB=SEQ/QB;
constexpr int ATTN_PITCH=DM, ATTN_UNIT_ROWS=QB;
__device__ __forceinline__ int crow(int r,int hi){return (r&3)+8*(r>>2)+4*hi;}
#define SBAR() __builtin_amdgcn_sched_barrier(0)
__device__ __forceinline__ void cmask(f32x16&p0,f32x16&p1,int jb,int qrel,int hi){
  const float NEG=-INFINITY; int qh=qrel-64*jb-4*hi; asm volatile("":"+v"(qh));
  #pragma unroll
  for(int r=0;r<16;++r){const int c=(r&3)+8*(r>>2); if(c>qh)p0[r]=NEG; if(c+32>qh)p1[r]=NEG;}
}

constexpr int NSLOT=3, SLOTB=8192;
constexpr int LDS_K=0, LDS_V=NSLOT*SLOTB, LDS_WS=2*NSLOT*SLOTB, LDS_OST=LDS_WS+NW*64*4, LDS_BYTES=LDS_OST+NW*4096;
constexpr float C2=0.125f*1.4426950408889634f;
__device__ __forceinline__ void glds16(const void*gsrc,unsigned lds_dst){unsigned keep;
  asm volatile("s_mov_b32 %0, m0\n\ts_mov_b32 m0, %2\n\ts_nop 0\n\tglobal_load_lds_dwordx4 %1, off\n\ts_mov_b32 m0, %0":"=&s"(keep):"v"(gsrc),"s"(lds_dst):"memory");}
__device__ __forceinline__ float max3f(float a,float b,float c){float r;asm("v_max3_f32 %0, %1, %2, %3":"=v"(r):"v"(a),"v"(b),"v"(c));return r;}
__device__ __forceinline__ float max2f(float a,float b){float r;asm("v_max_f32_e32 %0, %1, %2":"=v"(r):"v"(a),"v"(b));return r;}
__device__ __forceinline__ float fadd_s(float a,float b){float r;asm("v_add_f32_e32 %0, %1, %2":"=v"(r):"v"(a),"v"(b));return r;}
__device__ __forceinline__ float fsub_s(float a,float b){float r;asm("v_sub_f32_e32 %0, %1, %2":"=v"(r):"v"(a),"v"(b));return r;}
typedef float f32x2_t __attribute__((ext_vector_type(2))); typedef __bf16 bf16x2_t __attribute__((ext_vector_type(2)));
__device__ __forceinline__ unsigned cvtpk_s(float lo,float hi){f32x2_t v={lo,hi};bf16x2_t b=__builtin_convertvector(v,bf16x2_t);return __builtin_bit_cast(unsigned,b);}
#define WAIT_BAR(N) asm volatile("s_waitcnt vmcnt(" #N ") lgkmcnt(0)\n\ts_barrier":::"memory")

__device__ __forceinline__ void qkt(f32x16&p0,f32x16&p1,const char*Kslot,const bf16x8*qr,const f32x16&negm,int r32,int hi){
  const char*kb=Kslot+hi*1024+r32*16;
  #pragma unroll
  for(int d0=0;d0<4;++d0){
    const bf16x8 b0=*reinterpret_cast<const bf16x8*>(kb+d0*2048);
    const bf16x8 b1=*reinterpret_cast<const bf16x8*>(kb+d0*2048+512);
    if(d0==0){p0=__builtin_amdgcn_mfma_f32_32x32x16_bf16(b0,qr[0],negm,0,0,0);p1=__builtin_amdgcn_mfma_f32_32x32x16_bf16(b1,qr[0],negm,0,0,0);}
    else{p0=__builtin_amdgcn_mfma_f32_32x32x16_bf16(b0,qr[d0],p0,0,0,0);p1=__builtin_amdgcn_mfma_f32_32x32x16_bf16(b1,qr[d0],p1,0,0,0);}}
}
typedef __attribute__((address_space(3))) const char* lds_cptr;
typedef short v4i16_t __attribute__((ext_vector_type(4)));
__device__ __forceinline__ void kload8(bf16x8*kf,lds_cptr kp){
  kf[0]=*(const __attribute__((address_space(3))) bf16x8*)(kp);      kf[1]=*(const __attribute__((address_space(3))) bf16x8*)(kp+512);
  kf[2]=*(const __attribute__((address_space(3))) bf16x8*)(kp+2048); kf[3]=*(const __attribute__((address_space(3))) bf16x8*)(kp+2560);
  kf[4]=*(const __attribute__((address_space(3))) bf16x8*)(kp+4096); kf[5]=*(const __attribute__((address_space(3))) bf16x8*)(kp+4608);
  kf[6]=*(const __attribute__((address_space(3))) bf16x8*)(kp+6144); kf[7]=*(const __attribute__((address_space(3))) bf16x8*)(kp+6656);
}
__device__ __forceinline__ void kload2(bf16x8*kf,lds_cptr kp,int j){ kf[2*j]=*(const __attribute__((address_space(3))) bf16x8*)(kp+j*2048); kf[2*j+1]=*(const __attribute__((address_space(3))) bf16x8*)(kp+j*2048+512); }
__device__ __forceinline__ s16x4 vtr(lds_cptr p){ return __builtin_bit_cast(s16x4,__builtin_amdgcn_ds_read_tr16_b64_v4i16((__attribute__((address_space(3))) v4i16_t*)p)); }
__device__ __forceinline__ float rowmax(const f32x16&p0,const f32x16&p1){
  float a=max3f(p0[0],p0[1],p1[0]),b=max3f(p0[2],p0[3],p1[1]);a=max3f(a,p1[2],p1[3]);
  #pragma unroll
  for(int r=4;r<16;r+=4){a=max3f(a,p0[r],p0[r+1]);b=max3f(b,p0[r+2],p0[r+3]);a=max3f(a,p1[r],p1[r+1]);b=max3f(b,p1[r+2],p1[r+3]);}
  const float m=max2f(a,b);
  auto rr=__builtin_amdgcn_permlane32_swap(__float_as_uint(m),__float_as_uint(m),false,false);
  return max2f(__uint_as_float(rr[0]),__uint_as_float(rr[1]));
}
__device__ __forceinline__ void pv(f32x16*o,int vb,bf16x8 pa0,bf16x8 pa1,bf16x8 pa2,bf16x8 pa3){
  #pragma unroll
  for(int d0=0;d0<2;++d0){s16x4 lo[4],hi[4];
    #pragma unroll
    for(int ks=0;ks<4;++ks){
      asm volatile("ds_read_b64_tr_b16 %0,%1 offset:%c2":"=&v"(lo[ks]):"v"(vb),"i"(d0*4096+ks*1024):"memory");
      asm volatile("ds_read_b64_tr_b16 %0,%1 offset:%c2":"=&v"(hi[ks]):"v"(vb),"i"(d0*4096+ks*1024+512):"memory");}
    asm volatile("s_waitcnt lgkmcnt(0)":::"memory");SBAR();
    #define PK(k) (bf16x8){lo[k][0],lo[k][1],lo[k][2],lo[k][3],hi[k][0],hi[k][1],hi[k][2],hi[k][3]}
    o[d0]=__builtin_amdgcn_mfma_f32_32x32x16_bf16(pa0,PK(0),o[d0],0,0,0);
    o[d0]=__builtin_amdgcn_mfma_f32_32x32x16_bf16(pa1,PK(1),o[d0],0,0,0);
    o[d0]=__builtin_amdgcn_mfma_f32_32x32x16_bf16(pa2,PK(2),o[d0],0,0,0);
    o[d0]=__builtin_amdgcn_mfma_f32_32x32x16_bf16(pa3,PK(3),o[d0],0,0,0);
    #undef PK
  }
}

#ifndef ATTN_STORE16
#define ATTN_STORE16(p,v) (*(u32x4*)(p)=(v))
#endif
template<int THRL,bool TOPK> __device__ __forceinline__ void attn_unit(int b,int qb,const bf16*Qc,const bf16*__restrict__ Kc,const bf16*__restrict__ Vc,bf16*Oc,const unsigned*__restrict__ mk,char*shm){
  int tid_=threadIdx.x; asm volatile("":"+v"(tid_)); const int tid=tid_,lane=tid&63,r32=lane&31,hi=lane>>5; const int wid=__builtin_amdgcn_readfirstlane(tid>>6);
  const long rowbase=(long)b*SEQ; const int q0=qb*QB;
  const bf16*Qw=Qc+(rowbase+q0+wid*QBLK)*DM;
  const bf16*Kh=Kc+rowbase*DM,*Vh=Vc+rowbase*DM;
  const unsigned lds0=(unsigned)(uintptr_t)shm;
  float*wsf=(float*)(shm+LDS_WS)+wid*64;
  const bf16*ksrc=Kh+(long)lane*DM+wid*8;
  const bf16*vsrc=Vh+(long)(16*(wid&3)+(lane>>2))*DM+(wid>>2)*32+(lane&3)*8;
  const unsigned kdst=lds0+LDS_K+wid*1024, vdst=lds0+LDS_V+wid*1024;
  #define DMA_K(t,slot) glds16(ksrc+(long)(t)*KVBLK*DM,(unsigned)__builtin_amdgcn_readfirstlane(kdst+(slot)))
  #define DMA_V(t,slot) glds16(vsrc+(long)(t)*KVBLK*DM,(unsigned)__builtin_amdgcn_readfirstlane(vdst+(slot)))
  const int vb0=(int)(lds0+LDS_V)+((lane>>4)&1)*32+(lane&3)*8+(4*hi+((lane&15)>>2))*64;
  const char*Kbase=shm+LDS_K; bf16x8 kf[8];
  const lds_cptr shm3=(lds_cptr)shm; const lds_cptr kp0=shm3+LDS_K+hi*1024+r32*16; const lds_cptr vp0=shm3+LDS_V+((lane>>4)&1)*32+(lane&3)*8+(4*hi+((lane&15)>>2))*64;
  const int NT=(q0+QB)/KVBLK;
  DMA_K(0,0);DMA_V(0,0);DMA_K(1,SLOTB);
  bf16x8 qr[4];
  #pragma unroll
  for(int d0=0;d0<4;++d0)qr[d0]=*reinterpret_cast<const bf16x8*>(&Qw[(long)r32*DM+d0*16+hi*8]);
  float mhat=0.f,l_reg=0.f;f32x16 o[2];o[0]=f32x16{};o[1]=f32x16{};f32x16 negm=f32x16{};asm volatile("":"+v"(negm));
  const int qrel=wid*QBLK+r32;
  const unsigned*mrow=TOPK?(mk+((size_t)(b*64+qb*8+wid)*32)*64+r32*2):nullptr; const int sh4=4*hi; unsigned mw0=0u,mw1=0u; uint2 mwl=make_uint2(0u,0u);
  #define MLOAD(t) do{ if(TOPK){ mwl=*reinterpret_cast<const uint2*>(mrow+(size_t)(t)*64); } }while(0)
  #define MSHIFT() do{ if(TOPK){ mw0=mwl.x>>sh4; mw1=mwl.y>>sh4; asm volatile("":"+v"(mw0),"+v"(mw1)); } }while(0)
  #define MBIT(W,r) ((unsigned)__builtin_amdgcn_sbfe((int)(W),((r)&3)+8*((r)>>2),1))
  #define MAND(X,r,W) do{ if(TOPK){ X[r]=__uint_as_float(__float_as_uint(X[r])&MBIT(W,r)); } }while(0)
  MLOAD(0);
  #define CMASK(P0,P1,t) do{int jb_=(t)-(NT-4); if(jb_>=0)cmask(P0,P1,jb_,qrel,hi);}while(0)
  bool resc=false;
  #define START(P0,P1) do{ const float rm=rowmax(P0,P1); resc=false; \
    { const float dl=rm; mhat=fadd_s(mhat,dl); \
      _Pragma("unroll") for(int r=0;r<16;++r){P0[r]=fsub_s(P0[r],dl);P1[r]=fsub_s(P1[r],dl);} \
      _Pragma("unroll") for(int r=0;r<16;++r)negm[r]=-mhat; asm volatile("":"+v"(negm)); } \
    _Pragma("unroll") for(int r=0;r<16;++r)P0[r]=__builtin_amdgcn_exp2f(P0[r]); }while(0)
  #define RESC() do{ if(resc){ asm volatile("s_waitcnt lgkmcnt(0)":::"memory"); \
      _Pragma("unroll") for(int d_=0;d_<2;++d_) _Pragma("unroll") for(int r=0;r<16;++r)o[d_][r]*=wsf[crow(r,hi)]; } }while(0)
  f32x16 pA0,pA1,pB0,pB1;
  int sl_prev=0,sl_cur=0,sl_next=SLOTB;
  #define ROT() do{sl_prev=sl_cur;sl_cur=sl_next;sl_next=(sl_next==(NSLOT-1)*SLOTB)?0:sl_next+SLOTB;}while(0)
  DMA_K(2,2*SLOTB);
  WAIT_BAR(3);
  qkt(pA0,pA1,Kbase,qr,negm,r32,hi);asm volatile("s_nop 15\n\ts_nop 7":"+v"(pA0),"+v"(pA1));CMASK(pA0,pA1,0);
  START(pA0,pA1);
  _Pragma("unroll") for(int r=0;r<16;++r)pA1[r]=__builtin_amdgcn_exp2f(pA1[r]);
  if(TOPK){ MSHIFT(); _Pragma("unroll") for(int r=0;r<16;++r){ MAND(pA0,r,mw0); MAND(pA1,r,mw1); } }
  WAIT_BAR(0);
  DMA_K(3,0);DMA_V(1,SLOTB);
  ROT();
  kload8(kf,kp0+sl_cur);
  WAIT_BAR(2);
  s16x4 vlo[8],vhi[8]; u32x4 pw0,pw1,pw2,pw3;
  #define PKW(P,B) cvtpk_s(P[B],P[B+1])
  #define PAF(k) __builtin_bit_cast(bf16x8,pw##k)
  #define VFR(i) (bf16x8){vlo[i][0],vlo[i][1],vlo[i][2],vlo[i][3],vhi[i][0],vhi[i][1],vhi[i][2],vhi[i][3]}
  #define PIN(x) asm volatile("":"+v"(x))
  #define MX3(a,b,c) __builtin_fmaxf(__builtin_fmaxf((a),(b)),(c))
  #define GAPA(MF,A0,A1,A2,A3,W0,W1,PW) do{ MF; sacc+=A0; sacc+=A1; sacc+=A2; sacc+=A3; PIN(sacc); W0; W1; PIN(PW); SBAR(); }while(0)
  #define EX(v) __builtin_amdgcn_exp2f(v)
  #define GAPB(MF,X,B,W) do{ MF; X[B]=EX(X[B]); X[B+1]=EX(X[B+1]); X[B+2]=EX(X[B+2]); X[B+3]=EX(X[B+3]); MAND(X,B,W); MAND(X,B+1,W); MAND(X,B+2,W); MAND(X,B+3,W); PIN(X); SBAR(); }while(0)
  #define VRD(i) do{ vlo[i]=vtr(vp_+(((i)>>2)*4096+((i)&3)*1024)); vhi[i]=vtr(vp_+(((i)>>2)*4096+((i)&3)*1024+512)); }while(0)
  #define KRD(G,j) do{ if(G){ kload2(kf,kp0+sl_next,j); SBAR(); } }while(0)
  #define STEP(C0,C1,P0,P1,t,GK,GV,GL) do{ SBAR(); MLOAD(t); \
    const lds_cptr vp_=vp0+sl_prev; \
    VRD(0); SBAR(); float sacc=(P0[0]+P0[1]); \
    GAPA(C0=__builtin_amdgcn_mfma_f32_32x32x16_bf16(kf[0],qr[0],negm,0,0,0), P0[2],P0[3],P0[4],P0[5],     pw0[0]=PKW(P0,0), pw0[1]=PKW(P0,2), pw0); \
    VRD(4); SBAR(); GAPA(C1=__builtin_amdgcn_mfma_f32_32x32x16_bf16(kf[1],qr[0],negm,0,0,0), P0[6],P0[7],P0[8],P0[9],     pw0[2]=PKW(P0,4), pw0[3]=PKW(P0,6), pw0); \
    VRD(1); SBAR(); GAPA(C0=__builtin_amdgcn_mfma_f32_32x32x16_bf16(kf[2],qr[1],C0,0,0,0),   P0[10],P0[11],P0[12],P0[13], pw1[0]=PKW(P0,8), pw1[1]=PKW(P0,10), pw1); \
    VRD(5); SBAR(); GAPA(C1=__builtin_amdgcn_mfma_f32_32x32x16_bf16(kf[3],qr[1],C1,0,0,0),   P0[14],P0[15],P1[0],P1[1],   pw1[2]=PKW(P0,12),pw1[3]=PKW(P0,14), pw1); \
    VRD(2); SBAR(); GAPA(C0=__builtin_amdgcn_mfma_f32_32x32x16_bf16(kf[4],qr[2],C0,0,0,0),   P1[2],P1[3],P1[4],P1[5],     pw2[0]=PKW(P1,0), pw2[1]=PKW(P1,2), pw2); \
    VRD(6); SBAR(); GAPA(C1=__builtin_amdgcn_mfma_f32_32x32x16_bf16(kf[5],qr[2],C1,0,0,0),   P1[6],P1[7],P1[8],P1[9],     pw2[2]=PKW(P1,4), pw2[3]=PKW(P1,6), pw2); \
    VRD(3); SBAR(); GAPA(C0=__builtin_amdgcn_mfma_f32_32x32x16_bf16(kf[6],qr[3],C0,0,0,0),   P1[10],P1[11],P1[12],P1[13], pw3[0]=PKW(P1,8), pw3[1]=PKW(P1,10), pw3); \
    VRD(7); SBAR(); GAPA(C1=__builtin_amdgcn_mfma_f32_32x32x16_bf16(kf[7],qr[3],C1,0,0,0),   P1[14],P1[15],0.f,0.f,       pw3[2]=PKW(P1,12),pw3[3]=PKW(P1,14), pw3); \
    l_reg+=sacc; \
    MSHIFT(); if(GK){DMA_K((t)+3,sl_cur);} if(GV){DMA_V((t)+1,sl_next);} \
    CMASK(C0,C1,t); \
    { float a=MX3(C0[0],C0[1],C1[0]),b=MX3(C0[2],C0[3],C1[1]); a=MX3(a,C1[2],C1[3]); \
      _Pragma("unroll") for(int r=4;r<16;r+=4){a=MX3(a,C0[r],C0[r+1]);b=MX3(b,C0[r+2],C0[r+3]);a=MX3(a,C1[r],C1[r+1]);b=MX3(b,C1[r+2],C1[r+3]);} \
      float rm=__builtin_fmaxf(a,b); { auto rr=__builtin_amdgcn_permlane32_swap(__float_as_uint(rm),__float_as_uint(rm),false,false); rm=__builtin_fmaxf(__uint_as_float(rr[0]),__uint_as_float(rr[1])); } \
      resc=false; \
      if(__builtin_expect(__any(rm>(float)THRL),0)){ const float dl=__builtin_fmaxf(rm,0.f); mhat+=dl; \
        _Pragma("unroll") for(int r=0;r<16;++r){C0[r]-=dl;C1[r]-=dl;} \
        _Pragma("unroll") for(int r=0;r<16;++r)negm[r]=-mhat; asm volatile("":"+v"(negm)); \
        const float f=__builtin_amdgcn_exp2f(-dl); l_reg*=f; if(hi==0)wsf[r32]=f; resc=true; } } \
    SBAR(); \
    GAPB(o[0]=__builtin_amdgcn_mfma_f32_32x32x16_bf16(PAF(0),VFR(0),o[0],0,0,0), C0,0,mw0); \
    GAPB(o[1]=__builtin_amdgcn_mfma_f32_32x32x16_bf16(PAF(0),VFR(4),o[1],0,0,0), C0,4,mw0); \
    KRD(GL,0); GAPB(o[0]=__builtin_amdgcn_mfma_f32_32x32x16_bf16(PAF(1),VFR(1),o[0],0,0,0), C0,8,mw0); \
    KRD(GL,1); GAPB(o[1]=__builtin_amdgcn_mfma_f32_32x32x16_bf16(PAF(1),VFR(5),o[1],0,0,0), C0,12,mw0); \
    KRD(GL,2); GAPB(o[0]=__builtin_amdgcn_mfma_f32_32x32x16_bf16(PAF(2),VFR(2),o[0],0,0,0), C1,0,mw1); \
    KRD(GL,3); GAPB(o[1]=__builtin_amdgcn_mfma_f32_32x32x16_bf16(PAF(2),VFR(6),o[1],0,0,0), C1,4,mw1); \
    GAPB(o[0]=__builtin_amdgcn_mfma_f32_32x32x16_bf16(PAF(3),VFR(3),o[0],0,0,0), C1,8,mw1); \
    GAPB(o[1]=__builtin_amdgcn_mfma_f32_32x32x16_bf16(PAF(3),VFR(7),o[1],0,0,0), C1,12,mw1); \
    }while(0)
  int t=1;
  #undef CMASK
  #define CMASK(P0,P1,t) do{}while(0)
  for(;t+5<NT;t+=2){
    STEP(pB0,pB1,pA0,pA1,t,true,true,true);     WAIT_BAR(2); RESC(); ROT();
    STEP(pA0,pA1,pB0,pB1,t+1,true,true,true);   WAIT_BAR(2); RESC(); ROT();
  }
  #undef CMASK
  #define CMASK(P0,P1,t) do{int jb_=(t)-(NT-4); if(jb_>=0)cmask(P0,P1,jb_,qrel,hi);}while(0)
  #define ENDW(tt) do{ if((tt)+3<NT){WAIT_BAR(2);} else if((tt)+2<NT){WAIT_BAR(1);} else {WAIT_BAR(0);} }while(0)
  for(;t+1<NT;t+=2){
    STEP(pB0,pB1,pA0,pA1,t,(t+3<NT),(t+1<NT),(t+1<NT));       ENDW(t);   RESC(); ROT();
    STEP(pA0,pA1,pB0,pB1,t+1,(t+4<NT),(t+2<NT),(t+2<NT));     ENDW(t+1); RESC(); ROT();
  }
  STEP(pB0,pB1,pA0,pA1,NT-1,false,false,false); RESC();
  { float sacc=pB0[0]+pB0[1]; _Pragma("unroll") for(int r=2;r<16;++r)sacc+=pB0[r]; _Pragma("unroll") for(int r=0;r<16;++r)sacc+=pB1[r]; l_reg+=sacc;
    pw0=(u32x4){PKW(pB0,0),PKW(pB0,2),PKW(pB0,4),PKW(pB0,6)};pw1=(u32x4){PKW(pB0,8),PKW(pB0,10),PKW(pB0,12),PKW(pB0,14)};pw2=(u32x4){PKW(pB1,0),PKW(pB1,2),PKW(pB1,4),PKW(pB1,6)};pw3=(u32x4){PKW(pB1,8),PKW(pB1,10),PKW(pB1,12),PKW(pB1,14)};
    SBAR(); pv(o,vb0+sl_cur,PAF(0),PAF(1),PAF(2),PAF(3)); }
  #undef PKW
  #undef PAF
  #undef VFR
  #undef PIN
  #undef MX3
  #undef GAPA
  #undef GAPB
  #undef EX
  #undef VRD
  #undef KRD
  #undef STEP
  #undef ENDW
  {auto rr=__builtin_amdgcn_permlane32_swap(__float_as_uint(l_reg),__float_as_uint(l_reg),false,false);l_reg=__uint_as_float(rr[0])+__uint_as_float(rr[1]);}
  if(hi==0)wsf[32+r32]=l_reg;asm volatile("s_waitcnt lgkmcnt(0)":::"memory");
  float rli[16];
  #pragma unroll
  for(int r=0;r<16;++r)rli[r]=__builtin_amdgcn_rcpf(wsf[32+crow(r,hi)]);
  bf16*Ow=Oc+(rowbase+q0+wid*QBLK)*DM;
  { bf16*stg=(bf16*)(shm+LDS_OST)+wid*2048;
    #pragma unroll
    for(int r=0;r<16;++r){const int orow=crow(r,hi);
      #pragma unroll
      for(int d0=0;d0<2;++d0)stg[orow*64+d0*32+r32]=__float2bfloat16(o[d0][r]*rli[r]);}
    asm volatile("s_waitcnt lgkmcnt(0)":::"memory");
    #pragma unroll
    for(int i=0;i<4;++i){const int row=i*8+(lane>>3),ch=lane&7; const u32x4 v=*(const u32x4*)(stg+row*64+ch*8); ATTN_STORE16(Ow+(long)row*DM+ch*8,v);} }
  asm volatile("s_waitcnt lgkmcnt(0)\n\ts_barrier":::"memory");
  #undef DMA_K
  #undef DMA_V
  #undef CMASK
  #undef START
  #undef RESC
  #undef ROT
  #undef MLOAD
  #undef MSHIFT
  #undef MBIT
  #undef MAND
}
constexpr int ATTN_LDS_BYTES=LDS_BYTES;
#undef SBAR
#undef WAIT_BAR
}
#define GAS __attribute__((address_space(1)))
#define LAS __attribute__((address_space(3)))
typedef unsigned short bf16;
typedef unsigned v4u __attribute__((ext_vector_type(4)));
typedef float f32x4 __attribute__((ext_vector_type(4)));
typedef short bf16x8 __attribute__((ext_vector_type(8)));
typedef GAS unsigned gu32;
typedef GAS unsigned long long gu64;
#define RLX_AGENT __ATOMIC_RELAXED, __HIP_MEMORY_SCOPE_AGENT
#define LDS_WAIT() asm volatile("s_waitcnt lgkmcnt(0)" ::: "memory")
#define VM_WAIT() asm volatile("s_waitcnt vmcnt(0)" ::: "memory")
__device__ __forceinline__ unsigned long long rt() { return __builtin_amdgcn_s_memrealtime(); }
__device__ __forceinline__ unsigned f2bf(float f) { unsigned u = __builtin_bit_cast(unsigned, f); return (u + 0x7fffu + ((u >> 16) & 1u)) >> 16; }
__device__ __forceinline__ unsigned pk2(float lo, float hi) { return f2bf(lo) | (f2bf(hi) << 16); }

#define XB_TMO      128
#define XB_XCNT(j)  (256  + 64 * (j))
#define XB_XSUB(j)  (1280 + 64 * (j))
#define XB_XGEN(j)  (2304 + 64 * (j))
#define XB_TOP      3328
#define XB_TOPGEN   3392
#define XCD_BAR_WORDS 3456
#define XB_SPIN_CAP (1u << 18)

__device__ __forceinline__ unsigned xb_ld(unsigned* p)              { return __hip_atomic_load(p, __ATOMIC_RELAXED, __HIP_MEMORY_SCOPE_AGENT); }
__device__ __forceinline__ unsigned xb_add(unsigned* p, unsigned v) { return __hip_atomic_fetch_add(p, v, __ATOMIC_RELAXED, __HIP_MEMORY_SCOPE_AGENT); }
__device__ __forceinline__ unsigned xb_xcc_id() { return (unsigned)__builtin_amdgcn_s_getreg((3 << 11) | 20) & 0xFu; }
#define XB_SPIN(cond, bar) do { unsigned _sp = 0; while (cond) { __builtin_amdgcn_s_sleep(1); \
    if ((++_sp & 255u) == 0u) { if (xb_ld(&(bar)[XB_TMO])) break; if (_sp > XB_SPIN_CAP) { atomicAdd(&(bar)[XB_TMO], 1u); break; } } } } while (0)

struct XcdBarrier {
    unsigned* bar; unsigned x;
    volatile LAS unsigned* st;
};

__device__ __forceinline__ XcdBarrier xcd_barrier_post(unsigned* bar, volatile LAS unsigned* st) {
    XcdBarrier b; b.bar = bar; b.x = xb_xcc_id(); b.st = st;
    if (threadIdx.x == 0) (void)xb_add(&bar[XB_XCNT(b.x)], 1u);
    return b;
}
__device__ __forceinline__ void xcd_barrier_complete(unsigned* bar, unsigned x, unsigned& nloc, unsigned& nx) {
    const unsigned G = gridDim.x * gridDim.y * gridDim.z;
    unsigned sum, cnt, mine, sp = 0u;
    for (;;) {
        sum = 0u; cnt = 0u; mine = 0u;
#pragma unroll
        for (unsigned j = 0; j < 16; ++j) { const unsigned c = xb_ld(&bar[XB_XCNT(j)]); sum += c; cnt += (c > 0u) ? 1u : 0u; mine = (j == x) ? c : mine; }
        if (sum == G) break;
        __builtin_amdgcn_s_sleep(1);
        if ((++sp & 255u) == 0u) { if (xb_ld(&bar[XB_TMO])) break; if (sp > XB_SPIN_CAP) { atomicAdd(&bar[XB_TMO], 1u); break; } }
    }
    nloc = mine > 0u ? mine : 1u; nx = cnt > 0u ? cnt : 1u;
}

__device__ __forceinline__ void xcd_barrier(const XcdBarrier& b) {
    asm volatile("s_waitcnt vmcnt(0)" ::: "memory");
    __syncthreads();
    if (threadIdx.x == 0) {
        unsigned* bar = b.bar;
        __builtin_amdgcn_s_waitcnt(0);
        unsigned nloc = b.st[0], nx = b.st[1];
        if (nloc == 0u) { xcd_barrier_complete(bar, b.x, nloc, nx); b.st[0] = nloc; b.st[1] = nx; }
        const unsigned old = xb_add(&bar[XB_XSUB(b.x)], 1u);
        const unsigned gen = old / nloc;
        if (old + 1u == (gen + 1u) * nloc) {
            __builtin_amdgcn_fence(__ATOMIC_RELEASE, "agent");
            asm volatile("s_waitcnt vmcnt(0)" ::: "memory");
            const unsigned og = xb_add(&bar[XB_TOP], 1u);
            const unsigned tg = og / nx;
            if (og + 1u == (tg + 1u) * nx) xb_add(&bar[XB_TOPGEN], 1u);
            else XB_SPIN(xb_ld(&bar[XB_TOPGEN]) == tg, bar);
            __builtin_amdgcn_fence(__ATOMIC_ACQUIRE, "agent");
            xb_add(&bar[XB_XGEN(b.x)], 1u);
            asm volatile("s_waitcnt vmcnt(0)" ::: "memory");
        } else {
            XB_SPIN(xb_ld(&bar[XB_XGEN(b.x)]) == gen, bar);
            __builtin_amdgcn_fence(__ATOMIC_ACQUIRE, "agent");
            asm volatile("s_waitcnt vmcnt(0)" ::: "memory");
        }
    }
    __syncthreads();
}
namespace topk {
#define TK_LAS __attribute__((address_space(3)))
typedef short bf16x8 __attribute__((ext_vector_type(8)));
typedef float f32x16 __attribute__((ext_vector_type(16)));
typedef float f32x4 __attribute__((ext_vector_type(4)));
typedef unsigned u32x4 __attribute__((ext_vector_type(4)));
typedef unsigned short bf16_t;
constexpr int KSEL = 256;
__device__ __forceinline__ int crow0(int r) { return (r & 3) + 8 * (r >> 2); }
__device__ __forceinline__ unsigned half_sum(unsigned c) { auto rr = __builtin_amdgcn_permlane32_swap(c, c, false, false); return rr[0] + rr[1]; }
__device__ __forceinline__ unsigned half_or(unsigned c) { auto rr = __builtin_amdgcn_permlane32_swap(c, c, false, false); return rr[0] | rr[1]; }

__device__ __forceinline__ void unit(int b, int g, const bf16_t* __restrict__ IQ, const bf16_t* __restrict__ IK, const float* __restrict__ IW, unsigned* __restrict__ MASK, TK_LAS unsigned char* lds) {
    int tid_ = threadIdx.x; asm volatile("" : "+v"(tid_));
    const int tid = tid_, lane = tid & 63, r32 = lane & 31, hi = lane >> 5;
    const int w = __builtin_amdgcn_readfirstlane(tid >> 6);
    const int nt = g / 2 + 1;
    const int ntb = 4 * (g / 8) + 4;
    const int q = 32 * g + r32;
    const size_t rowq = (size_t)b * 2048 + q;
    const bool dotopk = (g >= 8);
    TK_LAS unsigned* cnt = (TK_LAS unsigned*)lds;
    TK_LAS unsigned* flag = (TK_LAS unsigned*)(lds + 2048);
    unsigned key[4][2][16];
    unsigned T = 0u, X = 2047u;
    if (dotopk) {
        if (tid == 0) flag[0] = 0u;
        const f32x4 wq = *(const f32x4*)(IW + rowq * 4);
#pragma unroll
        for (int jj = 0; jj < 4; ++jj) {
            const int tile = w + 8 * jj;
            if (tile < nt) {
#pragma unroll
                for (int p = 0; p < 2; ++p) {
                    const bf16_t* kp = IK + ((size_t)b * 2048 + 64 * tile + 32 * p + r32) * 64 + hi * 8;
                    bf16x8 kf[4];
#pragma unroll
                    for (int d0 = 0; d0 < 4; ++d0) kf[d0] = *(const bf16x8*)(kp + d0 * 16);
                    f32x16 s = {0.f, 0.f, 0.f, 0.f, 0.f, 0.f, 0.f, 0.f, 0.f, 0.f, 0.f, 0.f, 0.f, 0.f, 0.f, 0.f};
#pragma unroll 1
                    for (int h = 0; h < 4; ++h) {
                        const bf16_t* qp = IQ + rowq * 256 + h * 64 + hi * 8;
                        bf16x8 qf[4];
#pragma unroll
                        for (int d0 = 0; d0 < 4; ++d0) qf[d0] = *(const bf16x8*)(qp + d0 * 16);
                        f32x16 pp = {0.f, 0.f, 0.f, 0.f, 0.f, 0.f, 0.f, 0.f, 0.f, 0.f, 0.f, 0.f, 0.f, 0.f, 0.f, 0.f};
#pragma unroll
                        for (int d0 = 0; d0 < 4; ++d0) pp = __builtin_amdgcn_mfma_f32_32x32x16_bf16(kf[d0], qf[d0], pp, 0, 0, 0);
                        const float wh = (h == 0) ? wq.x : (h == 1) ? wq.y : (h == 2) ? wq.z : wq.w;
#pragma unroll
                        for (int r = 0; r < 16; ++r) s[r] = __builtin_fmaf(wh, __builtin_fmaxf(pp[r], 0.f), s[r]);
                    }
#pragma unroll
                    for (int r = 0; r < 16; ++r) { const unsigned uu = __float_as_uint(s[r] + 0.f); key[jj][p][r] = uu ^ ((unsigned)((int)uu >> 31) | 0x80000000u); }
                    if (tile == nt - 1) {
#pragma unroll
                        for (int r = 0; r < 16; ++r) { const int kpos = 64 * tile + 32 * p + crow0(r) + 4 * hi; if (kpos > q) key[jj][p][r] = 0u; }
                    }
                }
            } else {
#pragma unroll
                for (int p = 0; p < 2; ++p)
#pragma unroll
                    for (int r = 0; r < 16; ++r) key[jj][p][r] = 0u;
            }
        }
        int par = 0;
        unsigned prefix = 0u, ge = 0u;
#define TK_REDUCE(c, tot) do { const unsigned c_ = half_sum(c); if (hi == 0) cnt[par * 256 + r32 * 8 + w] = c_; __syncthreads(); \
            const u32x4 a_ = *(const TK_LAS u32x4*)(cnt + par * 256 + r32 * 8), b_ = *(const TK_LAS u32x4*)(cnt + par * 256 + r32 * 8 + 4); \
            tot = ((a_.x + a_.y) + (a_.z + a_.w)) + ((b_.x + b_.y) + (b_.z + b_.w)); par ^= 1; } while (0)
        for (int bit = 31; bit >= 0; --bit) {
            const unsigned cand = prefix | (1u << bit);
            unsigned c = 0u;
#pragma unroll
            for (int jj = 0; jj < 4; ++jj) if (w + 8 * jj < nt) {
#pragma unroll
                for (int p = 0; p < 2; ++p)
#pragma unroll
                    for (int r = 0; r < 16; ++r) c += (key[jj][p][r] >= cand) ? 1u : 0u;
            }
            unsigned tot; TK_REDUCE(c, tot);
            if (tot >= (unsigned)KSEL) { prefix = cand; ge = tot; }
        }
        T = prefix;
        if (ge != (unsigned)KSEL) flag[0] = 1u;
        __syncthreads();
        const bool tie = flag[0] != 0u;
        if (tie) {
            unsigned c = 0u;
#pragma unroll
            for (int jj = 0; jj < 4; ++jj) if (w + 8 * jj < nt) {
#pragma unroll
                for (int p = 0; p < 2; ++p)
#pragma unroll
                    for (int r = 0; r < 16; ++r) c += (key[jj][p][r] == T) ? 1u : 0u;
            }
            unsigned ceq; TK_REDUCE(c, ceq);
            const unsigned need = (unsigned)KSEL - (ge - ceq);
            unsigned px = 0u;
            for (int bit = 10; bit >= 0; --bit) {
                const unsigned cand = px | (1u << bit);
                unsigned c2 = 0u;
#pragma unroll
                for (int jj = 0; jj < 4; ++jj) if (w + 8 * jj < nt) {
#pragma unroll
                    for (int p = 0; p < 2; ++p)
#pragma unroll
                        for (int r = 0; r < 16; ++r) { const unsigned kpos = (unsigned)(64 * (w + 8 * jj) + 32 * p + crow0(r) + 4 * hi); c2 += (key[jj][p][r] == T && kpos < cand) ? 1u : 0u; }
                }
                unsigned tot; TK_REDUCE(c2, tot);
                if (tot < need) px = cand;
            }
            X = px;
        }
#undef TK_REDUCE
    }
#pragma unroll
    for (int jj = 0; jj < 4; ++jj) {
        const int tile = w + 8 * jj;
        if (tile < ntb) {
            unsigned w0 = 0u, w1 = 0u;
            if (tile < nt) {
#pragma unroll
                for (int r = 0; r < 16; ++r) {
                    const int kpos = 64 * tile + crow0(r) + 4 * hi;
                    bool s0, s1;
                    if (dotopk) { const unsigned k0 = key[jj][0][r], k1 = key[jj][1][r];
                        s0 = (k0 > T) || (k0 == T && (unsigned)kpos <= X); s1 = (k1 > T) || (k1 == T && (unsigned)(kpos + 32) <= X); }
                    else { s0 = kpos <= q; s1 = kpos + 32 <= q; }
                    w0 |= (s0 ? 1u : 0u) << crow0(r); w1 |= (s1 ? 1u : 0u) << crow0(r);
                }
                w0 <<= 4 * hi; w1 <<= 4 * hi;
                w0 = half_or(w0); w1 = half_or(w1);
            }
            if (hi == 0) *(uint2*)(MASK + (((size_t)(b * 64 + g) * 32 + tile) * 64 + r32 * 2)) = make_uint2(w0, w1);
        }
    }
    __syncthreads();
}
#undef TK_LAS
}
constexpr int NB = 32, SEQ = 2048, DMODEL = 1024, M = NB * SEQ;
constexpr int NIN = 5632;
constexpr int DIN = 5444;
constexpr int FF = 2816, NF1 = 2 * FF;
constexpr int NLAYER = 2, NPHASE = 1 + 8 * NLAYER;
constexpr float LAM_INIT0 = 0.2f, LAM_INIT1 = 0.35550906759096934f;
#ifndef MK_PER_PHASE
#define MK_PER_PHASE 0
#endif

constexpr size_t MiB = 1u << 20;
constexpr size_t WS_CTL = 0, CTL_ZERO_BYTES = 1 * MiB;
constexpr size_t WS_W = 2 * MiB, W_LAYER = 32 * MiB;
constexpr size_t OFF_IN = 0, OFF_UA = 11 * MiB, OFF_UB = 12 * MiB, OFF_O = 13 * MiB, OFF_F1 = 15 * MiB, OFF_F2 = 26 * MiB;
constexpr size_t WS_SS = 66 * MiB;
constexpr size_t WS_ROPE = 74 * MiB;
constexpr size_t WS_MASK = 90 * MiB, MASK_LAYER = 16 * MiB;
constexpr size_t WS_IW = 122 * MiB, WS_IK = 124 * MiB, WS_IQ = 132 * MiB;
constexpr size_t WS_XB = 164 * MiB;
constexpr size_t WS_AQ = 292 * MiB, WS_AK = 356 * MiB, WS_AV = 420 * MiB, WS_BQ = 484 * MiB, WS_BK = 548 * MiB, WS_BV = 612 * MiB, WS_G = 676 * MiB, WS_END = 932 * MiB;
constexpr size_t WS_YA = WS_AQ, WS_YB = WS_BQ, WS_TMP = WS_AK, WS_MRG = WS_BK, WS_ACT = WS_AQ;
static_assert(WS_ACT + (size_t)M * FF * 2 <= WS_G, "ACT overlay must stay clear of the gates");

constexpr int NWAVES = 8;
constexpr int RING_BYTES = 131072, LDSCTL_OFF = RING_BYTES, MISC_OFF = LDSCTL_OFF + 320, LDS_BYTES = 147456;
constexpr int CW_BAR = 4096;

__device__ __forceinline__ void tr_item(const float* __restrict__ W, int Nsrc, int k0, int c0, int nv, const float* __restrict__ gain, bf16* __restrict__ WT, int K, int p0, LAS float* scr, int lane) {
    const int j = lane & 31;
#pragma unroll 8
    for (int i = 0; i < 32; ++i) { const int kk = 2 * i + (lane >> 5); float v = (j < nv) ? W[(size_t)(k0 + kk) * Nsrc + c0 + j] : 0.f; if (gain) v *= gain[k0 + kk]; scr[kk * 33 + j] = v; }
    LDS_WAIT(); asm volatile("" ::: "memory");
    const int c = lane & 7;
#pragma unroll
    for (int jj = 0; jj < 4; ++jj) { const int n = (lane >> 3) + 8 * jj; const LAS float* s = scr + (8 * c) * 33 + n;
        v4u o; o.x = pk2(s[0 * 33], s[1 * 33]); o.y = pk2(s[2 * 33], s[3 * 33]); o.z = pk2(s[4 * 33], s[5 * 33]); o.w = pk2(s[6 * 33], s[7 * 33]);
        *(GAS v4u*)(WT + (size_t)(p0 + n) * K + k0 + 8 * c) = o; }
    LDS_WAIT(); asm volatile("" ::: "memory");
}
__device__ __forceinline__ void src_in(int tile, int s, int bj, int& c0, int& nv) {
    const int d0 = 32 * bj; nv = 32;
    if (tile < 2) c0 = (tile * 4 + s) * 64 + d0;
    else if (tile < 4) c0 = 512 + ((tile - 2) * 4 + s) * 64 + d0;
    else if (tile < 6) c0 = 1024 + ((tile - 4) * 4 + s) * 64 + d0;
    else if (tile == 6) c0 = 1536 + s * 64 + d0;
    else if (tile == 7) { if (s == 0) c0 = 1792 + d0; else if (s == 1 && bj == 0) { c0 = 1856; nv = 4; } else { c0 = 0; nv = 0; } }
    else if (tile < 10) c0 = 1860 + ((tile - 8) * 4 + s) * 64 + d0;
    else if (tile < 12) c0 = 2372 + ((tile - 10) * 4 + s) * 64 + d0;
    else if (tile < 14) c0 = 2884 + ((tile - 12) * 4 + s) * 64 + d0;
    else c0 = 3396 + ((tile - 14) * 4 + s) * 64 + d0;
}
__device__ __forceinline__ float wave_sum(float v) {
#pragma unroll
    for (int o = 1; o < 64; o <<= 1) v += __shfl_xor(v, o);
    return v;
}
__constant__ double INV_FREQ[32] = {1.0, 0.7498942093324559, 0.5623413251903491, 0.4216965034285822, 0.31622776601683794, 0.23713737056616552, 0.1778279410038923, 0.1333521432163324, 0.1, 0.07498942093324558,
    0.05623413251903491, 0.042169650342858224, 0.03162277660168379, 0.023713737056616554, 0.01778279410038923, 0.01333521432163324, 0.01, 0.007498942093324558, 0.005623413251903491, 0.004216965034285823,
    0.0031622776601683794, 0.0023713737056616554, 0.0017782794100389228, 0.001333521432163324, 0.001, 0.0007498942093324559, 0.0005623413251903491, 0.00042169650342858224, 0.00031622776601683794,
    0.00023713737056616554, 0.00017782794100389227, 0.0001333521432163324};
__device__ __forceinline__ void sincos_d(double x, float& c, float& s) {
    const double n = __builtin_rint(x * 0.15915494309189535);
    double r = __builtin_fma(-n, 6.283185307179586, x); r = __builtin_fma(-n, 2.4492935982947064e-16, r);
    const double r2 = r * r;
    double ts = r, ss = r, tc = 1.0, cc = 1.0;
#pragma unroll
    for (int k = 1; k <= 14; ++k) { ts *= r2 * (-1.0 / (double)((2 * k) * (2 * k + 1))); ss += ts; tc *= r2 * (-1.0 / (double)((2 * k - 1) * (2 * k))); cc += tc; }
    c = (float)cc; s = (float)ss;
}

struct Args { const float* in[18]; float* out; unsigned char* ws; int ph_lo, ph_hi; };

__device__ __forceinline__ void p0_prologue(unsigned char* ws, LAS unsigned char* ldsb, int vcu, int G, int wave, int lane) {
    LAS float* scr = (LAS float*)(ldsb + wave * 16384);
    const int gw = vcu * NWAVES + wave, NGW = G * NWAVES;
    constexpr int I_IN = 16 * 176, I_U = 8 * 32, I_O = 16 * 32, I_F1 = 16 * 176, I_F2 = 44 * 32, I_L = I_IN + 2 * I_U + I_O + I_F1 + I_F2;
    for (int it = gw; it < NLAYER * I_L; it += NGW) {
        const int l = it / I_L; int r = it - l * I_L;
        unsigned char* wl = ws + WS_W + (size_t)l * W_LAYER;
        if (r < I_IN) { const int kb = r / 176, pb = r - kb * 176, tile = pb >> 3, wb = pb & 7; int c0, nv; src_in(tile, wb & 3, wb >> 2, c0, nv);
            tr_item(epi::lds_inptr(ldsb, 3) + (size_t)l * DMODEL * DIN, DIN, 64 * kb, c0, nv, epi::lds_inptr(ldsb, 2) + l * DMODEL, (bf16*)(wl + OFF_IN), DMODEL, 32 * pb, scr, lane); continue; }
        r -= I_IN;
        if (r < I_U) { const int kb = r >> 5, nb = r & 31; tr_item(epi::lds_inptr(ldsb, 12) + (size_t)l * 512 * 1024, 1024, 64 * kb, 32 * nb, 32, nullptr, (bf16*)(wl + OFF_UA), 512, 32 * nb, scr, lane); continue; }
        r -= I_U;
        if (r < I_U) { const int kb = r >> 5, nb = r & 31; tr_item(epi::lds_inptr(ldsb, 13) + (size_t)l * 512 * 1024, 1024, 64 * kb, 32 * nb, 32, nullptr, (bf16*)(wl + OFF_UB), 512, 32 * nb, scr, lane); continue; }
        r -= I_U;
        if (r < I_O) { const int kb = r >> 5, nb = r & 31; tr_item(epi::lds_inptr(ldsb, 14) + (size_t)l * 1024 * 1024, 1024, 64 * kb, 32 * nb, 32, nullptr, (bf16*)(wl + OFF_O), 1024, 32 * nb, scr, lane); continue; }
        r -= I_O;
        if (r < I_F1) { const int kb = r / 176, pb = r - kb * 176, tile = pb >> 3, wb = pb & 7; const int c0 = 128 * tile + 32 * (wb & 3) + ((wb >> 2) ? FF : 0);
            tr_item(epi::lds_inptr(ldsb, 16) + (size_t)l * DMODEL * NF1, NF1, 64 * kb, c0, 32, epi::lds_inptr(ldsb, 15) + l * DMODEL, (bf16*)(wl + OFF_F1), DMODEL, 32 * pb, scr, lane); continue; }
        r -= I_F1;
        { const int kb = r >> 5, nb = r & 31; tr_item(epi::lds_inptr(ldsb, 17) + (size_t)l * FF * 1024, 1024, 64 * kb, 32 * nb, 32, nullptr, (bf16*)(wl + OFF_F2), FF, 32 * nb, scr, lane); }
    }
#if defined(DBG_FILL)
    { unsigned* fp = (unsigned*)(ws + DBG_FILL); for (size_t i = (size_t)gw * 64 + lane; i < (size_t)32 * MiB; i += (size_t)NGW * 64) fp[i] = 0x3f803f80u + ((unsigned)i & 0x3fu) * 0x00010001u; }
#endif
    const float* x = epi::lds_inptr(ldsb, 0); const int* pos = (const int*)epi::lds_inptr(ldsb, 1);
    bf16* XB = (bf16*)(ws + WS_XB); float* SS0 = (float*)(ws + WS_SS); float* ROPE = (float*)(ws + WS_ROPE);
    for (int m = gw; m < M; m += NGW) {
        const GAS f32x4* xr = (const GAS f32x4*)(x + (size_t)m * DMODEL) + lane;
        f32x4 v[4]; float s = 0.f;
#pragma unroll
        for (int j = 0; j < 4; ++j) { v[j] = xr[64 * j]; s += (v[j].x * v[j].x + v[j].y * v[j].y) + (v[j].z * v[j].z + v[j].w * v[j].w); }
        s = wave_sum(s);
        GAS unsigned long long* o8 = (GAS unsigned long long*)(XB + (size_t)m * DMODEL) + lane;
#pragma unroll
        for (int j = 0; j < 4; ++j) o8[64 * j] = (unsigned long long)pk2(v[j].x, v[j].y) | ((unsigned long long)pk2(v[j].z, v[j].w) << 32);
        if (lane < 16) SS0[(size_t)m * 16 + lane] = (lane == 0) ? s : 0.f;
        if (lane < 32) { const double ang = (double)pos[m] * INV_FREQ[lane]; float c, sn; sincos_d(ang, c, sn); *(float2*)(ROPE + ((size_t)m * 32 + lane) * 2) = make_float2(c, sn); }
    }
}
static_assert(epi::EI_SS == WS_SS && epi::EI_ROPE == WS_ROPE && epi::EI_IW == WS_IW && epi::EI_IK == WS_IK && epi::EI_IQ == WS_IQ && epi::EI_AQ == WS_AQ && epi::EI_AK == WS_AK && epi::EI_AV == WS_AV && epi::EI_BQ == WS_BQ && epi::EI_BK == WS_BK && epi::EI_BV == WS_BV && epi::EI_G == WS_G && epi::PTR_OFF >= MISC_OFF + 128 && epi::PTR_OFF + 18 * 8 <= LDS_BYTES, "EpiIn offsets vs the d_ws / LDS map");
__global__ void __launch_bounds__(NWAVES * 64, 2) mega_fwd(Args args) {
    extern __shared__ __attribute__((aligned(16))) unsigned char lds[];
    LAS unsigned char* ldsb = (LAS unsigned char*)lds;
    volatile LAS unsigned* MISC = (volatile LAS unsigned*)(ldsb + MISC_OFF);
    const int tid = threadIdx.x, lane = tid & 63, wave = __builtin_amdgcn_readfirstlane(tid >> 6);
    const int G = gridDim.x; const int bx = blockIdx.x;
    const int vcu = (G % 8 == 0) ? (bx % 8) * (G / 8) + bx / 8 : bx;
    unsigned char* ws = args.ws;
    gu32* ctl = (gu32*)(ws + WS_CTL);
    for (int u = tid; u < (LDS_BYTES - LDSCTL_OFF) / 4; u += NWAVES * 64) ((LAS unsigned*)(ldsb + LDSCTL_OFF))[u] = 0u;
    __syncthreads();
    XcdBarrier bar; bar.bar = (unsigned*)(ctl + CW_BAR); bar.x = 0; bar.st = nullptr;
    if (!MK_PER_PHASE) bar = xcd_barrier_post((unsigned*)(ctl + CW_BAR), MISC + 8);
#define GRID_BAR() do { if (!MK_PER_PHASE) { XcdBarrier b_ = bar; GAS unsigned* p_ = (GAS unsigned*)b_.bar; asm volatile("" : "+s"(p_)); b_.bar = (unsigned*)p_; xcd_barrier(b_); } } while (0)
    const int lo = args.ph_lo, hi = args.ph_hi;
#ifndef PH_EN
#define PH_EN 0x1ff
#endif
#define PHT(k) ((k) == 0 ? 0 : (((k) - 1) & 7) + 1)
#define IN(k) (((PH_EN >> PHT(k)) & 1) && lo <= (k) && (k) < hi)
#define BOTH(k) (IN(k) && IN((k) + 1))

    if (tid < 18) { const unsigned long long p = (unsigned long long)args.in[tid]; ((LAS unsigned*)(ldsb + epi::PTR_OFF))[2 * tid] = (unsigned)p; ((LAS unsigned*)(ldsb + epi::PTR_OFF))[2 * tid + 1] = (unsigned)(p >> 32); }
    __syncthreads();
#define INP(i) epi::lds_inptr(ldsb, (i))
#define WSL() GAS unsigned char* wsg_ = (GAS unsigned char*)ws; int Gp = G, bxp = bx, vcup = vcu; asm volatile("" : "+s"(wsg_), "+s"(Gp), "+s"(bxp), "+s"(vcup)); unsigned char* wsl = (unsigned char*)wsg_

    if (IN(0)) { int l_ = lane; asm volatile("" : "+v"(l_)); p0_prologue(ws, ldsb, vcu, G, wave, l_); if (BOTH(0)) GRID_BAR(); }

    for (int l = 0; l < NLAYER; ++l) {
        const int pb = 1 + 8 * l;
        if (IN(pb + 0)) {
            WSL();
            pg8::Gemm g{(const bf16*)(wsl + WS_XB), (const bf16*)(wsl + WS_W + (size_t)l * W_LAYER + OFF_IN), M, NIN, DMODEL}; pg8::StaticOrder S; S.init(M, NIN, Gp, bxp);
            epi::EpiIn E{wsl, ldsb, l};
            pg8::gemm_phase<epi::EpiIn, pg8::StaticOrder, true, true>(ldsb, g, S, E);
            if (BOTH(pb + 0)) GRID_BAR();
        }
        if (IN(pb + 1)) {
            WSL();
            const bf16* IQ = (const bf16*)(wsl + WS_IQ); const bf16* IK = (const bf16*)(wsl + WS_IK); const float* IW = (const float*)(wsl + WS_IW); unsigned* MASK = (unsigned*)(wsl + WS_MASK + (size_t)l * MASK_LAYER);
            for (int i = 0;; ++i) { const int L = i * Gp + vcup; if (L >= NB * 64) break;
                const int v = L & 255, ii = L >> 8, b = v >> 3, j = v & 7, g = 16 * (ii >> 1) + ((ii & 1) ? 15 - j : j);
                topk::unit(b, g, IQ, IK, IW, MASK, ldsb); }
            if (BOTH(pb + 1)) GRID_BAR();
        }
        if (IN(pb + 2)) {
#if !defined(NO_A)
            { WSL();
              const attn_body::bf16 *AQ = (const attn_body::bf16*)(wsl + WS_AQ), *AK = (const attn_body::bf16*)(wsl + WS_AK), *AV = (const attn_body::bf16*)(wsl + WS_AV); attn_body::bf16* YA = (attn_body::bf16*)(wsl + WS_YA);
              const unsigned* MASK = (const unsigned*)(wsl + WS_MASK + (size_t)l * MASK_LAYER);
              for (int i = 0;; ++i) { const int L = i * Gp + vcup; if (L >= NB * 64) break;
                const int v = L & 255, qb = L >> 8, b = v >> 3, he = v & 7;
                attn_body::attn_unit<8, true>(b, qb, AQ + he * 64, AK + he * 64, AV + he * 64, YA + he * 64, MASK, (char*)lds); } }
#endif
#if !defined(NO_B)
            { WSL();
              const attn_body::bf16 *BQ = (const attn_body::bf16*)(wsl + WS_BQ), *BK = (const attn_body::bf16*)(wsl + WS_BK), *BV = (const attn_body::bf16*)(wsl + WS_BV); attn_body::bf16* OB = (attn_body::bf16*)(wsl + WS_XB);
              for (int i = 0;; ++i) { const int L = i * Gp + vcup; if (L >= NB * 128) break;
                const int v = L & 255, ii = L >> 8, qb = ii & 7, b = v >> 3, e = 2 * (v & 7) + (ii >> 3), h = e >> 2, c = (e >> 1) & 1, hf = e & 1;
                attn_body::attn_unit<8, false>(b, qb, BQ + (2 * h + c) * 64, BK + (2 * h + c) * 64, BV + h * 128 + hf * 64, OB + (size_t)c * (32u << 20) + h * 128 + hf * 64, nullptr, (char*)lds); } }
#endif
            if (BOTH(pb + 2)) GRID_BAR();
        }
        if (IN(pb + 3)) {
            WSL(); int lane_ = lane; asm volatile("" : "+v"(lane_));
            const bf16 *OB0 = (const bf16*)(wsl + WS_XB), *OB1 = (const bf16*)(wsl + WS_XB + 64 * MiB); bf16* YB = (bf16*)(wsl + WS_YB);
            const float* dl = INP(10) + l * 256; const float* sub = INP(11) + l * 128;
            const float lam_init = (l == 0) ? LAM_INIT0 : LAM_INIT1;
            const float s1 = wave_sum(dl[lane_] * dl[64 + lane_]), s2 = wave_sum(dl[128 + lane_] * dl[192 + lane_]);
            const float lam = expf(s1) - expf(s2) + lam_init;
            const int gw = vcup * NWAVES + wave, NGW = Gp * NWAVES;
            float sg[8];
#pragma unroll
            for (int j = 0; j < 8; ++j) sg[j] = sub[(8 * lane_ + j) & 127] * (1.0f - lam_init);
            for (int m = gw; m < M; m += NGW) {
                const v4u a = *(const GAS v4u*)(OB0 + (size_t)m * 512 + 8 * lane_), bb = *(const GAS v4u*)(OB1 + (size_t)m * 512 + 8 * lane_);
                float d[8] = {epi::bflo(a.x) - lam * epi::bflo(bb.x), epi::bfhi(a.x) - lam * epi::bfhi(bb.x), epi::bflo(a.y) - lam * epi::bflo(bb.y), epi::bfhi(a.y) - lam * epi::bfhi(bb.y),
                              epi::bflo(a.z) - lam * epi::bflo(bb.z), epi::bfhi(a.z) - lam * epi::bfhi(bb.z), epi::bflo(a.w) - lam * epi::bflo(bb.w), epi::bfhi(a.w) - lam * epi::bfhi(bb.w)};
                float q = 0.f;
#pragma unroll
                for (int j = 0; j < 8; ++j) q += d[j] * d[j];
                q += __shfl_xor(q, 1); q += __shfl_xor(q, 2); q += __shfl_xor(q, 4); q += __shfl_xor(q, 8);
                const float rn = 1.0f / sqrtf(q * (1.0f / 128.0f) + 1e-6f);
                v4u o; o.x = pk2(d[0] * rn * sg[0], d[1] * rn * sg[1]); o.y = pk2(d[2] * rn * sg[2], d[3] * rn * sg[3]); o.z = pk2(d[4] * rn * sg[4], d[5] * rn * sg[5]); o.w = pk2(d[6] * rn * sg[6], d[7] * rn * sg[7]);
                *(GAS v4u*)(YB + (size_t)m * 512 + 8 * lane_) = o;
            }
            if (BOTH(pb + 3)) GRID_BAR();
        }
        if (IN(pb + 4)) {
            { WSL(); pg8::Gemm g{(const bf16*)(wsl + WS_YA), (const bf16*)(wsl + WS_W + (size_t)l * W_LAYER + OFF_UA), M, DMODEL, 512}; pg8::StaticOrder S; S.init(M, DMODEL, Gp, bxp);
              epi::EpiGate<false> E{(const bf16*)(wsl + WS_G), (bf16*)(wsl + WS_TMP), (bf16*)(wsl + WS_MRG)}; pg8::gemm_phase<epi::EpiGate<false>, pg8::StaticOrder, true, true>(ldsb, g, S, E); }
#if !defined(DBG_NO_UB)
            { WSL(); pg8::Gemm g{(const bf16*)(wsl + WS_YB), (const bf16*)(wsl + WS_W + (size_t)l * W_LAYER + OFF_UB), M, DMODEL, 512}; pg8::StaticOrder S; S.init(M, DMODEL, Gp, bxp);
              epi::EpiGate<true> E{(const bf16*)(wsl + WS_G), (bf16*)(wsl + WS_TMP), (bf16*)(wsl + WS_MRG)}; pg8::gemm_phase<epi::EpiGate<true>, pg8::StaticOrder, true, true>(ldsb, g, S, E); }
#endif
            if (BOTH(pb + 4)) GRID_BAR();
        }
        if (IN(pb + 5)) {
            WSL();
            pg8::Gemm g{(const bf16*)(wsl + WS_MRG), (const bf16*)(wsl + WS_W + (size_t)l * W_LAYER + OFF_O), M, DMODEL, DMODEL}; pg8::StaticOrder S; S.init(M, DMODEL, Gp, bxp);
            epi::EpiRes E{(l == 0) ? INP(0) : (const float*)args.out, args.out, (bf16*)(wsl + WS_XB), (float*)(wsl + WS_SS + 4 * MiB)};
            pg8::gemm_phase<epi::EpiRes, pg8::StaticOrder, true, true>(ldsb, g, S, E);
            if (BOTH(pb + 5)) GRID_BAR();
        }
        if (IN(pb + 6)) {
            WSL();
            pg8::Gemm g{(const bf16*)(wsl + WS_XB), (const bf16*)(wsl + WS_W + (size_t)l * W_LAYER + OFF_F1), M, NF1, DMODEL}; pg8::StaticOrder S; S.init(M, NF1, Gp, bxp);
            epi::EpiSwiglu E{(const float*)(wsl + WS_SS + 4 * MiB), (bf16*)(wsl + WS_ACT)};
            pg8::gemm_phase<epi::EpiSwiglu, pg8::StaticOrder, true, true>(ldsb, g, S, E);
            if (BOTH(pb + 6)) GRID_BAR();
        }
        if (IN(pb + 7)) {
            WSL();
            pg8::Gemm g{(const bf16*)(wsl + WS_ACT), (const bf16*)(wsl + WS_W + (size_t)l * W_LAYER + OFF_F2), M, DMODEL, FF}; pg8::StaticOrder S; S.init(M, DMODEL, Gp, bxp);
            epi::EpiRes E{(const float*)args.out, args.out, (bf16*)(wsl + WS_XB), (float*)(wsl + WS_SS)};
            pg8::gemm_phase<epi::EpiRes, pg8::StaticOrder, true, true>(ldsb, g, S, E);
            if (BOTH(pb + 7)) GRID_BAR();
        }
    }
#undef INP
#undef WSL
#undef IN
#undef BOTH
#undef GRID_BAR
}


#if defined(DBG_STOP)
struct DumpArgs { const unsigned short* p[16]; unsigned long long n[16]; float* out; int nb; int pad; };
__global__ void dbg_dump(DumpArgs d) {
    const size_t i0 = (size_t)blockIdx.x * blockDim.x + threadIdx.x, stride = (size_t)gridDim.x * blockDim.x;
    for (size_t i = i0; i < (size_t)M * DMODEL; i += stride) { float s = 0.f;
        for (int b = 0; b < d.nb; ++b) { const unsigned short w = d.p[b][i % d.n[b]]; float f = __uint_as_float((unsigned)w << 16); if (!(f == f) || fabsf(f) > 1e30f) f = 12345.f; s += f; }
        d.out[i] = s; }
}
#endif
extern "C" void kernel_launch(void* const* d_in, const int* in_sizes, int n_in, void* d_out, int out_size, void* d_ws, size_t ws_size, hipStream_t stream) {
    static int grid = 0;
    if (grid == 0) {
        if (n_in != 18 || in_sizes[0] != M * DMODEL || out_size != M * DMODEL || ws_size < WS_END) { fprintf(stderr, "kernel_launch: unexpected shapes (n_in %d, in0 %d, out %d, ws %zu)\n", n_in, n_in > 0 ? in_sizes[0] : -1, out_size, ws_size); grid = -1; return; }
        int dev = 0, cus = 0, per_cu = 0;
        if (hipGetDevice(&dev) != hipSuccess || hipDeviceGetAttribute(&cus, hipDeviceAttributeMultiprocessorCount, dev) != hipSuccess) { grid = -1; return; }
        if (hipFuncSetAttribute((const void*)mega_fwd, hipFuncAttributeMaxDynamicSharedMemorySize, LDS_BYTES) != hipSuccess) { fprintf(stderr, "kernel_launch: hipFuncSetAttribute failed\n"); grid = -1; return; }
        if (hipOccupancyMaxActiveBlocksPerMultiprocessor(&per_cu, (const void*)mega_fwd, NWAVES * 64, LDS_BYTES) != hipSuccess || per_cu < 1) fprintf(stderr, "kernel_launch: occupancy query reports %d\n", per_cu);
        (void)hipGetLastError();
        grid = cus;
    }
    if (grid < 0) return;
    if (hipMemsetAsync((char*)d_ws + WS_CTL, 0, CTL_ZERO_BYTES, stream) != hipSuccess) return;
    Args a{};
    for (int i = 0; i < 18; ++i) a.in[i] = (const float*)d_in[i];
    a.out = (float*)d_out; a.ws = (unsigned char*)d_ws;
#if defined(DBG_STOP)
    for (int p = 0; p < DBG_STOP; ++p) { a.ph_lo = p; a.ph_hi = p + 1; hipLaunchKernelGGL(mega_fwd, dim3(grid), dim3(NWAVES * 64), LDS_BYTES, stream, a); }
    { DumpArgs d{}; unsigned char* w = (unsigned char*)d_ws; int n = 0;
      const size_t offs[] = {DBG_BUFS}; const size_t lens[] = {DBG_LENS};
      for (size_t q = 0; q < sizeof(offs) / sizeof(offs[0]); ++q) { d.p[n] = (const unsigned short*)(w + offs[q]); d.n[n] = lens[q] / 2; ++n; }
      d.out = (float*)d_out; d.nb = n; hipLaunchKernelGGL(dbg_dump, dim3(2048), dim3(256), 0, stream, d); }
#elif MK_PER_PHASE
    for (int p = 0; p < NPHASE; ++p) { a.ph_lo = p; a.ph_hi = p + 1; hipLaunchKernelGGL(mega_fwd, dim3(grid), dim3(NWAVES * 64), LDS_BYTES, stream, a); }
#else
    a.ph_lo = 0; a.ph_hi = NPHASE;
    hipLaunchKernelGGL(mega_fwd, dim3(grid), dim3(NWAVES * 64), LDS_BYTES, stream, a);
#endif
    const hipError_t le = hipPeekAtLastError();
    if (le != hipSuccess) fprintf(stderr, "kernel_launch: launch failed: %s\n", hipGetErrorName(le));
}
```

```cpp
#include <hip/hip_runtime.h>
#include <cstdio>
#include <cstdint>
namespace pg8 {
#define PG8_LAS __attribute__((address_space(3)))
typedef unsigned short bf16_t;
typedef short bf16x8 __attribute__((ext_vector_type(8)));
typedef float f32x4 __attribute__((ext_vector_type(4)));
typedef unsigned u32x4 __attribute__((ext_vector_type(4)));
constexpr int BM = 256, BK = 64, HALF = 128, HTB = HALF * BK * 2  , STAGE_BYTES = 8 * HTB, NXCD = 8, WGM = 8;

__host__ __device__ __forceinline__ int lds_byte(int r, int c) { const int st = (r >> 4) * 2 + (c >> 5), rr = r & 15, cc = c & 31, ob = rr * 64 + cc * 2; return st * 1024 + (ob ^ (((ob >> 9) & 1) << 5)); }
__host__ __device__ __forceinline__ void stage_rc(int b, int& R, int& C) { const int st = b / 1024, sb = b % 1024, swz = sb ^ (((sb >> 9) & 1) << 5); R = (st >> 1) * 16 + swz / 64; C = (st & 1) * 32 + (swz % 64) / 2; }
__host__ __device__ __forceinline__ int perm32(int rho) { const int n = rho >> 4, i = rho & 15; return 8 * (i >> 2) + 4 * n + (i & 3); }

struct Unit { int pm, pn; };
struct Gemm { const bf16_t* A; const bf16_t* Bt; int M, N, K; const bf16_t* A2 = nullptr; int nsplit = 1 << 30; int serp = 0; };

struct StaticOrder {
    int nM, nN, nwg, G, c;
    __host__ __device__ void init(int M, int N, int G_, int c_) { nM = M / BM; nN = N / BM; nwg = nM * nN; G = G_; c = c_; }
    __host__ __device__ bool next(int i, Unit& u) const {
        const long L = (long)i * G + c; if (L >= nwg) return false;
        int wgid = (int)L; { const int q = nwg / NXCD, r = nwg % NXCD, xcd = wgid % NXCD, off = wgid / NXCD; wgid = (xcd < r ? xcd * (q + 1) : r * (q + 1) + (xcd - r) * q) + off; }
        const int nig = WGM * nN, gid = wgid / nig, fm = gid * WGM, gsz = (nM - fm) < WGM ? (nM - fm) : WGM;
        u.pm = fm + ((wgid % nig) % gsz); u.pn = (wgid % nig) / gsz; return true;
    }
    __device__ __forceinline__ void a_ready(const Unit&) const {}
    __device__ __forceinline__ void done(const Unit&) const {}
};

struct PairOrder {
    StaticOrder s;
    __host__ __device__ void init(int M, int N, int G_, int c_) { s.init(M, N, G_, c_); }
    __host__ __device__ bool next(int i, Unit& u) const { if (!s.next(i >> 1, u)) return false; u.pn += (i & 1) * s.nN; return true; }
    __device__ __forceinline__ void a_ready(const Unit&) const {}
    __device__ __forceinline__ void done(const Unit&) const {}
};

__device__ __forceinline__ unsigned cvt_pk_bf16(float lo, float hi) { unsigned r; asm volatile("v_cvt_pk_bf16_f32 %0, %1, %2" : "=v"(r) : "v"(lo), "v"(hi)); return r; }
typedef float f32x2 __attribute__((ext_vector_type(2)));
template <int N> __device__ __forceinline__ void pg8_wait_vm() { asm volatile("s_waitcnt vmcnt(%0)" :: "n"(N) : "memory"); }
__device__ __forceinline__ void pg8_wait_vm_relaxed(int rl) { if (rl >= 48) pg8_wait_vm<56>(); else if (rl >= 40) pg8_wait_vm<48>(); else if (rl >= 32) pg8_wait_vm<40>(); else if (rl >= 24) pg8_wait_vm<32>(); else if (rl >= 16) pg8_wait_vm<24>(); else pg8_wait_vm<8>(); }
__device__ __forceinline__ int pg8_lane_id() { int l; asm volatile("v_mbcnt_lo_u32_b32 %0, -1, 0\n\tv_mbcnt_hi_u32_b32 %0, -1, %0" : "=v"(l)); return l; }
template <class Epi, class Sched, bool ALIGN_EPI = false, bool SP2 = false>
__device__ __forceinline__ void gemm_phase(PG8_LAS unsigned char* lds, const Gemm g, const Sched& S, const Epi& E, const int wave_in  ) {
    int tid_ = wave_in * 64 + pg8_lane_id();
    const int tid = tid_, wid = __builtin_amdgcn_readfirstlane(tid >> 6), lane = tid & 63, wr = wid >> 2, wc = wid & 3, fr = lane & 15, fq = lane >> 4;
    const int K = g.K, nt = K / BK;
    unsigned voffA[2], voffB[2];
#pragma unroll
    for (int i = 0; i < 2; ++i) { int R, C; stage_rc(tid * 16 + i * 8192, R, C); const int Rb = Epi::PERM ? ((R & ~31) + perm32(R & 31)) : R;
        voffA[i] = (unsigned)(R * K + C) * 2u; voffB[i] = (unsigned)(Rb * K + C) * 2u; }
    const size_t kstep = (size_t)(BK * 2);
    const size_t hstep = (size_t)HALF * K * 2;
    const size_t tstep = 2 * hstep;
    const unsigned ldsw = (unsigned)wid * 1024u;
    const int aoff = lds_byte(wr * 64 + fr, fq * 8), boff = lds_byte(wc * 32 + fr, fq * 8);
#define PG8_SA(b, h) (((b) * 2 + (h)) * HTB)
#define PG8_SB(b, h) ((4 + (b) * 2 + (h)) * HTB)
#define PG8_STAGE(bufoff, gbase, voff) do { _Pragma("unroll") for (int _i = 0; _i < 2; ++_i) \
        __builtin_amdgcn_global_load_lds((const unsigned*)((const char*)(gbase) + (voff)[_i]), (PG8_LAS unsigned*)(lds + (bufoff) + ldsw + _i * 8192), 16, 0, 0); } while (0)
#define PG8_LDA(dst, b, h) do { _Pragma("unroll") for (int m = 0; m < 4; ++m) _Pragma("unroll") for (int k = 0; k < 2; ++k) dst[m][k] = *(const PG8_LAS bf16x8*)(lds + PG8_SA(b, h) + aoff + m * 2048 + k * 1024); } while (0)
#define PG8_LDB(dst, b, h) do { _Pragma("unroll") for (int n = 0; n < 2; ++n) _Pragma("unroll") for (int k = 0; k < 2; ++k) dst[n][k] = *(const PG8_LAS bf16x8*)(lds + PG8_SB(b, h) + boff + n * 2048 + k * 1024); } while (0)
#define PG8_MMA(ai, bj, At, Bt) do { __builtin_amdgcn_s_setprio(1); _Pragma("unroll") for (int m = 0; m < 4; ++m) _Pragma("unroll") for (int n = 0; n < 2; ++n) _Pragma("unroll") for (int k = 0; k < 2; ++k) \
        acc[ai][bj][m][n] = __builtin_amdgcn_mfma_f32_16x16x32_bf16(Bt[n][k], At[m][k], acc[ai][bj][m][n], 0, 0, 0); __builtin_amdgcn_s_setprio(0); } while (0)
#define PG8_WAIT_V(n) asm volatile("s_waitcnt vmcnt(" #n ")" ::: "memory")
#define PG8_WAIT_V_RLX(flag) asm volatile("s_cmp_eq_u32 %0, 0\n\ts_cbranch_scc1 1f\n\ts_waitcnt vmcnt(%1)\n\ts_branch 2f\n1:\n\ts_waitcnt vmcnt(8)\n2:" :: "s"(__builtin_amdgcn_readfirstlane(flag)), "n"(8 + Epi::VMEM_MIN) : "memory", "scc")
#define PG8_WAIT_L(n) asm volatile("s_waitcnt lgkmcnt(" #n ")" ::: "memory")
#define PG8_BAR __builtin_amdgcn_s_barrier()
#define PG8_SCHED __builtin_amdgcn_sched_barrier(0)
    Unit cur, nxt; int ui = 0;
    if (!S.next(0, cur)) return;
    f32x4 acc[2][2][4][2];
#pragma unroll
    for (int a = 0; a < 2; ++a)
#pragma unroll
        for (int b = 0; b < 2; ++b)
#pragma unroll
            for (int m = 0; m < 4; ++m)
#pragma unroll
                for (int n = 0; n < 2; ++n) acc[a][b][m][n] = (f32x4){0.f, 0.f, 0.f, 0.f};
    bf16x8 At[4][2], B0[2][2], B1[2][2];
    const long kfwd = (long)kstep, kend = (long)(nt - 1) * (long)kstep; long ck = kfwd;
    const char* cA = (const char*)(cur.pn >= g.nsplit ? g.A2 : g.A) + (size_t)cur.pm * tstep; const char* cB = (const char*)g.Bt + (size_t)cur.pn * tstep;
    S.a_ready(cur);
    if constexpr (SP2) {
        PG8_STAGE(PG8_SB(0, 0), cB, voffB); PG8_STAGE(PG8_SB(0, 1), cB + hstep, voffB); PG8_STAGE(PG8_SA(0, 0), cA, voffA); PG8_STAGE(PG8_SA(0, 1), cA + hstep, voffA);
        if (wr == 1) PG8_BAR;
        PG8_WAIT_V(2); PG8_BAR;
        PG8_STAGE(PG8_SB(1, 0), cB + kstep, voffB); PG8_STAGE(PG8_SA(1, 0), cA + kstep, voffA); PG8_STAGE(PG8_SB(1, 1), cB + hstep + kstep, voffB);
        PG8_WAIT_V(6); PG8_BAR;
    } else {
        PG8_STAGE(PG8_SB(0, 0), cB, voffB); PG8_STAGE(PG8_SA(0, 0), cA, voffA); PG8_STAGE(PG8_SB(0, 1), cB + hstep, voffB); PG8_STAGE(PG8_SA(0, 1), cA + hstep, voffA);
        if (wr == 1) PG8_BAR;
        PG8_WAIT_V(4); PG8_BAR;
        PG8_STAGE(PG8_SB(1, 0), cB + kstep, voffB); PG8_STAGE(PG8_SA(1, 0), cA + kstep, voffA); PG8_STAGE(PG8_SB(1, 1), cB + hstep + kstep, voffB);
        PG8_WAIT_V(6); PG8_BAR;
    }
    for (;;) {
        const bool has_next = S.next(ui + 1, nxt);
        const bool nrev = has_next && g.serp && (((ui + 1) & 1) != 0);
        const long nk = has_next ? (nrev ? -kfwd : kfwd) : ck;
        const char* nA = has_next ? (const char*)(nxt.pn >= g.nsplit ? g.A2 : g.A) + (size_t)nxt.pm * tstep + (nrev ? kend : 0) : cA; const char* nB = has_next ? (const char*)g.Bt + (size_t)nxt.pn * tstep + (nrev ? kend : 0) : cB;
        for (int t = 0; t < nt; t += 2) {
            const bool last = (t == nt - 2);
            const char* a1 = cA + (long)(t + 1) * ck;
            const char* a2 = last ? nA : cA + (long)(t + 2) * ck; const char* b2 = last ? nB : cB + (long)(t + 2) * ck;
            const long k3 = last ? nk : ck; const char* a3 = a2 + k3; const char* b3 = b2 + k3;
            if (last && has_next) S.a_ready(nxt);
            if constexpr (SP2) {
            const int rlx = (t == 0 && ui > 0) ? 1 : 0;
            PG8_LDB(B0, 0, 0); PG8_LDB(B1, 0, 1); PG8_SCHED; PG8_LDA(At, 0, 0); PG8_STAGE(PG8_SA(1, 1), a1 + hstep, voffA);
            PG8_WAIT_V_RLX(rlx); PG8_WAIT_L(0); PG8_BAR; PG8_MMA(0, 0, At, B0); PG8_MMA(0, 1, At, B1); PG8_BAR; PG8_SCHED;
            PG8_LDA(At, 0, 1); PG8_STAGE(PG8_SB(0, 0), b2, voffB); PG8_STAGE(PG8_SB(0, 1), b2 + hstep, voffB); PG8_STAGE(PG8_SA(0, 0), a2, voffA);
            PG8_WAIT_V_RLX(rlx); PG8_WAIT_L(0); PG8_BAR; PG8_MMA(1, 0, At, B0); PG8_MMA(1, 1, At, B1); PG8_BAR; PG8_SCHED;
            PG8_LDB(B0, 1, 0); PG8_LDB(B1, 1, 1); PG8_SCHED; PG8_LDA(At, 1, 0); PG8_STAGE(PG8_SA(0, 1), a2 + hstep, voffA);
            PG8_WAIT_V(8); PG8_WAIT_L(0); PG8_BAR; PG8_MMA(0, 0, At, B0); PG8_MMA(0, 1, At, B1); PG8_BAR; PG8_SCHED;
            PG8_LDA(At, 1, 1); PG8_STAGE(PG8_SB(1, 0), b3, voffB); PG8_STAGE(PG8_SB(1, 1), b3 + hstep, voffB); PG8_STAGE(PG8_SA(1, 0), a3, voffA);
            PG8_WAIT_V(8); PG8_WAIT_L(0); PG8_BAR; PG8_MMA(1, 0, At, B0); PG8_MMA(1, 1, At, B1); PG8_BAR; PG8_SCHED;
            } else {
            PG8_LDB(B0, 0, 0); PG8_SCHED; PG8_LDA(At, 0, 0); PG8_STAGE(PG8_SA(1, 1), a1 + hstep, voffA);
            PG8_WAIT_L(8); PG8_BAR; PG8_WAIT_L(0); PG8_MMA(0, 0, At, B0); PG8_BAR; PG8_SCHED;
            PG8_LDB(B1, 0, 1); PG8_STAGE(PG8_SB(0, 0), b2, voffB);
            PG8_BAR; PG8_WAIT_L(0); PG8_MMA(0, 1, At, B1); PG8_BAR;
            PG8_LDA(At, 0, 1); PG8_STAGE(PG8_SA(0, 0), a2, voffA);
            PG8_BAR; PG8_WAIT_L(0); PG8_MMA(1, 0, At, B0); PG8_BAR; PG8_SCHED;
            PG8_STAGE(PG8_SB(0, 1), b2 + hstep, voffB);
            PG8_WAIT_V(6); PG8_BAR; PG8_MMA(1, 1, At, B1); PG8_BAR;
            PG8_LDB(B0, 1, 0); PG8_SCHED; PG8_LDA(At, 1, 0); PG8_STAGE(PG8_SA(0, 1), a2 + hstep, voffA);
            PG8_WAIT_L(8); PG8_BAR; PG8_WAIT_L(0); PG8_MMA(0, 0, At, B0); PG8_BAR; PG8_SCHED;
            PG8_LDB(B1, 1, 1); PG8_STAGE(PG8_SB(1, 0), b3, voffB);
            PG8_BAR; PG8_WAIT_L(0); PG8_MMA(0, 1, At, B1); PG8_BAR;
            PG8_LDA(At, 1, 1); PG8_STAGE(PG8_SA(1, 0), a3, voffA);
            PG8_BAR; PG8_WAIT_L(0); PG8_MMA(1, 0, At, B0); PG8_BAR; PG8_SCHED;
            PG8_STAGE(PG8_SB(1, 1), b3 + hstep, voffB);
            PG8_WAIT_V(6); PG8_BAR; PG8_MMA(1, 1, At, B1); PG8_BAR;
            }
        }
        if constexpr (ALIGN_EPI) { if (wr == 0) PG8_BAR; }
        bool keep_acc = false; if constexpr (Epi::CARRY) keep_acc = Epi::carry(cur) && has_next;
        if constexpr (!Epi::AFTER_DRAIN) { (void)E(acc, cur, wr, wc, fr, fq); S.done(cur); }
        if (!has_next) break;
        if (!keep_acc) {
#pragma unroll
        for (int a = 0; a < 2; ++a)
#pragma unroll
            for (int b = 0; b < 2; ++b)
#pragma unroll
                for (int m = 0; m < 4; ++m)
#pragma unroll
                    for (int n = 0; n < 2; ++n) acc[a][b][m][n] = (f32x4){0.f, 0.f, 0.f, 0.f};
        }
        cur = nxt; cA = nA; cB = nB; ck = nk; ++ui;
        if constexpr (ALIGN_EPI) { if (wr == 1) PG8_BAR; }
    }
    PG8_WAIT_V(0);
    if constexpr (!ALIGN_EPI) { if (wr == 0) PG8_BAR; }
    PG8_BAR;
    if constexpr (Epi::AFTER_DRAIN) { E.fused(acc, cur, wr, wc, fr, fq, lds, wid, lane); S.done(cur); }
#undef PG8_SA
#undef PG8_SB
#undef PG8_STAGE
#undef PG8_LDA
#undef PG8_LDB
#undef PG8_MMA
#undef PG8_WAIT_V
#undef PG8_WAIT_V_RLX
#undef PG8_WAIT_L
#undef PG8_BAR
#undef PG8_SCHED
}
}
namespace epi {
using pg8::f32x4; using pg8::u32x4; using pg8::Unit; using pg8::bf16_t;
typedef float f32x2_t __attribute__((ext_vector_type(2))); typedef __bf16 bf16x2_t __attribute__((ext_vector_type(2))); typedef _Float16 h16x2 __attribute__((ext_vector_type(2)));
__device__ __forceinline__ unsigned cvt_pk_bf16(float lo, float hi) { const f32x2_t v = {lo, hi}; const bf16x2_t b = __builtin_convertvector(v, bf16x2_t); return __builtin_bit_cast(unsigned, b); }
constexpr float EPSN = 1e-6f;
constexpr float QSCALE = 0.125f * 1.4426950408889634f;
__device__ __forceinline__ float bflo(unsigned w) { return __uint_as_float(w << 16); }
__device__ __forceinline__ float bfhi(unsigned w) { return __uint_as_float(w & 0xffff0000u); }
__device__ __forceinline__ float swz_xor16(float v) { return __int_as_float(__builtin_amdgcn_ds_swizzle(__float_as_int(v), 0x401F)); }
__device__ __forceinline__ float sum_halves(float v) { auto rr = __builtin_amdgcn_permlane32_swap(__float_as_uint(v), __float_as_uint(v), false, false); return __uint_as_float(rr[0]) + __uint_as_float(rr[1]); }
__device__ __forceinline__ float sum_fq(float v) { v += swz_xor16(v); return sum_halves(v); }
__device__ __forceinline__ void rstd_rows(const float* ss, int rowb, int fq, float (&r)[2][4]) {
    f32x4 a[2][4];
#pragma unroll
    for (int ai = 0; ai < 2; ++ai)
#pragma unroll
        for (int m = 0; m < 4; ++m) a[ai][m] = ((const f32x4*)(ss + (size_t)(rowb + ai * 128 + m * 16) * 16))[fq];
#pragma unroll
    for (int ai = 0; ai < 2; ++ai)
#pragma unroll
        for (int m = 0; m < 4; ++m) { float s = (a[ai][m][0] + a[ai][m][1]) + (a[ai][m][2] + a[ai][m][3]); s = sum_fq(s);
            r[ai][m] = __builtin_amdgcn_rsqf(s * (1.0f / 1024.0f) + EPSN); }
}
__device__ __forceinline__ float sigm(float v) { return __builtin_amdgcn_rcpf(1.0f + __expf(-v)); }

constexpr int PTR_OFF = 131072 + 1024;
__device__ __forceinline__ const float* lds_inptr(PG8_LAS unsigned char* ldsb, int i) {
    const PG8_LAS unsigned* t = (const PG8_LAS unsigned*)(ldsb + PTR_OFF) + 2 * i;
    const unsigned lo = __builtin_amdgcn_readfirstlane(t[0]), hi = __builtin_amdgcn_readfirstlane(t[1]);
    return (const float*)(const __attribute__((address_space(1))) float*)(((unsigned long long)hi << 32) | lo);
}
constexpr size_t EMiB = 1u << 20;
constexpr size_t EI_SS = 66 * EMiB, EI_ROPE = 74 * EMiB, EI_IW = 122 * EMiB, EI_IK = 124 * EMiB, EI_IQ = 132 * EMiB, EI_AQ = 292 * EMiB, EI_AK = 356 * EMiB, EI_AV = 420 * EMiB, EI_BQ = 484 * EMiB, EI_BK = 548 * EMiB, EI_BV = 612 * EMiB, EI_G = 676 * EMiB;
__device__ __forceinline__ void rstd_rows4(const float* ss, int rowh, int fq, float (&r)[4]) {
    f32x4 a[4];
#pragma unroll
    for (int m = 0; m < 4; ++m) a[m] = ((const f32x4*)(ss + (size_t)(rowh + m * 16) * 16))[fq];
#pragma unroll
    for (int m = 0; m < 4; ++m) { float s = (a[m][0] + a[m][1]) + (a[m][2] + a[m][3]); s = sum_fq(s); r[m] = __builtin_amdgcn_rsqf(s * (1.0f / 1024.0f) + EPSN); }
}
constexpr int RSTD_OFF = 131072 + 1024 + 512, RSTD_SLOTS = 8;
template <class Sched> __device__ __forceinline__ void rstd_prepass(PG8_LAS unsigned char* ldsb, const Sched& S, const float* ss, int tid) {
    PG8_LAS int* tab = (PG8_LAS int*)(ldsb + RSTD_OFF); PG8_LAS float* rt = (PG8_LAS float*)(ldsb + RSTD_OFF + 64);
    if (tid == 0) { int n = 0; Unit u;
        for (int i = 0; S.next(i, u); ++i) { bool f = false; for (int k = 0; k < n; ++k) f |= (tab[k] == u.pm); if (!f && n < RSTD_SLOTS) tab[n++] = u.pm; }
        for (int k = n; k < RSTD_SLOTS; ++k) tab[k] = -1; }
    __syncthreads();
    for (int k = 0; k < RSTD_SLOTS; ++k) { const int pm = tab[k]; if (pm < 0) break;
        const int row = pm * 256 + (tid >> 1); const f32x4* p = (const f32x4*)(ss + (size_t)row * 16) + 2 * (tid & 1);
        const f32x4 a = p[0], b = p[1]; float s = ((a[0] + a[1]) + (a[2] + a[3])) + ((b[0] + b[1]) + (b[2] + b[3]));
        s += __int_as_float(__builtin_amdgcn_ds_swizzle(__float_as_int(s), 0x041F));
        if ((tid & 1) == 0) rt[k * 256 + (tid >> 1)] = __builtin_amdgcn_rsqf(s * (1.0f / 1024.0f) + EPSN); }
    __syncthreads();
}
__device__ __forceinline__ const PG8_LAS float* rstd_slot(PG8_LAS unsigned char* ldsb, int pm) {
    const PG8_LAS int* tab = (const PG8_LAS int*)(ldsb + RSTD_OFF); int slot = 0;
#pragma unroll
    for (int k = 1; k < RSTD_SLOTS; ++k) slot = (tab[k] == pm) ? k : slot;
    slot = __builtin_amdgcn_readfirstlane(slot);
    return (const PG8_LAS float*)(ldsb + RSTD_OFF + 64) + slot * 256;
}
__device__ __forceinline__ size_t gate_block(int pm, int t, int wave5, int ai, int mp, int bj5) { return ((size_t)((((pm * 8 + t) * 8 + wave5) * 2 + ai) * 2 + mp) * 2 + bj5) * 1024; }
struct EpiIn {
    static constexpr bool PERM = true, AFTER_DRAIN = false, CARRY = false; static constexpr int VMEM_MIN = 0;
    unsigned char* ws; PG8_LAS unsigned char* ldsb; int layer;
    __device__ __forceinline__ int operator()(const f32x4 (&acc)[2][2][4][2], const Unit& u, int wr, int wc, int fr, int fq) const {
        asm volatile("" : "+v"(fr), "+v"(fq));
        const int pn = u.pn, rowb = u.pm * 256 + wr * 64 + fr;
        const unsigned* rope = (const unsigned*)(ws + EI_ROPE);
        const PG8_LAS float* rt = rstd_slot(ldsb, u.pm) + wr * 64 + fr;
        if (pn >= 14) {
            const int colb = (pn - 14) * 256 + wc * 64 + 8 * fq;
            const float* gbias = lds_inptr(ldsb, 4) + layer * 2048; unsigned char* G8 = ws + EI_G;
            f32x4 bia[2][2];
#pragma unroll
            for (int bj = 0; bj < 2; ++bj)
#pragma unroll
                for (int n = 0; n < 2; ++n) bia[bj][n] = *(const f32x4*)(gbias + colb + 32 * bj + 4 * n);
#pragma unroll
            for (int ai = 0; ai < 2; ++ai) {
#pragma unroll
                for (int mp = 0; mp < 2; ++mp) { uint2 pc[2][2];
#pragma unroll
                  for (int mm = 0; mm < 2; ++mm) { const int m = 2 * mp + mm; const float r = rt[ai * 128 + m * 16];
#pragma unroll
                    for (int bj = 0; bj < 2; ++bj) { f32x4 v0 = acc[ai][bj][m][0] * r + bia[bj][0], v1 = acc[ai][bj][m][1] * r + bia[bj][1];
#pragma unroll
                        for (int i = 0; i < 4; ++i) { v0[i] = __builtin_amdgcn_fmed3f(v0[i], -60.f, 60.f); v1[i] = __builtin_amdgcn_fmed3f(v1[i], -60.f, 60.f); }
                        int w0 = 0, w1 = 0; w0 = __builtin_amdgcn_cvt_pk_fp8_f32(v0[0], v0[1], w0, false); w0 = __builtin_amdgcn_cvt_pk_fp8_f32(v0[2], v0[3], w0, true);
                        w1 = __builtin_amdgcn_cvt_pk_fp8_f32(v1[0], v1[1], w1, false); w1 = __builtin_amdgcn_cvt_pk_fp8_f32(v1[2], v1[3], w1, true);
                        pc[mm][bj] = make_uint2((unsigned)w0, (unsigned)w1); } }
#pragma unroll
                  for (int bj = 0; bj < 2; ++bj) { u32x4 w; w.x = pc[0][bj].x; w.y = pc[0][bj].y; w.z = pc[1][bj].x; w.w = pc[1][bj].y;
                        *(u32x4*)(G8 + gate_block(u.pm, pn - 14, wr * 4 + (wc & 1) * 2 + bj, ai, mp, wc >> 1) + (fq * 16 + fr) * 16) = w; } } }
            return 24;
        }
        size_t doff; int gi = -1; int pitch = 512; bool rp = false; float sc = 1.f;
        int vn = -1, vhalf = 0, vw = 8;
        int kn = -1;
        if (pn < 2)       { doff = EI_AQ + (size_t)((pn * 4 + wc) * 64) * 2; gi = 5; rp = true; sc = QSCALE; }
        else if (pn < 4)  { doff = EI_AK; kn = (pn - 2) * 4 + wc; gi = 6; rp = true; }
        else if (pn < 6)  { doff = EI_AV; vn = (pn - 4) * 4 + wc; }
        else if (pn == 6) { doff = EI_IQ + (size_t)(wc * 64) * 2; pitch = 256; rp = true; }
        else if (pn == 7) {
            if (wc == 0) { doff = EI_IK; pitch = 64; gi = 7; rp = true; kn = 100; }
            else { if (wc == 1) {
                    float* IW = (float*)(ws + EI_IW);
#pragma unroll
                    for (int ai = 0; ai < 2; ++ai)
#pragma unroll
                        for (int m = 0; m < 4; ++m) { const int row = rowb + ai * 128 + m * 16; if (fq == 0) *(f32x4*)(IW + (size_t)row * 4) = acc[ai][0][m][0] * (rt[ai * 128 + m * 16] * 0.5f); } }
                return (wc == 1) ? 1 : 0; } }
        else if (pn < 10) { doff = EI_BQ + (size_t)(((pn - 8) * 4 + wc) * 64) * 2; gi = 8; rp = true; sc = QSCALE; }
        else if (pn < 12) { doff = EI_BK; kn = (pn - 10) * 4 + wc; gi = 9; rp = true; }
        else              { doff = EI_BV; const int sl_ = (pn - 12) * 4 + wc; vn = sl_ >> 1; vhalf = sl_ & 1; vw = 16; }
        bf16_t* dst = (bf16_t*)(ws + doff);
        const float* gn = (gi >= 0) ? lds_inptr(ldsb, gi) + layer * 64 : nullptr;
        float gv[2][8];
#pragma unroll
        for (int bj = 0; bj < 2; ++bj)
#pragma unroll
            for (int j = 0; j < 8; ++j) gv[bj][j] = 1.f;
        if (gn) {
#pragma unroll
            for (int bj = 0; bj < 2; ++bj) { const f32x4 a = *(const f32x4*)(gn + 32 * bj + 8 * fq), b = *(const f32x4*)(gn + 32 * bj + 8 * fq + 4);
                gv[bj][0] = a[0] * sc; gv[bj][1] = a[1] * sc; gv[bj][2] = a[2] * sc; gv[bj][3] = a[3] * sc; gv[bj][4] = b[0] * sc; gv[bj][5] = b[1] * sc; gv[bj][6] = b[2] * sc; gv[bj][7] = b[3] * sc; } }
#pragma unroll
        for (int ai = 0; ai < 2; ++ai) {
            u32x4 cw[4][2];
            if (rp) {
#pragma unroll
                for (int mm = 0; mm < 4; ++mm) { const u32x4* cp = (const u32x4*)(rope + (size_t)(rowb + ai * 128 + mm * 16) * 32 + 8 * fq); cw[mm][0] = cp[0]; cw[mm][1] = cp[1]; } }
#pragma unroll
            for (int mm = 0; mm < 4; ++mm) { const int m = mm; const int row = rowb + ai * 128 + m * 16;
                const float r = rt[ai * 128 + m * 16];
                float v[2][8];
                if (gn) {
                    float q = 0.f;
#pragma unroll
                    for (int bj = 0; bj < 2; ++bj)
#pragma unroll
                        for (int n = 0; n < 2; ++n)
#pragma unroll
                            for (int i = 0; i < 4; ++i) q += acc[ai][bj][m][n][i] * acc[ai][bj][m][n][i];
                    q = sum_fq(q);
                    const float s = r * __builtin_amdgcn_rsqf(q * (r * r) * (1.0f / 64.0f) + EPSN);
#pragma unroll
                    for (int bj = 0; bj < 2; ++bj)
#pragma unroll
                        for (int n = 0; n < 2; ++n)
#pragma unroll
                            for (int i = 0; i < 4; ++i) v[bj][4 * n + i] = (acc[ai][bj][m][n][i] * s) * gv[bj][4 * n + i];
                } else { const float s = r * sc;
#pragma unroll
                    for (int bj = 0; bj < 2; ++bj)
#pragma unroll
                        for (int n = 0; n < 2; ++n)
#pragma unroll
                            for (int i = 0; i < 4; ++i) v[bj][4 * n + i] = acc[ai][bj][m][n][i] * s;
                }
                if (rp) {
#pragma unroll
                    for (int j = 0; j < 8; ++j) { const unsigned cwj = cw[mm][j >> 2][j & 3]; const h16x2 hh = __builtin_bit_cast(h16x2, cwj); const float cs = (float)hh[0], sn = (float)hh[1];
                        const float a = v[0][j], b = v[1][j]; v[0][j] = a * cs - b * sn; v[1][j] = b * cs + a * sn; }
                }
#pragma unroll
                for (int bj = 0; bj < 2; ++bj) { u32x4 w; w.x = cvt_pk_bf16(v[bj][0], v[bj][1]); w.y = cvt_pk_bf16(v[bj][2], v[bj][3]); w.z = cvt_pk_bf16(v[bj][4], v[bj][5]); w.w = cvt_pk_bf16(v[bj][6], v[bj][7]);
                    bf16_t* p_ = (kn == 100) ? dst + (((((size_t)((row >> 11) * 64 + ((row & 2047) >> 5)) * 4 + (2 * bj + (fq >> 1))) * 2 + (fq & 1)) * 32 + (row & 31)) << 3) : (vn >= 0) ? dst + (((((size_t)((row >> 11) * (vw == 16 ? 4 : 8) + vn) * 32 + ((row & 2047) >> 6)) * vw + (vhalf * 8 + 4 * bj + ((row & 63) >> 4))) * 64 + ((row & 15) * 4 + fq)) << 3) : (kn >= 0) ? dst + (((((size_t)((row >> 11) * 8 + kn) * 32 + ((row & 2047) >> 6)) * 8 + (4 * bj + fq)) * 64 + (row & 63)) << 3) : dst + (size_t)row * pitch + 32 * bj + 8 * fq;
                    *(u32x4*)p_ = w; }
            }
        }
        return 24;
    }
};

template <bool SECOND> struct EpiGate {
    static constexpr bool PERM = true, AFTER_DRAIN = false, CARRY = false; static constexpr int VMEM_MIN = SECOND ? 48 : 32;
    const unsigned char* G; bf16_t* T; bf16_t* O;
    __device__ __forceinline__ int operator()(const f32x4 (&acc)[2][2][4][2], const Unit& u, int wr, int wc, int fr, int fq) const {
        const int rowb = u.pm * 256 + wr * 64 + fr, colb = u.pn * 256 + wc * 32 + 8 * fq;
#pragma unroll
        for (int ai = 0; ai < 2; ++ai) {
            uint2 gw[4][2]; u32x4 tw[4][2];
#pragma unroll
            for (int m = 0; m < 4; ++m)
#pragma unroll
                for (int bj = 0; bj < 2; ++bj) { gw[m][bj] = *(const uint2*)(G + (size_t)(rowb + ai * 128 + m * 16) * 2048 + (SECOND ? 1024 : 0) + colb + 128 * bj);
                    if (SECOND) tw[m][bj] = *(const u32x4*)(T + (size_t)(rowb + ai * 128 + m * 16) * 1024 + colb + 128 * bj); }
#pragma unroll
            for (int m = 0; m < 4; ++m) { const int row = rowb + ai * 128 + m * 16;
#pragma unroll
                for (int bj = 0; bj < 2; ++bj) { const int col = colb + 128 * bj; const uint2 g8 = gw[m][bj];
                    const f32x2_t g01 = __builtin_amdgcn_cvt_pk_f32_fp8((int)g8.x, false), g23 = __builtin_amdgcn_cvt_pk_f32_fp8((int)g8.x, true), g45 = __builtin_amdgcn_cvt_pk_f32_fp8((int)g8.y, false), g67 = __builtin_amdgcn_cvt_pk_f32_fp8((int)g8.y, true);
                    const f32x4 a0 = acc[ai][bj][m][0], a1 = acc[ai][bj][m][1];
                    float v[8] = {a0[0] * sigm(g01.x), a0[1] * sigm(g01.y), a0[2] * sigm(g23.x), a0[3] * sigm(g23.y), a1[0] * sigm(g45.x), a1[1] * sigm(g45.y), a1[2] * sigm(g67.x), a1[3] * sigm(g67.y)};
                    if (SECOND) { const u32x4 t = tw[m][bj];
                        v[0] += bflo(t.x); v[1] += bfhi(t.x); v[2] += bflo(t.y); v[3] += bfhi(t.y); v[4] += bflo(t.z); v[5] += bfhi(t.z); v[6] += bflo(t.w); v[7] += bfhi(t.w); }
                    u32x4 w; w.x = cvt_pk_bf16(v[0], v[1]); w.y = cvt_pk_bf16(v[2], v[3]); w.z = cvt_pk_bf16(v[4], v[5]); w.w = cvt_pk_bf16(v[6], v[7]);
                    *(u32x4*)((SECOND ? O : T) + (size_t)row * 1024 + col) = w; } }
        }
        return SECOND ? 48 : 32;
    }
};

struct EpiGatePair {
    static constexpr bool PERM = true, AFTER_DRAIN = false, CARRY = false; static constexpr int VMEM_MIN = 32;
    const unsigned char* G; bf16_t* T; bf16_t* O;
    __device__ __forceinline__ int operator()(const f32x4 (&acc)[2][2][4][2], const Unit& u, int wr, int wc, int fr, int fq) const {
        if (u.pn < 4) { const EpiGate<false> e{G, T, O}; return e(acc, u, wr, wc, fr, fq); }
        const Unit v{u.pm, u.pn - 4}; const EpiGate<true> e{G, T, O}; return e(acc, v, wr, wc, fr, fq);
    }
};

struct EpiGateFused {
    static constexpr bool PERM = true, AFTER_DRAIN = false, CARRY = true; static constexpr int VMEM_MIN = 16;
    const unsigned char* G; bf16_t* O;
    static __device__ __forceinline__ bool carry(const Unit& u) { return u.pn < 4; }
    static __device__ __forceinline__ float ex(float g) { return __builtin_amdgcn_exp2f(g * -1.4426950408889634f); }
    __device__ __forceinline__ int operator()(f32x4 (&acc)[2][2][4][2], const Unit& u, int wr, int wc, int fr, int fq) const {
        const bool first = u.pn < 4;
        const int rowb = u.pm * 256 + wr * 64 + fr, colb = (u.pn & 3) * 256 + wc * 32 + 8 * fq;
        if (first) {
#pragma unroll
            for (int ai = 0; ai < 2; ++ai) {
                uint2 ga[4][2], gb[4][2];
#pragma unroll
                for (int mp = 0; mp < 2; ++mp)
#pragma unroll
                    for (int bj = 0; bj < 2; ++bj) { const int ln16 = (fq * 16 + fr) * 16; const u32x4 qa = *(const u32x4*)(G + gate_block(u.pm, u.pn & 3, wr * 4 + wc, ai, mp, bj) + ln16), qb = *(const u32x4*)(G + gate_block(u.pm, 4 + (u.pn & 3), wr * 4 + wc, ai, mp, bj) + ln16);
                        ga[2 * mp][bj] = make_uint2(qa.x, qa.y); ga[2 * mp + 1][bj] = make_uint2(qa.z, qa.w); gb[2 * mp][bj] = make_uint2(qb.x, qb.y); gb[2 * mp + 1][bj] = make_uint2(qb.z, qb.w); }
#pragma unroll
                for (int m = 0; m < 4; ++m)
#pragma unroll
                    for (int bj = 0; bj < 2; ++bj) {
                        const f32x2_t a01 = __builtin_amdgcn_cvt_pk_f32_fp8((int)ga[m][bj].x, false), a23 = __builtin_amdgcn_cvt_pk_f32_fp8((int)ga[m][bj].x, true), a45 = __builtin_amdgcn_cvt_pk_f32_fp8((int)ga[m][bj].y, false), a67 = __builtin_amdgcn_cvt_pk_f32_fp8((int)ga[m][bj].y, true);
                        const f32x2_t b01 = __builtin_amdgcn_cvt_pk_f32_fp8((int)gb[m][bj].x, false), b23 = __builtin_amdgcn_cvt_pk_f32_fp8((int)gb[m][bj].x, true), b45 = __builtin_amdgcn_cvt_pk_f32_fp8((int)gb[m][bj].y, false), b67 = __builtin_amdgcn_cvt_pk_f32_fp8((int)gb[m][bj].y, true);
                        const float ga8[8] = {a01.x, a01.y, a23.x, a23.y, a45.x, a45.y, a67.x, a67.y}, gb8[8] = {b01.x, b01.y, b23.x, b23.y, b45.x, b45.y, b67.x, b67.y};
#pragma unroll
                        for (int n = 0; n < 2; ++n)
#pragma unroll
                            for (int i = 0; i < 4; ++i) acc[ai][bj][m][n][i] *= (1.0f + ex(gb8[4 * n + i])) * __builtin_amdgcn_rcpf(1.0f + ex(ga8[4 * n + i]));
                    }
            }
            return 32;
        }
#pragma unroll
        for (int ai = 0; ai < 2; ++ai) {
            uint2 gb[4][2];
#pragma unroll
            for (int mp = 0; mp < 2; ++mp)
#pragma unroll
                for (int bj = 0; bj < 2; ++bj) { const u32x4 qb = *(const u32x4*)(G + gate_block(u.pm, 4 + (u.pn & 3), wr * 4 + wc, ai, mp, bj) + (fq * 16 + fr) * 16); gb[2 * mp][bj] = make_uint2(qb.x, qb.y); gb[2 * mp + 1][bj] = make_uint2(qb.z, qb.w); }
#pragma unroll
            for (int m = 0; m < 4; ++m) { const int row = rowb + ai * 128 + m * 16;
#pragma unroll
                for (int bj = 0; bj < 2; ++bj) { const int col = colb + 128 * bj;
                    const f32x2_t b01 = __builtin_amdgcn_cvt_pk_f32_fp8((int)gb[m][bj].x, false), b23 = __builtin_amdgcn_cvt_pk_f32_fp8((int)gb[m][bj].x, true), b45 = __builtin_amdgcn_cvt_pk_f32_fp8((int)gb[m][bj].y, false), b67 = __builtin_amdgcn_cvt_pk_f32_fp8((int)gb[m][bj].y, true);
                    const f32x4 a0 = acc[ai][bj][m][0], a1 = acc[ai][bj][m][1];
                    const float v[8] = {a0[0] * sigm(b01.x), a0[1] * sigm(b01.y), a0[2] * sigm(b23.x), a0[3] * sigm(b23.y), a1[0] * sigm(b45.x), a1[1] * sigm(b45.y), a1[2] * sigm(b67.x), a1[3] * sigm(b67.y)};
                    u32x4 w; w.x = cvt_pk_bf16(v[0], v[1]); w.y = cvt_pk_bf16(v[2], v[3]); w.z = cvt_pk_bf16(v[4], v[5]); w.w = cvt_pk_bf16(v[6], v[7]);
                    *(u32x4*)(O + (size_t)row * 1024 + col) = w; } }
        }
        return 32;
    }
};

struct EpiRes {
    static constexpr bool PERM = true, AFTER_DRAIN = false, CARRY = false; static constexpr int VMEM_MIN = 40;
    bf16_t* XB; float* ssout; float* fout; bf16_t* XO;
    __device__ __forceinline__ int operator()(const f32x4 (&acc)[2][2][4][2], const Unit& u, int wr, int wc, int fr, int fq) const {
        const int rowb = u.pm * 256 + wr * 64 + fr, colb = u.pn * 256 + wc * 32 + 8 * fq;
        u32x4 bw[2][4][2];
#pragma unroll
        for (int ai = 0; ai < 2; ++ai)
#pragma unroll
            for (int m = 0; m < 4; ++m)
#pragma unroll
                for (int bj = 0; bj < 2; ++bj) bw[ai][m][bj] = *(const u32x4*)(XB + (size_t)(rowb + ai * 128 + m * 16) * 1024 + colb + 128 * bj);
#pragma unroll
        for (int ai = 0; ai < 2; ++ai)
#pragma unroll
            for (int m = 0; m < 4; ++m) { const int row = rowb + ai * 128 + m * 16; float q = 0.f;
#pragma unroll
                for (int bj = 0; bj < 2; ++bj) { const size_t off = (size_t)row * 1024 + colb + 128 * bj; const u32x4 b = bw[ai][m][bj];
                    const f32x4 o0 = (f32x4){bflo(b.x), bfhi(b.x), bflo(b.y), bfhi(b.y)} + acc[ai][bj][m][0], o1 = (f32x4){bflo(b.z), bfhi(b.z), bflo(b.w), bfhi(b.w)} + acc[ai][bj][m][1];
                    if (fout) { *(f32x4*)(fout + off) = o0; *(f32x4*)(fout + off + 4) = o1; }
                    u32x4 w; w.x = cvt_pk_bf16(o0[0], o0[1]); w.y = cvt_pk_bf16(o0[2], o0[3]); w.z = cvt_pk_bf16(o1[0], o1[1]); w.w = cvt_pk_bf16(o1[2], o1[3]);
                    if (!fout) *(u32x4*)(XO + off) = w;
                    q += ((o0[0] * o0[0] + o0[1] * o0[1]) + (o0[2] * o0[2] + o0[3] * o0[3])) + ((o1[0] * o1[0] + o1[1] * o1[1]) + (o1[2] * o1[2] + o1[3] * o1[3])); }
                q = sum_fq(q);
                if (fq == 0 && !fout) ssout[(size_t)row * 16 + u.pn * 4 + wc] = q; }
        return 40;
    }
};

struct EpiSwiglu {
    static constexpr bool PERM = true, AFTER_DRAIN = false, CARRY = false; static constexpr int VMEM_MIN = 8;
    PG8_LAS unsigned char* ldsb; bf16_t* ACT;
    __device__ __forceinline__ int operator()(const f32x4 (&acc)[2][2][4][2], const Unit& u, int wr, int wc, int fr, int fq) const {
        const int rowb = u.pm * 256 + wr * 64 + fr, colb = u.pn * 128 + wc * 32 + 8 * fq;
        const PG8_LAS float* rt = rstd_slot(ldsb, u.pm) + wr * 64 + fr;
#pragma unroll
        for (int ai = 0; ai < 2; ++ai)
#pragma unroll
            for (int m = 0; m < 4; ++m) { const int row = rowb + ai * 128 + m * 16; const float r = rt[ai * 128 + m * 16];
                float a[8];
#pragma unroll
                for (int n = 0; n < 2; ++n)
#pragma unroll
                    for (int i = 0; i < 4; ++i) { const float g = acc[ai][0][m][n][i] * r, up = acc[ai][1][m][n][i] * r; a[4 * n + i] = (g * sigm(g)) * up; }
                u32x4 w; w.x = cvt_pk_bf16(a[0], a[1]); w.y = cvt_pk_bf16(a[2], a[3]); w.z = cvt_pk_bf16(a[4], a[5]); w.w = cvt_pk_bf16(a[6], a[7]);
                *(u32x4*)(ACT + (size_t)row * 2816 + colb) = w; }
        return 16;
    }
};

template <int MODE> struct EpiProbe {
    static constexpr bool PERM = true, AFTER_DRAIN = false, CARRY = false; static constexpr int VMEM_MIN = 0;
    bf16_t* ACT;
    __device__ __forceinline__ int operator()(const f32x4 (&acc)[2][2][4][2], const Unit& u, int wr, int wc, int fr, int fq) const {
#pragma unroll
        for (int ai = 0; ai < 2; ++ai)
#pragma unroll
            for (int bj = 0; bj < 2; ++bj)
#pragma unroll
                for (int m = 0; m < 4; ++m) asm volatile("" :: "v"(acc[ai][bj][m][0]), "v"(acc[ai][bj][m][1]));
        if (MODE == 0) return 0;
        const int rowb = u.pm * 256 + wr * 64 + fr, colb = u.pn * 128 + wc * 32 + 8 * fq;
#pragma unroll
        for (int ai = 0; ai < 2; ++ai)
#pragma unroll
            for (int m = 0; m < 4; ++m) { const int row = rowb + ai * 128 + m * 16; u32x4 w; w.x = cvt_pk_bf16(acc[ai][0][m][0][0], acc[ai][0][m][0][1]); w.y = cvt_pk_bf16(acc[ai][0][m][0][2], acc[ai][0][m][0][3]); w.z = cvt_pk_bf16(acc[ai][1][m][1][0], acc[ai][1][m][1][1]); w.w = cvt_pk_bf16(acc[ai][1][m][1][2], acc[ai][1][m][1][3]);
                *(u32x4*)(ACT + (size_t)row * 2816 + colb) = w; }
        return 8;
    }
};
}
#include <hip/hip_bf16.h>
#include <cmath>
namespace attn_body {
using bf16=__hip_bfloat16;
using bf16x8=__attribute__((ext_vector_type(8)))short;
using s16x4=__attribute__((ext_vector_type(4)))short;
using f32x16=__attribute__((ext_vector_type(16)))float;
using u32x4=__attribute__((ext_vector_type(4)))unsigned;
constexpr int SEQ=2048,D=64,DM=512;
constexpr int NW=8,QBLK=32,QB=QBLK*NW,KVBLK=64,NQB=SEQ/QB;
constexpr int ATTN_PITCH=DM, ATTN_UNIT_ROWS=QB;
__device__ __forceinline__ int crow(int r,int hi){return (r&3)+8*(r>>2)+4*hi;}
#define SBAR() __builtin_amdgcn_sched_barrier(0)
__device__ __forceinline__ void cmask(f32x16&p0,f32x16&p1,int jb,int qrel,int hi){
  const float NEG=-INFINITY; int qh=qrel-64*jb-4*hi; asm volatile("":"+v"(qh));
  #pragma unroll
  for(int r=0;r<16;++r){const int c=(r&3)+8*(r>>2); if(c>qh)p0[r]=NEG; if(c+32>qh)p1[r]=NEG;}
}

constexpr int NSLOT=3, SLOTB=8192;
constexpr int LDS_K=0, LDS_V=NSLOT*SLOTB, LDS_WS=2*NSLOT*SLOTB, LDS_OST=LDS_WS+NW*64*4, LDS_BYTES=LDS_OST+NW*4096;
constexpr float C2=0.125f*1.4426950408889634f;
__device__ __forceinline__ void glds16(const void*gsrc,unsigned lds_dst){unsigned keep;
  asm volatile("s_mov_b32 %0, m0\n\ts_mov_b32 m0, %2\n\ts_nop 0\n\tglobal_load_lds_dwordx4 %1, off\n\ts_mov_b32 m0, %0":"=&s"(keep):"v"(gsrc),"s"(lds_dst):"memory");}
__device__ __forceinline__ float max3f(float a,float b,float c){float r;asm("v_max3_f32 %0, %1, %2, %3":"=v"(r):"v"(a),"v"(b),"v"(c));return r;}
__device__ __forceinline__ float max2f(float a,float b){float r;asm("v_max_f32_e32 %0, %1, %2":"=v"(r):"v"(a),"v"(b));return r;}
__device__ __forceinline__ float fadd_s(float a,float b){float r;asm("v_add_f32_e32 %0, %1, %2":"=v"(r):"v"(a),"v"(b));return r;}
__device__ __forceinline__ float fsub_s(float a,float b){float r;asm("v_sub_f32_e32 %0, %1, %2":"=v"(r):"v"(a),"v"(b));return r;}
typedef float f32x2_t __attribute__((ext_vector_type(2))); typedef __bf16 bf16x2_t __attribute__((ext_vector_type(2)));
__device__ __forceinline__ unsigned cvtpk_s(float lo,float hi){f32x2_t v={lo,hi};bf16x2_t b=__builtin_convertvector(v,bf16x2_t);return __builtin_bit_cast(unsigned,b);}
#define WAIT_BAR(N) asm volatile("s_waitcnt vmcnt(" #N ") lgkmcnt(0)\n\ts_barrier":::"memory")

__device__ __forceinline__ void qkt(f32x16&p0,f32x16&p1,const char*Kslot,const bf16x8*qr,const f32x16&negm,int r32,int hi){
  const char*kb=Kslot+hi*1024+r32*16;
  #pragma unroll
  for(int d0=0;d0<4;++d0){
    const bf16x8 b0=*reinterpret_cast<const bf16x8*>(kb+d0*2048);
    const bf16x8 b1=*reinterpret_cast<const bf16x8*>(kb+d0*2048+512);
    if(d0==0){p0=__builtin_amdgcn_mfma_f32_32x32x16_bf16(b0,qr[0],negm,0,0,0);p1=__builtin_amdgcn_mfma_f32_32x32x16_bf16(b1,qr[0],negm,0,0,0);}
    else{p0=__builtin_amdgcn_mfma_f32_32x32x16_bf16(b0,qr[d0],p0,0,0,0);p1=__builtin_amdgcn_mfma_f32_32x32x16_bf16(b1,qr[d0],p1,0,0,0);}}
}
typedef __attribute__((address_space(3))) const char* lds_cptr;
typedef short v4i16_t __attribute__((ext_vector_type(4)));
__device__ __forceinline__ void kload8(bf16x8*kf,lds_cptr kp){
  kf[0]=*(const __attribute__((address_space(3))) bf16x8*)(kp);      kf[1]=*(const __attribute__((address_space(3))) bf16x8*)(kp+512);
  kf[2]=*(const __attribute__((address_space(3))) bf16x8*)(kp+2048); kf[3]=*(const __attribute__((address_space(3))) bf16x8*)(kp+2560);
  kf[4]=*(const __attribute__((address_space(3))) bf16x8*)(kp+4096); kf[5]=*(const __attribute__((address_space(3))) bf16x8*)(kp+4608);
  kf[6]=*(const __attribute__((address_space(3))) bf16x8*)(kp+6144); kf[7]=*(const __attribute__((address_space(3))) bf16x8*)(kp+6656);
}
__device__ __forceinline__ void kload2(bf16x8*kf,lds_cptr kp,int j){ kf[2*j]=*(const __attribute__((address_space(3))) bf16x8*)(kp+j*2048); kf[2*j+1]=*(const __attribute__((address_space(3))) bf16x8*)(kp+j*2048+512); }
__device__ __forceinline__ s16x4 vtr(lds_cptr p){ return __builtin_bit_cast(s16x4,__builtin_amdgcn_ds_read_tr16_b64_v4i16((__attribute__((address_space(3))) v4i16_t*)p)); }
__device__ __forceinline__ float rowmax(const f32x16&p0,const f32x16&p1){
  float a=max3f(p0[0],p0[1],p1[0]),b=max3f(p0[2],p0[3],p1[1]);a=max3f(a,p1[2],p1[3]);
  #pragma unroll
  for(int r=4;r<16;r+=4){a=max3f(a,p0[r],p0[r+1]);b=max3f(b,p0[r+2],p0[r+3]);a=max3f(a,p1[r],p1[r+1]);b=max3f(b,p1[r+2],p1[r+3]);}
  const float m=max2f(a,b);
  auto rr=__builtin_amdgcn_permlane32_swap(__float_as_uint(m),__float_as_uint(m),false,false);
  return max2f(__uint_as_float(rr[0]),__uint_as_float(rr[1]));
}
template<int NO> __device__ __forceinline__ void pv(f32x16*o,int vb,bf16x8 pa0,bf16x8 pa1,bf16x8 pa2,bf16x8 pa3){
  #pragma unroll
  for(int d0=0;d0<NO;++d0){s16x4 lo[4],hi[4];
    #pragma unroll
    for(int ks=0;ks<4;++ks){
      asm volatile("ds_read_b64_tr_b16 %0,%1 offset:%c2":"=&v"(lo[ks]):"v"(vb),"i"(d0*4096+ks*1024):"memory");
      asm volatile("ds_read_b64_tr_b16 %0,%1 offset:%c2":"=&v"(hi[ks]):"v"(vb),"i"(d0*4096+ks*1024+512):"memory");}
    asm volatile("s_waitcnt lgkmcnt(0)":::"memory");SBAR();
    #define PK(k) (bf16x8){lo[k][0],lo[k][1],lo[k][2],lo[k][3],hi[k][0],hi[k][1],hi[k][2],hi[k][3]}
    o[d0]=__builtin_amdgcn_mfma_f32_32x32x16_bf16(pa0,PK(0),o[d0],0,0,0);
    o[d0]=__builtin_amdgcn_mfma_f32_32x32x16_bf16(pa1,PK(1),o[d0],0,0,0);
    o[d0]=__builtin_amdgcn_mfma_f32_32x32x16_bf16(pa2,PK(2),o[d0],0,0,0);
    o[d0]=__builtin_amdgcn_mfma_f32_32x32x16_bf16(pa3,PK(3),o[d0],0,0,0);
    #undef PK
  }
}

#ifndef ATTN_STORE16
#define ATTN_STORE16(p,v) (*(u32x4*)(p)=(v))
#endif
template<int THRL,bool TOPK,bool DV> __device__ __forceinline__ void attn_unit(int b,int qb,const bf16*Qc,const bf16*__restrict__ Kc,const bf16*__restrict__ Vc,bf16*Oc,const unsigned*__restrict__ mk,char*shm,const int wave_in,const bool cmb=false,const bf16*Oprev=nullptr,const float*__restrict__ subg=nullptr,const float lam=0.f,const float oscale=0.f){
  int lane_; asm volatile("v_mbcnt_lo_u32_b32 %0, -1, 0\n\tv_mbcnt_hi_u32_b32 %0, -1, %0":"=v"(lane_)); const int lane=lane_,r32=lane&31,hi=lane>>5; const int wid=wave_in;
  const long rowbase=(long)b*SEQ; const int q0=qb*QB;
  constexpr int VSL=DV?2:1, NO=DV?4:2, LW=LDS_V+NSLOT*SLOTB*VSL, LO=LW+NW*64*4;
  const bf16*Qw=Qc+(rowbase+q0+wid*QBLK)*DM;
  const bf16*Kh=Kc+rowbase*DM,*Vh=Vc+rowbase*DM;
  const unsigned lds0=(unsigned)(uintptr_t)shm;
  float*wsf=(float*)(shm+LW)+wid*64;
  const bf16*ksrc=Kh+wid*512+lane*8;
  const bf16*vsrc=Vh+wid*512+lane*8;
  const unsigned kdst=lds0+LDS_K+wid*1024, vdst=lds0+LDS_V+wid*1024;
  #define DMA_K(t,slot) glds16(ksrc+(long)(t)*(KVBLK*64),(unsigned)__builtin_amdgcn_readfirstlane(kdst+(slot)))
  #define DMA_V(t,slot) do{ glds16(vsrc+(long)(t)*(DV?8192:4096),(unsigned)__builtin_amdgcn_readfirstlane(vdst+VSL*(slot))); if(DV){ glds16(vsrc+(long)(t)*8192+4096,(unsigned)__builtin_amdgcn_readfirstlane(vdst+VSL*(slot)+8192)); } }while(0)
  const int vb0=(int)(lds0+LDS_V)+((lane>>4)&1)*32+(lane&3)*8+(4*hi+((lane&15)>>2))*64;
  const char*Kbase=shm+LDS_K; bf16x8 kf[8];
  const lds_cptr shm3=(lds_cptr)shm; const lds_cptr kp0=shm3+LDS_K+hi*1024+r32*16; const lds_cptr vp0=shm3+LDS_V+((lane>>4)&1)*32+(lane&3)*8+(4*hi+((lane&15)>>2))*64;
  const int NT=(q0+QB)/KVBLK;
  DMA_K(0,0);DMA_V(0,0);DMA_K(1,SLOTB);
  bf16x8 qr[4];
  #pragma unroll
  for(int d0=0;d0<4;++d0)qr[d0]=*reinterpret_cast<const bf16x8*>(&Qw[(long)r32*DM+d0*16+hi*8]);
  float mhat=0.f,l_reg=0.f;f32x16 o[NO]; _Pragma("unroll") for(int d_=0;d_<NO;++d_)o[d_]=f32x16{};f32x16 negm=f32x16{}; if(!DV){asm volatile("":"+v"(negm));}
  const int qrel=wid*QBLK+r32;
  const unsigned*mrow=TOPK?(mk+((size_t)(b*64+qb*8+wid)*32)*64+r32*2):nullptr; const int sh4=4*hi; unsigned mw0=0u,mw1=0u; uint2 mwl=make_uint2(0u,0u);
  #define MLOAD(t) do{ if(TOPK){ mwl=*reinterpret_cast<const uint2*>(mrow+(size_t)(t)*64); } }while(0)
  #define MSHIFT() do{ if(TOPK){ mw0=mwl.x>>sh4; mw1=mwl.y>>sh4; asm volatile("":"+v"(mw0),"+v"(mw1)); } }while(0)
  #define MBIT(W,r) ((unsigned)__builtin_amdgcn_sbfe((int)(W),((r)&3)+8*((r)>>2),1))
  #define MAND(X,r,W) do{ if(TOPK){ X[r]=__uint_as_float(__float_as_uint(X[r])&MBIT(W,r)); } }while(0)
  MLOAD(0);
  #define CMASK(P0,P1,t) do{int jb_=(t)-(NT-4); if(jb_>=0)cmask(P0,P1,jb_,qrel,hi);}while(0)
  bool resc=false;
  #define START(P0,P1) do{ const float rm=rowmax(P0,P1); resc=false; \
    { const float dl=rm; mhat=fadd_s(mhat,dl); \
      _Pragma("unroll") for(int r=0;r<16;++r){P0[r]=fsub_s(P0[r],dl);P1[r]=fsub_s(P1[r],dl);} \
      if(!DV){ _Pragma("unroll") for(int r=0;r<16;++r)negm[r]=-mhat; asm volatile("":"+v"(negm)); } } \
    _Pragma("unroll") for(int r=0;r<16;++r)P0[r]=__builtin_amdgcn_exp2f(P0[r]); }while(0)
  #define RESC() do{ if(resc){ asm volatile("s_waitcnt lgkmcnt(0)":::"memory"); \
      _Pragma("unroll") for(int d_=0;d_<NO;++d_) _Pragma("unroll") for(int r=0;r<16;++r)o[d_][r]*=wsf[crow(r,hi)]; } }while(0)
  f32x16 pA0,pA1,pB0,pB1;
  int sl_prev=0,sl_cur=0,sl_next=SLOTB;
  #define ROT() do{sl_prev=sl_cur;sl_cur=sl_next;sl_next=(sl_next==(NSLOT-1)*SLOTB)?0:sl_next+SLOTB;}while(0)
  #define WAIT_BAR_KV() do{ if(DV){WAIT_BAR(3);}else{WAIT_BAR(2);} }while(0)
  #define WAIT_BAR_V() do{ if(DV){WAIT_BAR(2);}else{WAIT_BAR(1);} }while(0)
  DMA_K(2,2*SLOTB);
  WAIT_BAR(3);
  qkt(pA0,pA1,Kbase,qr,negm,r32,hi);    asm volatile("s_nop 15\n\ts_nop 7":"+v"(pA0),"+v"(pA1));CMASK(pA0,pA1,0);
  START(pA0,pA1);
  _Pragma("unroll") for(int r=0;r<16;++r)pA1[r]=__builtin_amdgcn_exp2f(pA1[r]);
  if(TOPK){ MSHIFT(); _Pragma("unroll") for(int r=0;r<16;++r){ MAND(pA0,r,mw0); MAND(pA1,r,mw1); } }
  WAIT_BAR(0);
  DMA_K(3,0);DMA_V(1,SLOTB);
  ROT();
  kload8(kf,kp0+sl_cur);
  WAIT_BAR_KV();
  s16x4 vlo[8],vhi[8]; u32x4 pw0,pw1,pw2,pw3;
  #define PKW(P,B) cvtpk_s(P[B],P[B+1])
  #define PAF(k) __builtin_bit_cast(bf16x8,pw##k)
  #define VFR(i) (bf16x8){vlo[i][0],vlo[i][1],vlo[i][2],vlo[i][3],vhi[i][0],vhi[i][1],vhi[i][2],vhi[i][3]}
  #define PIN(x) asm volatile("":"+v"(x))
  #define MX3(a,b,c) __builtin_fmaxf(__builtin_fmaxf((a),(b)),(c))
  #define GAPA(MF,A0,A1,A2,A3,W0,W1,PW) do{ MF; sacc2+=(f32x2_t){A0,A1}; sacc2+=(f32x2_t){A2,A3}; PIN(sacc2); W0; W1; PIN(PW); SBAR(); }while(0)
  #define EX(v) (DV?__builtin_amdgcn_exp2f((v)-mhat):__builtin_amdgcn_exp2f(v))
  #define QKC0 (DV?f32x16{}:negm)
  #define GAPB(MF,X,B,W) do{ MF; if(DV){ const f32x2_t t0_=(f32x2_t){X[B],X[B+1]}-(f32x2_t){mhat,mhat}, t1_=(f32x2_t){X[B+2],X[B+3]}-(f32x2_t){mhat,mhat}; X[B]=__builtin_amdgcn_exp2f(t0_.x); X[B+1]=__builtin_amdgcn_exp2f(t0_.y); X[B+2]=__builtin_amdgcn_exp2f(t1_.x); X[B+3]=__builtin_amdgcn_exp2f(t1_.y); } else { X[B]=EX(X[B]); X[B+1]=EX(X[B+1]); X[B+2]=EX(X[B+2]); X[B+3]=EX(X[B+3]); } MAND(X,B,W); MAND(X,B+1,W); MAND(X,B+2,W); MAND(X,B+3,W); PIN(X); SBAR(); }while(0)
  #define VRD(i) do{ vlo[i]=vtr(vp_+(((i)>>2)*4096+((i)&3)*1024)); vhi[i]=vtr(vp_+(((i)>>2)*4096+((i)&3)*1024+512)); }while(0)
  #define KRD(G,j) do{ if(G){ kload2(kf,kp0+sl_next,j); SBAR(); } }while(0)
  #define VRD2(i) do{ if(DV){ vlo[i]=vtr(vp_+(8192+((i)>>2)*4096+((i)&3)*1024)); vhi[i]=vtr(vp_+(8192+((i)>>2)*4096+((i)&3)*1024+512)); SBAR(); } }while(0)
  #define STEP(C0,C1,P0,P1,t,GK,GV,GL) do{ SBAR(); MLOAD(t); \
    const lds_cptr vp_=vp0+VSL*sl_prev; \
    VRD(0); SBAR(); f32x2_t sacc2={P0[0],P0[1]}; \
    GAPA(C0=__builtin_amdgcn_mfma_f32_32x32x16_bf16(kf[0],qr[0],QKC0,0,0,0), P0[2],P0[3],P0[4],P0[5],     pw0[0]=PKW(P0,0), pw0[1]=PKW(P0,2), pw0); \
    VRD(4); SBAR(); GAPA(C1=__builtin_amdgcn_mfma_f32_32x32x16_bf16(kf[1],qr[0],QKC0,0,0,0), P0[6],P0[7],P0[8],P0[9],     pw0[2]=PKW(P0,4), pw0[3]=PKW(P0,6), pw0); \
    VRD(1); SBAR(); GAPA(C0=__builtin_amdgcn_mfma_f32_32x32x16_bf16(kf[2],qr[1],C0,0,0,0),   P0[10],P0[11],P0[12],P0[13], pw1[0]=PKW(P0,8), pw1[1]=PKW(P0,10), pw1); \
    VRD(5); SBAR(); GAPA(C1=__builtin_amdgcn_mfma_f32_32x32x16_bf16(kf[3],qr[1],C1,0,0,0),   P0[14],P0[15],P1[0],P1[1],   pw1[2]=PKW(P0,12),pw1[3]=PKW(P0,14), pw1); \
    VRD(2); SBAR(); GAPA(C0=__builtin_amdgcn_mfma_f32_32x32x16_bf16(kf[4],qr[2],C0,0,0,0),   P1[2],P1[3],P1[4],P1[5],     pw2[0]=PKW(P1,0), pw2[1]=PKW(P1,2), pw2); \
    VRD(6); SBAR(); GAPA(C1=__builtin_amdgcn_mfma_f32_32x32x16_bf16(kf[5],qr[2],C1,0,0,0),   P1[6],P1[7],P1[8],P1[9],     pw2[2]=PKW(P1,4), pw2[3]=PKW(P1,6), pw2); \
    VRD(3); SBAR(); GAPA(C0=__builtin_amdgcn_mfma_f32_32x32x16_bf16(kf[6],qr[3],C0,0,0,0),   P1[10],P1[11],P1[12],P1[13], pw3[0]=PKW(P1,8), pw3[1]=PKW(P1,10), pw3); \
    VRD(7); SBAR(); GAPA(C1=__builtin_amdgcn_mfma_f32_32x32x16_bf16(kf[7],qr[3],C1,0,0,0),   P1[14],P1[15],0.f,0.f,       pw3[2]=PKW(P1,12),pw3[3]=PKW(P1,14), pw3); \
    l_reg+=sacc2.x+sacc2.y; \
    MSHIFT(); if(GK){DMA_K((t)+3,sl_cur);} if(GV){DMA_V((t)+1,sl_next);} \
    CMASK(C0,C1,t); \
    { float a=MX3(C0[0],C0[1],C1[0]),b=MX3(C0[2],C0[3],C1[1]); a=MX3(a,C1[2],C1[3]); \
      _Pragma("unroll") for(int r=4;r<16;r+=4){a=MX3(a,C0[r],C0[r+1]);b=MX3(b,C0[r+2],C0[r+3]);a=MX3(a,C1[r],C1[r+1]);b=MX3(b,C1[r+2],C1[r+3]);} \
      float rm=__builtin_fmaxf(a,b); { auto rr=__builtin_amdgcn_permlane32_swap(__float_as_uint(rm),__float_as_uint(rm),false,false); rm=__builtin_fmaxf(__uint_as_float(rr[0]),__uint_as_float(rr[1])); } \
      resc=false; \
      if(DV) rm-=mhat; \
      if(__builtin_expect(__any(rm>(float)THRL),0)){ const float dl=__builtin_fmaxf(rm,0.f); mhat+=dl; \
        if(!DV){ _Pragma("unroll") for(int r=0;r<16;++r){C0[r]-=dl;C1[r]-=dl;} \
        _Pragma("unroll") for(int r=0;r<16;++r)negm[r]=-mhat; asm volatile("":"+v"(negm)); } \
        const float f=__builtin_amdgcn_exp2f(-dl); l_reg*=f; if(hi==0)wsf[r32]=f; resc=true; } } \
    SBAR(); \
    GAPB(o[0]=__builtin_amdgcn_mfma_f32_32x32x16_bf16(PAF(0),VFR(0),o[0],0,0,0), C0,0,mw0); VRD2(0); \
    GAPB(o[1]=__builtin_amdgcn_mfma_f32_32x32x16_bf16(PAF(0),VFR(4),o[1],0,0,0), C0,4,mw0); VRD2(4); \
    KRD(GL,0); GAPB(o[0]=__builtin_amdgcn_mfma_f32_32x32x16_bf16(PAF(1),VFR(1),o[0],0,0,0), C0,8,mw0); VRD2(1); \
    KRD(GL,1); GAPB(o[1]=__builtin_amdgcn_mfma_f32_32x32x16_bf16(PAF(1),VFR(5),o[1],0,0,0), C0,12,mw0); VRD2(5); \
    KRD(GL,2); GAPB(o[0]=__builtin_amdgcn_mfma_f32_32x32x16_bf16(PAF(2),VFR(2),o[0],0,0,0), C1,0,mw1); VRD2(2); \
    KRD(GL,3); GAPB(o[1]=__builtin_amdgcn_mfma_f32_32x32x16_bf16(PAF(2),VFR(6),o[1],0,0,0), C1,4,mw1); VRD2(6); \
    GAPB(o[0]=__builtin_amdgcn_mfma_f32_32x32x16_bf16(PAF(3),VFR(3),o[0],0,0,0), C1,8,mw1); VRD2(3); \
    GAPB(o[1]=__builtin_amdgcn_mfma_f32_32x32x16_bf16(PAF(3),VFR(7),o[1],0,0,0), C1,12,mw1); VRD2(7); \
    if(DV){ \
      o[2]=__builtin_amdgcn_mfma_f32_32x32x16_bf16(PAF(0),VFR(0),o[2],0,0,0); o[3]=__builtin_amdgcn_mfma_f32_32x32x16_bf16(PAF(0),VFR(4),o[3],0,0,0); \
      o[2]=__builtin_amdgcn_mfma_f32_32x32x16_bf16(PAF(1),VFR(1),o[2],0,0,0); o[3]=__builtin_amdgcn_mfma_f32_32x32x16_bf16(PAF(1),VFR(5),o[3],0,0,0); \
      o[2]=__builtin_amdgcn_mfma_f32_32x32x16_bf16(PAF(2),VFR(2),o[2],0,0,0); o[3]=__builtin_amdgcn_mfma_f32_32x32x16_bf16(PAF(2),VFR(6),o[3],0,0,0); \
      o[2]=__builtin_amdgcn_mfma_f32_32x32x16_bf16(PAF(3),VFR(3),o[2],0,0,0); o[3]=__builtin_amdgcn_mfma_f32_32x32x16_bf16(PAF(3),VFR(7),o[3],0,0,0); SBAR(); } \
    }while(0)
  int t=1;
  #undef CMASK
  #define CMASK(P0,P1,t) do{}while(0)
  for(;t+5<NT;t+=2){
    STEP(pB0,pB1,pA0,pA1,t,true,true,true);     WAIT_BAR_KV(); RESC(); ROT();
    STEP(pA0,pA1,pB0,pB1,t+1,true,true,true);   WAIT_BAR_KV(); RESC(); ROT();
  }
  #undef CMASK
  #define CMASK(P0,P1,t) do{int jb_=(t)-(NT-4); if(jb_>=0)cmask(P0,P1,jb_,qrel,hi);}while(0)
  #define ENDW(tt) do{ if((tt)+3<NT){WAIT_BAR_KV();} else if((tt)+2<NT){WAIT_BAR_V();} else {WAIT_BAR(0);} }while(0)
  for(;t+3<NT;t+=2){
    STEP(pB0,pB1,pA0,pA1,t,(t+3<NT),(t+1<NT),(t+1<NT));       ENDW(t);   RESC(); ROT();
    STEP(pA0,pA1,pB0,pB1,t+1,(t+4<NT),(t+2<NT),(t+2<NT));     ENDW(t+1); RESC(); ROT();
  }
  STEP(pB0,pB1,pA0,pA1,NT-3,false,true,true);   ENDW(NT-3); RESC(); ROT();
  if(wid>=4){
    STEP(pA0,pA1,pB0,pB1,NT-2,false,true,true);   ENDW(NT-2); RESC(); ROT();
    if(wid>=6){ STEP(pB0,pB1,pA0,pA1,NT-1,false,false,false); RESC(); } else { pB0=pA0; pB1=pA1; sl_cur=sl_prev; }
  } else { DMA_V(NT-1,sl_next); ENDW(NT-2); ROT(); sl_cur=sl_next; }
  {
  { float sacc=pB0[0]+pB0[1]; _Pragma("unroll") for(int r=2;r<16;++r)sacc+=pB0[r]; _Pragma("unroll") for(int r=0;r<16;++r)sacc+=pB1[r]; l_reg+=sacc;
    pw0=(u32x4){PKW(pB0,0),PKW(pB0,2),PKW(pB0,4),PKW(pB0,6)};pw1=(u32x4){PKW(pB0,8),PKW(pB0,10),PKW(pB0,12),PKW(pB0,14)};pw2=(u32x4){PKW(pB1,0),PKW(pB1,2),PKW(pB1,4),PKW(pB1,6)};pw3=(u32x4){PKW(pB1,8),PKW(pB1,10),PKW(pB1,12),PKW(pB1,14)};
    SBAR(); pv<NO>(o,vb0+VSL*sl_cur,PAF(0),PAF(1),PAF(2),PAF(3)); }
  }
  #undef PKW
  #undef PAF
  #undef VFR
  #undef PIN
  #undef MX3
  #undef GAPA
  #undef GAPB
  #undef EX
  #undef QKC0
  #undef VRD
  #undef KRD
  #undef VRD2
  #undef STEP
  #undef ENDW
  {auto rr=__builtin_amdgcn_permlane32_swap(__float_as_uint(l_reg),__float_as_uint(l_reg),false,false);l_reg=__uint_as_float(rr[0])+__uint_as_float(rr[1]);}
  if(hi==0)wsf[32+r32]=l_reg;asm volatile("s_waitcnt lgkmcnt(0)":::"memory");
  float rli[16];
  #pragma unroll
  for(int r=0;r<16;++r)rli[r]=__builtin_amdgcn_rcpf(wsf[32+crow(r,hi)]);
  bf16*Ow=Oc+(rowbase+q0+wid*QBLK)*DM;
  if(DV&&cmb){
    bf16*stg=(bf16*)(shm+LO)+wid*2048; const bf16*Pw=Oprev+(rowbase+q0+wid*QBLK)*DM; const int ch=lane&7;
    float dd[2][4][8],ssq[4]={0.f,0.f,0.f,0.f},gg[2][8];
    #pragma unroll
    for(int hh=0;hh<2;++hh){ const float4 g0=*reinterpret_cast<const float4*>(subg+hh*64+ch*8),g1=*reinterpret_cast<const float4*>(subg+hh*64+ch*8+4);
      gg[hh][0]=g0.x*oscale;gg[hh][1]=g0.y*oscale;gg[hh][2]=g0.z*oscale;gg[hh][3]=g0.w*oscale;gg[hh][4]=g1.x*oscale;gg[hh][5]=g1.y*oscale;gg[hh][6]=g1.z*oscale;gg[hh][7]=g1.w*oscale; }
    #pragma unroll
    for(int hh=0;hh<2;++hh){
      u32x4 pv4[4];
      #pragma unroll
      for(int i=0;i<4;++i)pv4[i]=*reinterpret_cast<const u32x4*>(Pw+(long)(i*8+(lane>>3))*DM+hh*64+ch*8);
      #pragma unroll
      for(int r=0;r<16;++r){const int orow=crow(r,hi);
        #pragma unroll
        for(int d0=0;d0<2;++d0)stg[orow*64+d0*32+r32]=__float2bfloat16(o[2*hh+d0][r]*rli[r]);}
      asm volatile("s_waitcnt lgkmcnt(0)":::"memory");
      #pragma unroll
      for(int i=0;i<4;++i){const int row=i*8+(lane>>3); const u32x4 v=*(const u32x4*)(stg+row*64+ch*8); const u32x4 p=pv4[i];
        #pragma unroll
        for(int j=0;j<4;++j){ const float a0=__uint_as_float(p[j]<<16),a1=__uint_as_float(p[j]&0xffff0000u),b0=__uint_as_float(v[j]<<16),b1=__uint_as_float(v[j]&0xffff0000u);
          const float e0=a0-lam*b0,e1=a1-lam*b1; dd[hh][i][2*j]=e0; dd[hh][i][2*j+1]=e1; ssq[i]+=e0*e0+e1*e1; } }
      asm volatile("s_waitcnt lgkmcnt(0)":::"memory"); }
    #pragma unroll
    for(int i=0;i<4;++i){ float q=ssq[i];
      q+=__int_as_float(__builtin_amdgcn_ds_swizzle(__float_as_int(q),0x041F)); q+=__int_as_float(__builtin_amdgcn_ds_swizzle(__float_as_int(q),0x081F)); q+=__int_as_float(__builtin_amdgcn_ds_swizzle(__float_as_int(q),0x101F));
      const float rn=__builtin_amdgcn_rsqf(q*(1.0f/128.0f)+1e-6f); const int row=i*8+(lane>>3);
      #pragma unroll
      for(int hh=0;hh<2;++hh){ u32x4 w;
        #pragma unroll
        for(int j=0;j<4;++j)w[j]=cvtpk_s(dd[hh][i][2*j]*rn*gg[hh][2*j],dd[hh][i][2*j+1]*rn*gg[hh][2*j+1]);
        ATTN_STORE16(Ow+(long)row*DM+hh*64+ch*8,w); } }
  } else
  { bf16*stg=(bf16*)(shm+LO)+wid*2048;
    #pragma unroll
    for(int hh=0;hh<NO/2;++hh){
      #pragma unroll
      for(int r=0;r<16;++r){const int orow=crow(r,hi);
        #pragma unroll
        for(int d0=0;d0<2;++d0)stg[orow*64+d0*32+r32]=__float2bfloat16(o[2*hh+d0][r]*rli[r]);}
      asm volatile("s_waitcnt lgkmcnt(0)":::"memory");
      #pragma unroll
      for(int i=0;i<4;++i){const int row=i*8+(lane>>3),ch=lane&7; const u32x4 v=*(const u32x4*)(stg+row*64+ch*8); ATTN_STORE16(Ow+(long)row*DM+hh*64+ch*8,v);}
      asm volatile("s_waitcnt lgkmcnt(0)":::"memory"); } }
  asm volatile("s_waitcnt lgkmcnt(0)\n\ts_barrier":::"memory");
  #undef DMA_K
  #undef DMA_V
  #undef CMASK
  #undef START
  #undef RESC
  #undef ROT
  #undef WAIT_BAR_KV
  #undef WAIT_BAR_V
  #undef MLOAD
  #undef MSHIFT
  #undef MBIT
  #undef MAND
}
constexpr int ATTN_LDS_BYTES=LDS_BYTES;
#undef SBAR
#undef WAIT_BAR
}
#define GAS __attribute__((address_space(1)))
#define LAS __attribute__((address_space(3)))
typedef unsigned short bf16;
typedef unsigned v4u __attribute__((ext_vector_type(4)));
typedef float f32x4 __attribute__((ext_vector_type(4)));
typedef short bf16x8 __attribute__((ext_vector_type(8)));
typedef GAS unsigned gu32;
typedef GAS unsigned long long gu64;
#define RLX_AGENT __ATOMIC_RELAXED, __HIP_MEMORY_SCOPE_AGENT
#define LDS_WAIT() asm volatile("s_waitcnt lgkmcnt(0)" ::: "memory")
#define VM_WAIT() asm volatile("s_waitcnt vmcnt(0)" ::: "memory")
__device__ __forceinline__ unsigned long long rt() { return __builtin_amdgcn_s_memrealtime(); }
__device__ __forceinline__ unsigned f2bf(float f) { unsigned u = __builtin_bit_cast(unsigned, f); return (u + 0x7fffu + ((u >> 16) & 1u)) >> 16; }
__device__ __forceinline__ unsigned pk2(float lo, float hi) { return f2bf(lo) | (f2bf(hi) << 16); }

#define XB_TMO      128
#define XB_XCNT(j)  (256  + 64 * (j))
#define XB_XSUB(j)  (1280 + 64 * (j))
#define XB_XGEN(j)  (2304 + 64 * (j))
#define XB_TOP      3328
#define XB_TOPGEN   3392
#define XCD_BAR_WORDS 3456
#define XB_SPIN_CAP (1u << 18)

__device__ __forceinline__ unsigned xb_ld(unsigned* p)              { return __hip_atomic_load(p, __ATOMIC_RELAXED, __HIP_MEMORY_SCOPE_AGENT); }
__device__ __forceinline__ unsigned xb_add(unsigned* p, unsigned v) { return __hip_atomic_fetch_add(p, v, __ATOMIC_RELAXED, __HIP_MEMORY_SCOPE_AGENT); }
__device__ __forceinline__ unsigned xb_xcc_id() { return (unsigned)__builtin_amdgcn_s_getreg((3 << 11) | 20) & 0xFu; }
#define XB_SPIN(cond, bar) do { unsigned _sp = 0; while (cond) { __builtin_amdgcn_s_sleep(1); \
    if ((++_sp & 255u) == 0u) { if (xb_ld(&(bar)[XB_TMO])) break; if (_sp > XB_SPIN_CAP) { atomicAdd(&(bar)[XB_TMO], 1u); break; } } } } while (0)

struct XcdBarrier {
    unsigned* bar; unsigned x;
    volatile LAS unsigned* st;
};

__device__ __forceinline__ XcdBarrier xcd_barrier_post(unsigned* bar, volatile LAS unsigned* st) {
    XcdBarrier b; b.bar = bar; b.x = xb_xcc_id(); b.st = st;
    if (threadIdx.x == 0) (void)xb_add(&bar[XB_XCNT(b.x)], 1u);
    return b;
}
__device__ __forceinline__ void xcd_barrier_complete(unsigned* bar, unsigned x, unsigned& nloc, unsigned& nx) {
    const unsigned G = gridDim.x * gridDim.y * gridDim.z;
    unsigned sum, cnt, mine, sp = 0u;
    for (;;) {
        sum = 0u; cnt = 0u; mine = 0u;
#pragma unroll
        for (unsigned j = 0; j < 16; ++j) { const unsigned c = xb_ld(&bar[XB_XCNT(j)]); sum += c; cnt += (c > 0u) ? 1u : 0u; mine = (j == x) ? c : mine; }
        if (sum == G) break;
        __builtin_amdgcn_s_sleep(1);
        if ((++sp & 255u) == 0u) { if (xb_ld(&bar[XB_TMO])) break; if (sp > XB_SPIN_CAP) { atomicAdd(&bar[XB_TMO], 1u); break; } }
    }
    nloc = mine > 0u ? mine : 1u; nx = cnt > 0u ? cnt : 1u;
}

__device__ __forceinline__ void xcd_barrier(const XcdBarrier& b, const bool leader_thread  ) {
    asm volatile("s_waitcnt vmcnt(0)" ::: "memory");
    __syncthreads();
    if (leader_thread) {
        unsigned* bar = b.bar;
        __builtin_amdgcn_s_waitcnt(0);
        unsigned nloc = b.st[0], nx = b.st[1];
        if (nloc == 0u) { xcd_barrier_complete(bar, b.x, nloc, nx); b.st[0] = nloc; b.st[1] = nx; }
        const unsigned old = xb_add(&bar[XB_XSUB(b.x)], 1u);
        const unsigned gen = old / nloc;
        if (old + 1u == (gen + 1u) * nloc) {
            __builtin_amdgcn_fence(__ATOMIC_RELEASE, "agent");
            asm volatile("s_waitcnt vmcnt(0)" ::: "memory");
            const unsigned og = xb_add(&bar[XB_TOP], 1u);
            const unsigned tg = og / nx;
            if (og + 1u == (tg + 1u) * nx) xb_add(&bar[XB_TOPGEN], 1u);
            else XB_SPIN(xb_ld(&bar[XB_TOPGEN]) == tg, bar);
            __builtin_amdgcn_fence(__ATOMIC_ACQUIRE, "agent");
            xb_add(&bar[XB_XGEN(b.x)], 1u);
            asm volatile("s_waitcnt vmcnt(0)" ::: "memory");
        } else {
            XB_SPIN(xb_ld(&bar[XB_XGEN(b.x)]) == gen, bar);
            __builtin_amdgcn_fence(__ATOMIC_ACQUIRE, "agent");
            asm volatile("s_waitcnt vmcnt(0)" ::: "memory");
        }
    }
    __syncthreads();
}
namespace topk {
#define TK_LAS __attribute__((address_space(3)))
typedef short bf16x8 __attribute__((ext_vector_type(8)));
typedef float f32x16 __attribute__((ext_vector_type(16)));
typedef float f32x4 __attribute__((ext_vector_type(4)));
typedef float f32x2 __attribute__((ext_vector_type(2)));
__device__ __forceinline__ unsigned fkey(float s) { const unsigned uu = __float_as_uint(s); return uu ^ ((unsigned)((int)uu >> 31) | 0x80000000u); }
__device__ __forceinline__ float kfloat(unsigned k) { return __uint_as_float((k & 0x80000000u) ? (k ^ 0x80000000u) : ~k); }
typedef unsigned u32x4 __attribute__((ext_vector_type(4)));
typedef unsigned short bf16_t;
constexpr int KSEL = 256;
__device__ __forceinline__ int crow0(int r) { return (r & 3) + 8 * (r >> 2); }
__device__ __forceinline__ unsigned half_sum(unsigned c) { auto rr = __builtin_amdgcn_permlane32_swap(c, c, false, false); return rr[0] + rr[1]; }
__device__ __forceinline__ unsigned half_or(unsigned c) { auto rr = __builtin_amdgcn_permlane32_swap(c, c, false, false); return rr[0] | rr[1]; }

__device__ __forceinline__ void unit(int b, int g, const bf16_t* __restrict__ IQ, const bf16_t* __restrict__ IK, const float* __restrict__ IW, unsigned* __restrict__ MASK, TK_LAS unsigned char* lds, const int wave_in) {
    int lane_; asm volatile("v_mbcnt_lo_u32_b32 %0, -1, 0\n\tv_mbcnt_hi_u32_b32 %0, -1, %0" : "=v"(lane_));
    const int lane = lane_, r32 = lane & 31, hi = lane >> 5;
    const int w = wave_in, tid = w * 64 + lane;
    const int nt = g / 2 + 1;
    const int ntb = 4 * (g / 8) + 4;
    const int q = 32 * g + r32;
    const size_t rowq = (size_t)b * 2048 + q;
    const bool dotopk = (g >= 8);
    TK_LAS unsigned* cnt = (TK_LAS unsigned*)lds;
    TK_LAS unsigned* flag = (TK_LAS unsigned*)(lds + 2048);
    f32x2 sc[4][2][8];
    unsigned T = 0u, X = 2047u;
    if (dotopk) {
        if (tid == 0) flag[0] = 0u;
        const f32x4 wq = *(const f32x4*)(IW + rowq * 4);
        TK_LAS unsigned char* qlds = lds + 4096;
        { const bf16_t* qg = IQ + ((size_t)b * 2048 + 32 * g) * 256;
#pragma unroll
          for (int i = 0; i < 2; ++i) { const int pc = tid + 512 * i, row = pc >> 5, c16 = pc & 31; const u32x4 v = *(const u32x4*)(qg + row * 256 + c16 * 8); *(TK_LAS u32x4*)(qlds + row * 528 + c16 * 16) = v; } }
        __syncthreads();
        const TK_LAS unsigned char* qrd = qlds + r32 * 528 + hi * 16;
        const bf16_t* kbase = IK + (size_t)b * (2048 * 64) + lane * 8;
        bf16x8 kf[2][4];
        if (w < nt) {
#pragma unroll
            for (int d0 = 0; d0 < 4; ++d0) kf[0][d0] = *(const bf16x8*)(kbase + (size_t)(2 * w) * 2048 + d0 * 512);
        }
#pragma unroll
        for (int st = 0; st < 8; ++st) {
            const int jj = st >> 1, p = st & 1, tile = w + 8 * jj;
            if (st + 1 < 8) { const int jn = (st + 1) >> 1, pn = (st + 1) & 1, tn = w + 8 * jn;
                if (tn < nt) {
#pragma unroll
                    for (int d0 = 0; d0 < 4; ++d0) kf[(st + 1) & 1][d0] = *(const bf16x8*)(kbase + (size_t)(2 * tn + pn) * 2048 + d0 * 512);
                } }
            if (tile < nt) {
                f32x16 s = {0.f, 0.f, 0.f, 0.f, 0.f, 0.f, 0.f, 0.f, 0.f, 0.f, 0.f, 0.f, 0.f, 0.f, 0.f, 0.f};
#pragma unroll
                for (int h = 0; h < 4; ++h) {
                    f32x16 pp = {0.f, 0.f, 0.f, 0.f, 0.f, 0.f, 0.f, 0.f, 0.f, 0.f, 0.f, 0.f, 0.f, 0.f, 0.f, 0.f};
#pragma unroll
                    for (int d0 = 0; d0 < 4; ++d0) { const bf16x8 qf = *(const TK_LAS bf16x8*)(qrd + h * 128 + d0 * 32); pp = __builtin_amdgcn_mfma_f32_32x32x16_bf16(kf[st & 1][d0], qf, pp, 0, 0, 0); }
                    const float wh = wq[h];
#pragma unroll
                    for (int r = 0; r < 16; ++r) s[r] = __builtin_fmaf(wh, __builtin_fmaxf(pp[r], 0.f), s[r]);
                }
#pragma unroll
                for (int r = 0; r < 8; ++r) {
                    const float kp0 = (float)(64 * tile + 32 * p + crow0(2 * r) + 4 * hi + 1) * -0x1p-100f, kp1 = (float)(64 * tile + 32 * p + crow0(2 * r + 1) + 4 * hi + 1) * -0x1p-100f;
                    sc[jj][p][r] = (f32x2){s[2 * r] == 0.f ? kp0 : s[2 * r], s[2 * r + 1] == 0.f ? kp1 : s[2 * r + 1]}; }
                if (tile == nt - 1) {
#pragma unroll
                    for (int r = 0; r < 16; ++r) { const int kpos = 64 * tile + 32 * p + crow0(r) + 4 * hi; if (kpos > q) sc[jj][p][r >> 1][r & 1] = -INFINITY; }
                }
            } else {
#pragma unroll
                for (int r = 0; r < 8; ++r) sc[jj][p][r] = (f32x2){-INFINITY, -INFINITY};
            }
        }
        int par = 0;
        unsigned prefix = 0u, ge = 0u;
#define TK_REDUCE(c, tot) do { const unsigned c_ = half_sum(c); if (hi == 0) cnt[par * 256 + r32 * 8 + w] = c_; __syncthreads(); \
            const u32x4 a_ = *(const TK_LAS u32x4*)(cnt + par * 256 + r32 * 8), b_ = *(const TK_LAS u32x4*)(cnt + par * 256 + r32 * 8 + 4); \
            tot = ((a_.x + a_.y) + (a_.z + a_.w)) + ((b_.x + b_.y) + (b_.z + b_.w)); par ^= 1; } while (0)
        const f32x2 big2 = {0x1p100f, 0x1p100f};
        for (int bit = 31; bit >= 0; --bit) {
            const unsigned cand = prefix | (1u << bit);
            const float addend = (cand == 0x80000000u) ? 1.0f : -kfloat(cand - 1u) * 0x1p100f;
            const f32x2 add2 = {addend, addend};
            f32x2 c2 = {0.f, 0.f}, c3 = {0.f, 0.f};
#pragma unroll
            for (int jj = 0; jj < 4; ++jj) if (w + 8 * jj < nt) {
#pragma unroll
                for (int p = 0; p < 2; ++p)
#pragma unroll
                    for (int r = 0; r < 8; r += 2) { f32x2 i0, i1;
                        asm("v_pk_fma_f32 %2, %4, %6, %7 op_sel_hi:[1,0,0] clamp\n\tv_pk_fma_f32 %3, %5, %6, %7 op_sel_hi:[1,0,0] clamp\n\tv_pk_add_f32 %0, %0, %2\n\tv_pk_add_f32 %1, %1, %3"
                            : "+v"(c2), "+v"(c3), "=&v"(i0), "=&v"(i1) : "v"(sc[jj][p][r]), "v"(sc[jj][p][r + 1]), "v"(big2), "v"(add2)); }
            }
            c2 += c3;
            const unsigned c = (unsigned)(c2.x + c2.y);
            unsigned tot; TK_REDUCE(c, tot);
            if (tot >= (unsigned)KSEL) { prefix = cand; ge = tot; }
            if (__all(ge == (unsigned)KSEL)) break;
        }
        T = prefix;
#pragma unroll
        for (int jj = 0; jj < 4; ++jj) if (w + 8 * jj < nt) {
#pragma unroll
            for (int p = 0; p < 2; ++p)
#pragma unroll
                for (int r = 0; r < 8; ++r) { f32x2 v = sc[jj][p][r]; v.x = __uint_as_float(fkey(v.x)); v.y = __uint_as_float(fkey(v.y)); sc[jj][p][r] = v; }
        }
#define TK_KEY(jj, p, r) __float_as_uint(sc[jj][p][(r) >> 1][(r) & 1])
        if (ge != (unsigned)KSEL) flag[0] = 1u;
        __syncthreads();
        const bool tie = flag[0] != 0u;
        if (tie) {
            unsigned c = 0u;
#pragma unroll
            for (int jj = 0; jj < 4; ++jj) if (w + 8 * jj < nt) {
#pragma unroll
                for (int p = 0; p < 2; ++p)
#pragma unroll
                    for (int r = 0; r < 16; ++r) c += (TK_KEY(jj, p, r) == T) ? 1u : 0u;
            }
            unsigned ceq; TK_REDUCE(c, ceq);
            const unsigned need = (unsigned)KSEL - (ge - ceq);
            unsigned px = 0u;
            for (int bit = 10; bit >= 0; --bit) {
                const unsigned cand = px | (1u << bit);
                unsigned c2 = 0u;
#pragma unroll
                for (int jj = 0; jj < 4; ++jj) if (w + 8 * jj < nt) {
#pragma unroll
                    for (int p = 0; p < 2; ++p)
#pragma unroll
                        for (int r = 0; r < 16; ++r) { const unsigned kpos = (unsigned)(64 * (w + 8 * jj) + 32 * p + crow0(r) + 4 * hi); c2 += (TK_KEY(jj, p, r) == T && kpos < cand) ? 1u : 0u; }
                }
                unsigned tot; TK_REDUCE(c2, tot);
                if (tot < need) px = cand;
            }
            X = px;
        }
#undef TK_REDUCE
    }
#pragma unroll
    for (int jj = 0; jj < 4; ++jj) {
        const int tile = w + 8 * jj;
        if (tile < ntb) {
            unsigned w0 = 0u, w1 = 0u;
            if (tile < nt) {
#pragma unroll
                for (int r = 0; r < 16; ++r) {
                    const int kpos = 64 * tile + crow0(r) + 4 * hi;
                    bool s0, s1;
                    if (dotopk) { const unsigned k0 = TK_KEY(jj, 0, r), k1 = TK_KEY(jj, 1, r);
                        s0 = (k0 > T) || (k0 == T && (unsigned)kpos <= X); s1 = (k1 > T) || (k1 == T && (unsigned)(kpos + 32) <= X); }
                    else { s0 = kpos <= q; s1 = kpos + 32 <= q; }
                    w0 |= (s0 ? 1u : 0u) << crow0(r); w1 |= (s1 ? 1u : 0u) << crow0(r);
                }
                w0 <<= 4 * hi; w1 <<= 4 * hi;
                w0 = half_or(w0); w1 = half_or(w1);
            }
            if (hi == 0) *(uint2*)(MASK + (((size_t)(b * 64 + g) * 32 + tile) * 64 + r32 * 2)) = make_uint2(w0, w1);
        }
    }
    __syncthreads();
}
#undef TK_LAS
#undef TK_KEY
}
constexpr int NB = 32, SEQ = 2048, DMODEL = 1024, M = NB * SEQ;
constexpr int NIN = 5632;
constexpr int DIN = 5444;
constexpr int FF = 2816, NF1 = 2 * FF;
constexpr int NLAYER = 2, NPHASE = 1 + 8 * NLAYER;
constexpr float LAM_INIT0 = 0.2f, LAM_INIT1 = 0.35550906759096934f;
#ifndef MK_PER_PHASE
#define MK_PER_PHASE 0
#endif

constexpr size_t MiB = 1u << 20;
constexpr size_t WS_CTL = 0, CTL_ZERO_BYTES = 64 * 1024;
constexpr size_t WS_W = 2 * MiB, W_LAYER = 32 * MiB;
constexpr size_t OFF_IN = 0, OFF_UA = 11 * MiB, OFF_UB = 12 * MiB, OFF_O = 13 * MiB, OFF_F1 = 15 * MiB, OFF_F2 = 26 * MiB;
constexpr size_t WS_SS = 66 * MiB;
constexpr size_t WS_ROPE = 74 * MiB;
constexpr size_t WS_MASK = 90 * MiB, MASK_LAYER = 16 * MiB;
constexpr size_t WS_IW = 122 * MiB, WS_IK = 124 * MiB, WS_IQ = 132 * MiB;
constexpr size_t WS_XB = 164 * MiB;
constexpr size_t WS_AQ = 292 * MiB, WS_AK = 356 * MiB, WS_AV = 420 * MiB, WS_BQ = 484 * MiB, WS_BK = 548 * MiB, WS_BV = 612 * MiB, WS_G = 676 * MiB, WS_END = 932 * MiB;
constexpr size_t WS_YA = WS_AQ, WS_YB = WS_BQ, WS_TMP = WS_AK, WS_MRG = WS_BK, WS_ACT = WS_AQ;
static_assert(WS_ACT + (size_t)M * FF * 2 <= WS_G, "ACT overlay must stay clear of the gates");

constexpr int NWAVES = 8;
constexpr int RING_BYTES = 131072, LDSCTL_OFF = RING_BYTES, MISC_OFF = LDSCTL_OFF + 320, LDS_BYTES = 147456;
constexpr int CW_BAR = 4096;
constexpr int SCL_OFF = 131072 + 1024 + 256;

struct TrItem { const float* W; const float* gain; bf16* WT; int Nsrc, k0, c0, nv, K, p0; };
__device__ __forceinline__ void tr_load(const TrItem& t, f32x4 (&v)[8], float (&gk)[8], int lane) {
    const int c4 = lane & 7, r8 = lane >> 3; const bool ok = 4 * c4 < t.nv;
#pragma unroll
    for (int i = 0; i < 8; ++i) { const int kk = 8 * i + r8; v[i] = (f32x4){0.f, 0.f, 0.f, 0.f};
        if (ok) v[i] = *(const GAS f32x4*)(t.W + (size_t)(t.k0 + kk) * t.Nsrc + t.c0 + 4 * c4);
        gk[i] = t.gain ? t.gain[t.k0 + kk] : 1.0f; }
}
__device__ __forceinline__ void tr_store(const TrItem& t, const f32x4 (&v)[8], const float (&gk)[8], LAS float* scr, int lane) {
    const int c4 = lane & 7, r8 = lane >> 3;
#pragma unroll
    for (int i = 0; i < 8; ++i) { const int kk = 8 * i + r8; LAS float* s_ = scr + kk * 33 + 4 * c4; s_[0] = v[i].x * gk[i]; s_[1] = v[i].y * gk[i]; s_[2] = v[i].z * gk[i]; s_[3] = v[i].w * gk[i]; }
    LDS_WAIT(); asm volatile("" ::: "memory");
    const int c = lane & 7;
#pragma unroll
    for (int jj = 0; jj < 4; ++jj) { const int n = (lane >> 3) + 8 * jj; const LAS float* s = scr + (8 * c) * 33 + n;
        v4u o; o.x = pk2(s[0 * 33], s[1 * 33]); o.y = pk2(s[2 * 33], s[3 * 33]); o.z = pk2(s[4 * 33], s[5 * 33]); o.w = pk2(s[6 * 33], s[7 * 33]);
        *(GAS v4u*)(t.WT + (size_t)(t.p0 + n) * t.K + t.k0 + 8 * c) = o; }
    LDS_WAIT(); asm volatile("" ::: "memory");
}
__device__ __forceinline__ void src_in(int tile, int s, int bj, int& c0, int& nv) {
    const int d0 = 32 * bj; nv = 32;
    if (tile < 2) c0 = (tile * 4 + s) * 64 + d0;
    else if (tile < 4) c0 = 512 + ((tile - 2) * 4 + s) * 64 + d0;
    else if (tile < 6) c0 = 1024 + ((tile - 4) * 4 + s) * 64 + d0;
    else if (tile == 6) c0 = 1536 + s * 64 + d0;
    else if (tile == 7) { if (s == 0) c0 = 1792 + d0; else if (s == 1 && bj == 0) { c0 = 1856; nv = 4; } else { c0 = 0; nv = 0; } }
    else if (tile < 10) c0 = 1860 + ((tile - 8) * 4 + s) * 64 + d0;
    else if (tile < 12) c0 = 2372 + ((tile - 10) * 4 + s) * 64 + d0;
    else if (tile < 14) c0 = 2884 + ((tile - 12) * 4 + s) * 64 + d0;
    else c0 = 3396 + ((tile - 14) * 4 + s) * 64 + d0;
}
__device__ __forceinline__ float wave_sum(float v) {
    v += __int_as_float(__builtin_amdgcn_ds_swizzle(__float_as_int(v), 0x041F)); v += __int_as_float(__builtin_amdgcn_ds_swizzle(__float_as_int(v), 0x081F));
    v += __int_as_float(__builtin_amdgcn_ds_swizzle(__float_as_int(v), 0x101F)); v += __int_as_float(__builtin_amdgcn_ds_swizzle(__float_as_int(v), 0x201F));
    v += __int_as_float(__builtin_amdgcn_ds_swizzle(__float_as_int(v), 0x401F)); return epi::sum_halves(v);
}
__device__ __forceinline__ int lane_id_asm() { int l; asm volatile("v_mbcnt_lo_u32_b32 %0, -1, 0\n\tv_mbcnt_hi_u32_b32 %0, -1, %0" : "=v"(l)); return l; }
__constant__ double INV_FREQ[32] = {1.0, 0.7498942093324559, 0.5623413251903491, 0.4216965034285822, 0.31622776601683794, 0.23713737056616552, 0.1778279410038923, 0.1333521432163324, 0.1, 0.07498942093324558,
    0.05623413251903491, 0.042169650342858224, 0.03162277660168379, 0.023713737056616554, 0.01778279410038923, 0.01333521432163324, 0.01, 0.007498942093324558, 0.005623413251903491, 0.004216965034285823,
    0.0031622776601683794, 0.0023713737056616554, 0.0017782794100389228, 0.001333521432163324, 0.001, 0.0007498942093324559, 0.0005623413251903491, 0.00042169650342858224, 0.00031622776601683794,
    0.00023713737056616554, 0.00017782794100389227, 0.0001333521432163324};
__device__ __forceinline__ void sincos_d(double x, float& c, float& s) {
    const double n = __builtin_rint(x * 0.15915494309189535);
    double r = __builtin_fma(-n, 6.283185307179586, x); r = __builtin_fma(-n, 2.4492935982947064e-16, r);
    const double r2 = r * r;
    double ts = r, ss = r, tc = 1.0, cc = 1.0;
#pragma unroll
    for (int k = 1; k <= 14; ++k) { ts *= r2 * (-1.0 / (double)((2 * k) * (2 * k + 1))); ss += ts; tc *= r2 * (-1.0 / (double)((2 * k - 1) * (2 * k))); cc += tc; }
    c = (float)cc; s = (float)ss;
}

struct Args { const float* in[18]; float* out; unsigned char* ws; int ph_lo, ph_hi; };

__device__ __forceinline__ void p0_prologue(unsigned char* ws, LAS unsigned char* ldsb, int vcu, int G, int wave, int lane) {
    LAS float* scr = (LAS float*)(ldsb + wave * 16384);
    const int gw = vcu * NWAVES + wave, NGW = G * NWAVES;
    constexpr int I_IN = 16 * 176, I_U = 8 * 32, I_O = 16 * 32, I_F1 = 16 * 176, I_F2 = 44 * 32, I_L = I_IN + 2 * I_U + I_O + I_F1 + I_F2;
    for (int ph_ = 0; ph_ < 2; ++ph_) {
    if (((ph_ ^ (wave >> 2)) & 1) == 0) {
    auto decode = [&](int it, TrItem& t) {
        const int l = it / I_L; int r = it - l * I_L;
        unsigned char* wl = ws + WS_W + (size_t)l * W_LAYER;
        if (r < I_IN) { const int kb = r / 176, pb = r - kb * 176, tile = pb >> 3, wb = pb & 7; int c0, nv; src_in(tile, wb & 3, wb >> 2, c0, nv);
            t = TrItem{epi::lds_inptr(ldsb, 3) + (size_t)l * DMODEL * DIN, epi::lds_inptr(ldsb, 2) + l * DMODEL, (bf16*)(wl + OFF_IN), DIN, 64 * kb, c0, nv, DMODEL, 32 * pb}; return; }
        r -= I_IN;
        if (r < I_U) { const int kb = r >> 5, nb = r & 31; t = TrItem{epi::lds_inptr(ldsb, 12) + (size_t)l * 512 * 1024, nullptr, (bf16*)(wl + OFF_UA), 1024, 64 * kb, 32 * nb, 32, 512, 32 * nb}; return; }
        r -= I_U;
        if (r < I_U) { const int kb = r >> 5, nb = r & 31; t = TrItem{epi::lds_inptr(ldsb, 13) + (size_t)l * 512 * 1024, nullptr, (bf16*)(wl + OFF_UB), 1024, 64 * kb, 32 * nb, 32, 512, 32 * nb}; return; }
        r -= I_U;
        if (r < I_O) { const int kb = r >> 5, nb = r & 31; t = TrItem{epi::lds_inptr(ldsb, 14) + (size_t)l * 1024 * 1024, nullptr, (bf16*)(wl + OFF_O), 1024, 64 * kb, 32 * nb, 32, 1024, 32 * nb}; return; }
        r -= I_O;
        if (r < I_F1) { const int kb = r / 176, pb = r - kb * 176, tile = pb >> 3, wb = pb & 7; const int c0 = 128 * tile + 32 * (wb & 3) + ((wb >> 2) ? FF : 0);
            t = TrItem{epi::lds_inptr(ldsb, 16) + (size_t)l * DMODEL * NF1, epi::lds_inptr(ldsb, 15) + l * DMODEL, (bf16*)(wl + OFF_F1), NF1, 64 * kb, c0, 32, DMODEL, 32 * pb}; return; }
        r -= I_F1;
        { const int kb = r >> 5, nb = r & 31; t = TrItem{epi::lds_inptr(ldsb, 17) + (size_t)l * FF * 1024, nullptr, (bf16*)(wl + OFF_F2), 1024, 64 * kb, 32 * nb, 32, FF, 32 * nb}; }
    };
    { TrItem cur, nxt; f32x4 va[8], vb[8]; float ga[8], gb[8];
      int it = gw; if (it < NLAYER * I_L) { decode(it, cur); tr_load(cur, va, ga, lane); }
      for (; it < NLAYER * I_L; it += NGW) { const bool hn = it + NGW < NLAYER * I_L;
          if (hn) { decode(it + NGW, nxt); tr_load(nxt, vb, gb, lane); }
          tr_store(cur, va, ga, scr, lane);
          if (hn) { cur = nxt;
#pragma unroll
              for (int i = 0; i < 8; ++i) { va[i] = vb[i]; ga[i] = gb[i]; } } } }
#if defined(DBG_FILL)
    { unsigned* fp = (unsigned*)(ws + DBG_FILL); for (size_t i = (size_t)gw * 64 + lane; i < (size_t)32 * MiB; i += (size_t)NGW * 64) fp[i] = 0x3f803f80u + ((unsigned)i & 0x3fu) * 0x00010001u; }
#endif
    } else {
    const float* x = epi::lds_inptr(ldsb, 0); const int* pos = (const int*)epi::lds_inptr(ldsb, 1);
    bf16* XB = (bf16*)(ws + WS_XB); float* SS0 = (float*)(ws + WS_SS); float* ROPE = (float*)(ws + WS_ROPE);
    for (int m0 = gw; m0 < M; m0 += 4 * NGW) {
        f32x4 v[4][4]; float s[4];
#pragma unroll
        for (int u = 0; u < 4; ++u) { const int m = m0 + u * NGW; const GAS f32x4* xr = (const GAS f32x4*)(x + (size_t)(m < M ? m : gw) * DMODEL) + lane;
#pragma unroll
            for (int j = 0; j < 4; ++j) v[u][j] = xr[64 * j]; }
#pragma unroll
        for (int u = 0; u < 4; ++u) { float t = 0.f;
#pragma unroll
            for (int j = 0; j < 4; ++j) t += (v[u][j].x * v[u][j].x + v[u][j].y * v[u][j].y) + (v[u][j].z * v[u][j].z + v[u][j].w * v[u][j].w);
            s[u] = wave_sum(t); }
#pragma unroll
        for (int u = 0; u < 4; ++u) { const int m = m0 + u * NGW; if (m < M) {
            GAS unsigned long long* o8 = (GAS unsigned long long*)(XB + (size_t)m * DMODEL) + lane;
#pragma unroll
            for (int j = 0; j < 4; ++j) o8[64 * j] = (unsigned long long)pk2(v[u][j].x, v[u][j].y) | ((unsigned long long)pk2(v[u][j].z, v[u][j].w) << 32);
            if (lane < 16) SS0[(size_t)m * 16 + lane] = (lane == 0) ? s[u] : 0.f; } }
    }
    { const int fi = lane & 31; int m = gw + (lane >> 5) * NGW; int pn_ = (m < M) ? pos[m] : 0;
      for (; m - (lane >> 5) * NGW < M; m += 2 * NGW) { const int pc = pn_; const int mn = m + 2 * NGW; if (mn < M) pn_ = pos[mn];
        if (m < M) { const double ang = (double)pc * INV_FREQ[fi]; float c, sn; sincos_d(ang, c, sn); const epi::h16x2 hh = {(_Float16)c, (_Float16)sn}; ((unsigned*)ROPE)[(size_t)m * 32 + fi] = __builtin_bit_cast(unsigned, hh); } } }
    }
    }
}
static_assert(epi::EI_SS == WS_SS && epi::EI_ROPE == WS_ROPE && epi::EI_IW == WS_IW && epi::EI_IK == WS_IK && epi::EI_IQ == WS_IQ && epi::EI_AQ == WS_AQ && epi::EI_AK == WS_AK && epi::EI_AV == WS_AV && epi::EI_BQ == WS_BQ && epi::EI_BK == WS_BK && epi::EI_BV == WS_BV && epi::EI_G == WS_G && epi::PTR_OFF >= MISC_OFF + 128 && epi::PTR_OFF + 18 * 8 <= SCL_OFF && SCL_OFF + 64 <= epi::RSTD_OFF && epi::RSTD_OFF + 64 + epi::RSTD_SLOTS * 1024 <= LDS_BYTES, "EpiIn offsets vs the d_ws / LDS map");
#define VNATB(b_, h_) ((long)((b_) * 4 + (h_)) * (2048 * 128) - (long)(b_) * 2048 * 512)
#define KNAT(b_, hs_) ((long)((b_) * 8 + (hs_)) * (2048 * 64) - (long)(b_) * 2048 * 512)
__global__ void __launch_bounds__(NWAVES * 64, 2) mega_fwd(Args args) {
    extern __shared__ __attribute__((aligned(16))) unsigned char lds[];
    LAS unsigned char* ldsb = (LAS unsigned char*)lds;
    volatile LAS unsigned* MISC = (volatile LAS unsigned*)(ldsb + MISC_OFF);
    const int tid = threadIdx.x; int wave_ = __builtin_amdgcn_readfirstlane(tid >> 6); asm volatile("" : "+s"(wave_)); const int wave = wave_;
    const int G = gridDim.x; const int bx = blockIdx.x;
    const int vcu = (G % 8 == 0) ? (bx % 8) * (G / 8) + bx / 8 : bx;
    unsigned char* ws = args.ws;
    gu32* ctl = (gu32*)(ws + WS_CTL);
    for (int u = tid; u < (LDS_BYTES - LDSCTL_OFF) / 4; u += NWAVES * 64) ((LAS unsigned*)(ldsb + LDSCTL_OFF))[u] = 0u;
    __syncthreads();
    if (!MK_PER_PHASE) (void)xcd_barrier_post((unsigned*)(ctl + CW_BAR), MISC + 8);
#define GRID_BAR() do { if (!MK_PER_PHASE) { XcdBarrier b_; b_.bar = (unsigned*)(SCLP(0) + WS_CTL + (size_t)CW_BAR * 4); b_.x = xb_xcc_id(); b_.st = MISC + 8; xcd_barrier(b_, wave == 0 && lane_id_asm() == 0); } } while (0)
    if (tid == 0) { LAS unsigned* sw = (LAS unsigned*)(ldsb + SCL_OFF); const unsigned long long pw = (unsigned long long)args.ws, po = (unsigned long long)args.out;
        sw[0] = (unsigned)pw; sw[1] = (unsigned)(pw >> 32); sw[2] = (unsigned)po; sw[3] = (unsigned)(po >> 32); sw[4] = (unsigned)G; sw[5] = (unsigned)bx; sw[6] = (unsigned)vcu; sw[7] = (unsigned)args.ph_lo; sw[8] = (unsigned)args.ph_hi; }
#define SCL(i) ((int)__builtin_amdgcn_readfirstlane(((const LAS unsigned*)(ldsb + SCL_OFF))[i]))
#define SCLP(i) ((unsigned char*)(GAS unsigned char*)(((unsigned long long)(unsigned)SCL((i) + 1) << 32) | (unsigned)SCL(i)))
#ifndef PH_EN
#define PH_EN 0x1ff
#endif
#define PHT(k) ((k) == 0 ? 0 : (((k) - 1) & 7) + 1)
#define IN(k) (((PH_EN >> PHT(k)) & 1) && SCL(7) <= (k) && (k) < SCL(8))
#define BOTH(k) (IN(k) && IN((k) + 1))
#ifndef DBG_REP
#define DBG_REP 0
#endif
#define NREP(t) (((DBG_REP >> (t)) & 1) ? 2 : 1)

    if (tid < 18) { const unsigned long long p = (unsigned long long)args.in[tid]; ((LAS unsigned*)(ldsb + epi::PTR_OFF))[2 * tid] = (unsigned)p; ((LAS unsigned*)(ldsb + epi::PTR_OFF))[2 * tid + 1] = (unsigned)(p >> 32); }
    __syncthreads();
#define INP(i) epi::lds_inptr(ldsb, (i))
#define WSL() unsigned char* wsl = SCLP(0); float* const outp = (float*)SCLP(2); const int Gp = SCL(4), bxp = SCL(5), vcup = SCL(6); const int wavep = wave; (void)outp; (void)Gp; (void)bxp; (void)vcup

    if (IN(0)) { for (int rep_ = 0; rep_ < NREP(0); ++rep_) { int l_ = lane_id_asm(); p0_prologue(SCLP(0), ldsb, SCL(6), SCL(4), wave, l_); } if (BOTH(0)) GRID_BAR(); }

#pragma unroll
    for (int l = 0; l < NLAYER; ++l) {
        const int pb = 1 + 8 * l;
        if (IN(pb + 0)) {
for (int rep_ = 0; rep_ < NREP(1); ++rep_) {
            WSL();
            pg8::Gemm g{(const bf16*)(wsl + WS_XB), (const bf16*)(wsl + WS_W + (size_t)l * W_LAYER + OFF_IN), M, NIN, DMODEL}; g.serp = 1; pg8::StaticOrder S; S.init(M, NIN, Gp, bxp);
            epi::rstd_prepass(ldsb, S, (const float*)(wsl + WS_SS), wavep * 64 + lane_id_asm());
            epi::EpiIn E{wsl, ldsb, l};
            pg8::gemm_phase<epi::EpiIn, pg8::StaticOrder, true, true>(ldsb, g, S, E, wavep);
}
            if (BOTH(pb + 0)) GRID_BAR();
        }
        if (IN(pb + 1)) {
{
            WSL();
            const bf16* IQ = (const bf16*)(wsl + WS_IQ); const bf16* IK = (const bf16*)(wsl + WS_IK); const float* IW = (const float*)(wsl + WS_IW); unsigned* MASK = (unsigned*)(wsl + WS_MASK + (size_t)l * MASK_LAYER);
            for (int i0 = 0;; ++i0) { const int i = (NREP(2) == 2) ? (i0 >> 1) : i0; const int L = i * Gp + vcup; if (L >= NB * 64) break;
                const int v = L & 255, ii = L >> 8, b = v >> 3, j = v & 7, g = 16 * (ii >> 1) + ((ii & 1) ? 15 - j : j);
                topk::unit(b, g, IQ, IK, IW, MASK, ldsb, wavep); }
}
            if (BOTH(pb + 1)) GRID_BAR();
        }
        if (IN(pb + 2)) {
#if !defined(NO_A)
            { WSL();
              const attn_body::bf16 *AQ = (const attn_body::bf16*)(wsl + WS_AQ), *AK = (const attn_body::bf16*)(wsl + WS_AK), *AV = (const attn_body::bf16*)(wsl + WS_AV); attn_body::bf16* YA = (attn_body::bf16*)(wsl + WS_YA);
              const unsigned* MASK = (const unsigned*)(wsl + WS_MASK + (size_t)l * MASK_LAYER);
              for (int i = 0;; ++i) { const int L = i * Gp + vcup; if (L >= NB * 64) break;
                const int v = L & 255, he = L >> 8, b = v >> 3, qb = ((v & 7) + he) & 7;
#if defined(DBG_PROBEA)
                attn_body::attn_unit<8, true, false>(b, qb, AQ + he * 64, AK + he * 64, AV + he * 64, (attn_body::bf16*)outp + he * 64, MASK, (char*)lds, wavep);
#endif
                attn_body::attn_unit<8, true, false>(b, qb, AQ + he * 64, AK + KNAT(b, he), AV + KNAT(b, he), YA + he * 64, MASK, (char*)lds, wavep); } }
#endif
#if !defined(NO_B)
for (int rep_ = 0; rep_ < NREP(3); ++rep_) {
            { WSL();
              const attn_body::bf16 *BQ = (const attn_body::bf16*)(wsl + WS_BQ), *BK = (const attn_body::bf16*)(wsl + WS_BK), *BV = (const attn_body::bf16*)(wsl + WS_BV); attn_body::bf16* OB = (attn_body::bf16*)outp;
              const float* dl = INP(10) + l * 256; const float lam_init = (l == 0) ? LAM_INIT0 : LAM_INIT1; const int ln_ = lane_id_asm();
              const float lam = expf(wave_sum(dl[ln_] * dl[64 + ln_])) - expf(wave_sum(dl[128 + ln_] * dl[192 + ln_])) + lam_init;
              const float* sub = INP(11) + l * 128; attn_body::bf16* YBp = (attn_body::bf16*)(wsl + WS_YB);
              for (int i = 0;; ++i) { const int L = i * Gp + vcup; if (L >= NB * 64) break;
                const int v = L & 255, e = L >> 8, b = v >> 3, h = e >> 1, c = e & 1, qb = (h & 1) ? 7 - (v & 7) : (v & 7);
                if (c == 0) attn_body::attn_unit<8, false, true>(b, qb, BQ + (2 * h) * 64, BK + KNAT(b, 2 * h), BV + VNATB(b, h), OB + h * 128, nullptr, (char*)lds, wavep);
                else        attn_body::attn_unit<8, false, true>(b, qb, BQ + (2 * h + 1) * 64, BK + KNAT(b, 2 * h + 1), BV + VNATB(b, h), YBp + h * 128, nullptr, (char*)lds, wavep, true, OB + h * 128, sub, lam, 1.0f - lam_init); } }
}
#endif
            if (BOTH(pb + 2)) GRID_BAR();
        }
        if (IN(pb + 4)) {
for (int rep_ = 0; rep_ < NREP(5); ++rep_) {
            { WSL(); pg8::Gemm g{(const bf16*)(wsl + WS_YA), (const bf16*)(wsl + WS_W + (size_t)l * W_LAYER + OFF_UA), M, 2 * DMODEL, 512, (const bf16*)(wsl + WS_YB), 4}; pg8::PairOrder S; S.init(M, DMODEL, Gp, bxp);
              epi::EpiGateFused E{(const unsigned char*)(wsl + WS_G), (bf16*)(wsl + WS_MRG)}; pg8::gemm_phase<epi::EpiGateFused, pg8::PairOrder, true, true>(ldsb, g, S, E, wavep); }
}
            if (BOTH(pb + 4)) GRID_BAR();
        }
        if (IN(pb + 5)) {
            WSL();
            pg8::Gemm g{(const bf16*)(wsl + WS_MRG), (const bf16*)(wsl + WS_W + (size_t)l * W_LAYER + OFF_O), M, DMODEL, DMODEL}; pg8::StaticOrder S; S.init(M, DMODEL, Gp, bxp);
#if defined(DBG_PROBE6)
            { epi::EpiProbe<0> E0{nullptr}; pg8::gemm_phase<epi::EpiProbe<0>, pg8::StaticOrder, true, true>(ldsb, g, S, E0, wavep); }
#endif
#if defined(DBG_PROBE6E)
            { epi::EpiRes E0{(bf16*)(wsl + WS_XB), (float*)(wsl + WS_G + 128 * MiB), nullptr, (bf16*)(wsl + WS_G)}; pg8::gemm_phase<epi::EpiRes, pg8::StaticOrder, true, true>(ldsb, g, S, E0, wavep); }
#endif
            epi::EpiRes E{(bf16*)(wsl + WS_XB), (float*)(wsl + WS_SS + 4 * MiB), nullptr, (bf16*)(wsl + WS_XB)};
            pg8::gemm_phase<epi::EpiRes, pg8::StaticOrder, true, true>(ldsb, g, S, E, wavep);
            if (BOTH(pb + 5)) GRID_BAR();
        }
        if (IN(pb + 6)) {
for (int rep_ = 0; rep_ < NREP(7); ++rep_) {
            WSL();
            pg8::Gemm g{(const bf16*)(wsl + WS_XB), (const bf16*)(wsl + WS_W + (size_t)l * W_LAYER + OFF_F1), M, NF1, DMODEL}; g.serp = 1; pg8::StaticOrder S; S.init(M, NF1, Gp, bxp);
#if defined(DBG_PROBE7)
            if (rep_ == 0) { epi::EpiProbe<DBG_PROBE7> E0{(bf16*)(wsl + WS_ACT)}; pg8::gemm_phase<epi::EpiProbe<DBG_PROBE7>, pg8::StaticOrder, true, true>(ldsb, g, S, E0, wavep); continue; }
#endif
            epi::rstd_prepass(ldsb, S, (const float*)(wsl + WS_SS + 4 * MiB), wavep * 64 + lane_id_asm());
            epi::EpiSwiglu E{ldsb, (bf16*)(wsl + WS_ACT)};
            pg8::gemm_phase<epi::EpiSwiglu, pg8::StaticOrder, true, true>(ldsb, g, S, E, wavep);
}
            if (BOTH(pb + 6)) GRID_BAR();
        }
        if (IN(pb + 7)) {
            WSL();
            pg8::Gemm g{(const bf16*)(wsl + WS_ACT), (const bf16*)(wsl + WS_W + (size_t)l * W_LAYER + OFF_F2), M, DMODEL, FF}; pg8::StaticOrder S; S.init(M, DMODEL, Gp, bxp);
#if defined(DBG_PROBE8)
            { epi::EpiProbe<0> E0{nullptr}; pg8::gemm_phase<epi::EpiProbe<0>, pg8::StaticOrder, true, true>(ldsb, g, S, E0, wavep); }
#endif
#if defined(DBG_PROBE8E)
            { epi::EpiRes E0{(bf16*)(wsl + WS_XB), (float*)(wsl + WS_G + 128 * MiB), nullptr, (bf16*)(wsl + WS_G)}; pg8::gemm_phase<epi::EpiRes, pg8::StaticOrder, true, true>(ldsb, g, S, E0, wavep); }
#endif
            epi::EpiRes E{(bf16*)(wsl + WS_XB), (float*)(wsl + WS_SS), (l == NLAYER - 1) ? outp : nullptr, (bf16*)(wsl + WS_XB)};
            pg8::gemm_phase<epi::EpiRes, pg8::StaticOrder, true, true>(ldsb, g, S, E, wavep);
            if (BOTH(pb + 7)) GRID_BAR();
        }
    }
#undef INP
#undef WSL
#undef IN
#undef BOTH
#undef GRID_BAR
}


#if defined(DBG_STOP)
struct DumpArgs { const unsigned short* p[16]; unsigned long long n[16]; float* out; int nb; int pad; };
__global__ void dbg_dump(DumpArgs d) {
    const size_t i0 = (size_t)blockIdx.x * blockDim.x + threadIdx.x, stride = (size_t)gridDim.x * blockDim.x;
    for (size_t i = i0; i < (size_t)M * DMODEL; i += stride) { float s = 0.f;
        for (int b = 0; b < d.nb; ++b) { const unsigned short w = d.p[b][i % d.n[b]]; float f = __uint_as_float((unsigned)w << 16); if (!(f == f) || fabsf(f) > 1e30f) f = 12345.f; s += f; }
        d.out[i] = s; }
}
#endif
extern "C" void kernel_launch(void* const* d_in, const int* in_sizes, int n_in, void* d_out, int out_size, void* d_ws, size_t ws_size, hipStream_t stream) {
    static int grid = 0;
    if (grid == 0) {
        if (n_in != 18 || in_sizes[0] != M * DMODEL || out_size != M * DMODEL || ws_size < WS_END) { fprintf(stderr, "kernel_launch: unexpected shapes (n_in %d, in0 %d, out %d, ws %zu)\n", n_in, n_in > 0 ? in_sizes[0] : -1, out_size, ws_size); grid = -1; return; }
        int dev = 0, cus = 0, per_cu = 0;
        if (hipGetDevice(&dev) != hipSuccess || hipDeviceGetAttribute(&cus, hipDeviceAttributeMultiprocessorCount, dev) != hipSuccess) { grid = -1; return; }
        if (hipFuncSetAttribute((const void*)mega_fwd, hipFuncAttributeMaxDynamicSharedMemorySize, LDS_BYTES) != hipSuccess) { fprintf(stderr, "kernel_launch: hipFuncSetAttribute failed\n"); grid = -1; return; }
        if (hipOccupancyMaxActiveBlocksPerMultiprocessor(&per_cu, (const void*)mega_fwd, NWAVES * 64, LDS_BYTES) != hipSuccess || per_cu < 1) fprintf(stderr, "kernel_launch: occupancy query reports %d\n", per_cu);
        (void)hipGetLastError();
        grid = cus;
    }
    if (grid < 0) return;
    if (hipMemsetAsync((char*)d_ws + WS_CTL, 0, CTL_ZERO_BYTES, stream) != hipSuccess) return;
    Args a{};
    for (int i = 0; i < 18; ++i) a.in[i] = (const float*)d_in[i];
    a.out = (float*)d_out; a.ws = (unsigned char*)d_ws;
#if defined(DBG_STOP)
    for (int p = 0; p < DBG_STOP; ++p) { a.ph_lo = p; a.ph_hi = p + 1; hipLaunchKernelGGL(mega_fwd, dim3(grid), dim3(NWAVES * 64), LDS_BYTES, stream, a); }
    { DumpArgs d{}; unsigned char* w = (unsigned char*)d_ws; int n = 0;
      const size_t offs[] = {DBG_BUFS}; const size_t lens[] = {DBG_LENS};
      for (size_t q = 0; q < sizeof(offs) / sizeof(offs[0]); ++q) { d.p[n] = (const unsigned short*)(w + offs[q]); d.n[n] = lens[q] / 2; ++n; }
      d.out = (float*)d_out; d.nb = n; hipLaunchKernelGGL(dbg_dump, dim3(2048), dim3(256), 0, stream, d); }
#elif MK_PER_PHASE
    for (int p = 0; p < NPHASE; ++p) { a.ph_lo = p; a.ph_hi = p + 1; hipLaunchKernelGGL(mega_fwd, dim3(grid), dim3(NWAVES * 64), LDS_BYTES, stream, a); }
#else
    a.ph_lo = 0; a.ph_hi = NPHASE;
    hipLaunchKernelGGL(mega_fwd, dim3(grid), dim3(NWAVES * 64), LDS_BYTES, stream, a);
#endif
    const hipError_t le = hipPeekAtLastError();
    if (le != hipSuccess) fprintf(stderr, "kernel_launch: launch failed: %s\n", hipGetErrorName(le));
}
```

```cpp
#include <hip/hip_runtime.h>
#include <cstdio>
#include <cstdint>
namespace pg8 {
#define PG8_LAS __attribute__((address_space(3)))
typedef unsigned short bf16_t;
typedef short bf16x8 __attribute__((ext_vector_type(8)));
typedef float f32x4 __attribute__((ext_vector_type(4)));
typedef unsigned u32x4 __attribute__((ext_vector_type(4)));
constexpr int BM = 256, BK = 64, HALF = 128, HTB = HALF * BK * 2  , STAGE_BYTES = 8 * HTB, NXCD = 8, WGM = 8;

__host__ __device__ __forceinline__ int lds_byte(int r, int c) { const int st = (r >> 4) * 2 + (c >> 5), rr = r & 15, cc = c & 31, ob = rr * 64 + cc * 2; return st * 1024 + (ob ^ (((ob >> 9) & 1) << 5)); }
__host__ __device__ __forceinline__ void stage_rc(int b, int& R, int& C) { const int st = b / 1024, sb = b % 1024, swz = sb ^ (((sb >> 9) & 1) << 5); R = (st >> 1) * 16 + swz / 64; C = (st & 1) * 32 + (swz % 64) / 2; }
__host__ __device__ __forceinline__ int perm32(int rho) { const int n = rho >> 4, i = rho & 15; return 8 * (i >> 2) + 4 * n + (i & 3); }

struct Unit { int pm, pn; };
struct Gemm { const bf16_t* A; const bf16_t* Bt; int M, N, K; const bf16_t* A2 = nullptr; int nsplit = 1 << 30; };

struct StaticOrder {
    int nM, nN, nwg, G, c;
    __host__ __device__ void init(int M, int N, int G_, int c_) { nM = M / BM; nN = N / BM; nwg = nM * nN; G = G_; c = c_; }
    __host__ __device__ bool next(int i, Unit& u) const {
        const long L = (long)i * G + c; if (L >= nwg) return false;
        int wgid = (int)L; { const int q = nwg / NXCD, r = nwg % NXCD, xcd = wgid % NXCD, off = wgid / NXCD; wgid = (xcd < r ? xcd * (q + 1) : r * (q + 1) + (xcd - r) * q) + off; }
        const int nig = WGM * nN, gid = wgid / nig, fm = gid * WGM, gsz = (nM - fm) < WGM ? (nM - fm) : WGM;
        u.pm = fm + ((wgid % nig) % gsz); u.pn = (wgid % nig) / gsz; return true;
    }
    __device__ __forceinline__ void a_ready(const Unit&) const {}
    __device__ __forceinline__ void done(const Unit&) const {}
};

struct PairOrder {
    StaticOrder s;
    __host__ __device__ void init(int M, int N, int G_, int c_) { s.init(M, N, G_, c_); }
    __host__ __device__ bool next(int i, Unit& u) const { if (!s.next(i >> 1, u)) return false; u.pn += (i & 1) * s.nN; return true; }
    __device__ __forceinline__ void a_ready(const Unit&) const {}
    __device__ __forceinline__ void done(const Unit&) const {}
};

__device__ __forceinline__ unsigned cvt_pk_bf16(float lo, float hi) { unsigned r; asm volatile("v_cvt_pk_bf16_f32 %0, %1, %2" : "=v"(r) : "v"(lo), "v"(hi)); return r; }
typedef float f32x2 __attribute__((ext_vector_type(2)));
template <int N> __device__ __forceinline__ void pg8_wait_vm() { asm volatile("s_waitcnt vmcnt(%0)" :: "n"(N) : "memory"); }
__device__ __forceinline__ void pg8_wait_vm_relaxed(int rl) { if (rl >= 48) pg8_wait_vm<56>(); else if (rl >= 40) pg8_wait_vm<48>(); else if (rl >= 32) pg8_wait_vm<40>(); else if (rl >= 24) pg8_wait_vm<32>(); else if (rl >= 16) pg8_wait_vm<24>(); else pg8_wait_vm<8>(); }
__device__ __forceinline__ int pg8_lane_id() { int l; asm volatile("v_mbcnt_lo_u32_b32 %0, -1, 0\n\tv_mbcnt_hi_u32_b32 %0, -1, %0" : "=v"(l)); return l; }
template <class Epi, class Sched, bool ALIGN_EPI = false, bool SP2 = false>
__device__ __forceinline__ void gemm_phase(PG8_LAS unsigned char* lds, const Gemm g, const Sched& S, const Epi& E, const int wave_in  ) {
    int tid_ = wave_in * 64 + pg8_lane_id();
    const int tid = tid_, wid = __builtin_amdgcn_readfirstlane(tid >> 6), lane = tid & 63, wr = wid >> 2, wc = wid & 3, fr = lane & 15, fq = lane >> 4;
    const int K = g.K, nt = K / BK;
    unsigned voffA[2], voffB[2];
#pragma unroll
    for (int i = 0; i < 2; ++i) { int R, C; stage_rc(tid * 16 + i * 8192, R, C); const int Rb = Epi::PERM ? ((R & ~31) + perm32(R & 31)) : R;
        voffA[i] = (unsigned)(R * K + C) * 2u; voffB[i] = (unsigned)(Rb * K + C) * 2u; }
    const size_t kstep = (size_t)(BK * 2);
    const size_t hstep = (size_t)HALF * K * 2;
    const size_t tstep = 2 * hstep;
    const unsigned ldsw = (unsigned)wid * 1024u;
    const int aoff = lds_byte(wr * 64 + fr, fq * 8), boff = lds_byte(wc * 32 + fr, fq * 8);
#define PG8_SA(b, h) (((b) * 2 + (h)) * HTB)
#define PG8_SB(b, h) ((4 + (b) * 2 + (h)) * HTB)
#define PG8_STAGE(bufoff, gbase, voff) do { _Pragma("unroll") for (int _i = 0; _i < 2; ++_i) \
        __builtin_amdgcn_global_load_lds((const unsigned*)((const char*)(gbase) + (voff)[_i]), (PG8_LAS unsigned*)(lds + (bufoff) + ldsw + _i * 8192), 16, 0, 0); } while (0)
#define PG8_LDA(dst, b, h) do { _Pragma("unroll") for (int m = 0; m < 4; ++m) _Pragma("unroll") for (int k = 0; k < 2; ++k) dst[m][k] = *(const PG8_LAS bf16x8*)(lds + PG8_SA(b, h) + aoff + m * 2048 + k * 1024); } while (0)
#define PG8_LDB(dst, b, h) do { _Pragma("unroll") for (int n = 0; n < 2; ++n) _Pragma("unroll") for (int k = 0; k < 2; ++k) dst[n][k] = *(const PG8_LAS bf16x8*)(lds + PG8_SB(b, h) + boff + n * 2048 + k * 1024); } while (0)
#define PG8_MMA(ai, bj, At, Bt) do { __builtin_amdgcn_s_setprio(1); _Pragma("unroll") for (int m = 0; m < 4; ++m) _Pragma("unroll") for (int n = 0; n < 2; ++n) _Pragma("unroll") for (int k = 0; k < 2; ++k) \
        acc[ai][bj][m][n] = __builtin_amdgcn_mfma_f32_16x16x32_bf16(Bt[n][k], At[m][k], acc[ai][bj][m][n], 0, 0, 0); __builtin_amdgcn_s_setprio(0); } while (0)
#define PG8_WAIT_V(n) asm volatile("s_waitcnt vmcnt(" #n ")" ::: "memory")
#define PG8_WAIT_V_RLX(flag) asm volatile("s_cmp_eq_u32 %0, 0\n\ts_cbranch_scc1 1f\n\ts_waitcnt vmcnt(%1)\n\ts_branch 2f\n1:\n\ts_waitcnt vmcnt(8)\n2:" :: "s"(__builtin_amdgcn_readfirstlane(flag)), "n"(8 + Epi::VMEM_MIN) : "memory", "scc")
#define PG8_WAIT_L(n) asm volatile("s_waitcnt lgkmcnt(" #n ")" ::: "memory")
#define PG8_BAR __builtin_amdgcn_s_barrier()
#define PG8_SCHED __builtin_amdgcn_sched_barrier(0)
    Unit cur, nxt; int ui = 0;
    if (!S.next(0, cur)) return;
    f32x4 acc[2][2][4][2];
#pragma unroll
    for (int a = 0; a < 2; ++a)
#pragma unroll
        for (int b = 0; b < 2; ++b)
#pragma unroll
            for (int m = 0; m < 4; ++m)
#pragma unroll
                for (int n = 0; n < 2; ++n) acc[a][b][m][n] = (f32x4){0.f, 0.f, 0.f, 0.f};
    bf16x8 At[4][2], B0[2][2], B1[2][2];
    const char* cA = (const char*)(cur.pn >= g.nsplit ? g.A2 : g.A) + (size_t)cur.pm * tstep; const char* cB = (const char*)g.Bt + (size_t)cur.pn * tstep;
    S.a_ready(cur);
    if constexpr (SP2) {
        PG8_STAGE(PG8_SB(0, 0), cB, voffB); PG8_STAGE(PG8_SB(0, 1), cB + hstep, voffB); PG8_STAGE(PG8_SA(0, 0), cA, voffA); PG8_STAGE(PG8_SA(0, 1), cA + hstep, voffA);
        if (wr == 1) PG8_BAR;
        PG8_WAIT_V(2); PG8_BAR;
        PG8_STAGE(PG8_SB(1, 0), cB + kstep, voffB); PG8_STAGE(PG8_SA(1, 0), cA + kstep, voffA); PG8_STAGE(PG8_SB(1, 1), cB + hstep + kstep, voffB);
        PG8_WAIT_V(6); PG8_BAR;
    } else {
        PG8_STAGE(PG8_SB(0, 0), cB, voffB); PG8_STAGE(PG8_SA(0, 0), cA, voffA); PG8_STAGE(PG8_SB(0, 1), cB + hstep, voffB); PG8_STAGE(PG8_SA(0, 1), cA + hstep, voffA);
        if (wr == 1) PG8_BAR;
        PG8_WAIT_V(4); PG8_BAR;
        PG8_STAGE(PG8_SB(1, 0), cB + kstep, voffB); PG8_STAGE(PG8_SA(1, 0), cA + kstep, voffA); PG8_STAGE(PG8_SB(1, 1), cB + hstep + kstep, voffB);
        PG8_WAIT_V(6); PG8_BAR;
    }
    for (;;) {
        const bool has_next = S.next(ui + 1, nxt);
        const char* nA = has_next ? (const char*)(nxt.pn >= g.nsplit ? g.A2 : g.A) + (size_t)nxt.pm * tstep : cA; const char* nB = has_next ? (const char*)g.Bt + (size_t)nxt.pn * tstep : cB;
        for (int t = 0; t < nt; t += 2) {
            const bool last = (t == nt - 2);
            const char* a1 = cA + (size_t)(t + 1) * kstep;
            const char* a2 = last ? nA : cA + (size_t)(t + 2) * kstep; const char* b2 = last ? nB : cB + (size_t)(t + 2) * kstep;
            const char* a3 = a2 + kstep; const char* b3 = b2 + kstep;
            if (last && has_next) S.a_ready(nxt);
            if constexpr (SP2) {
            const int rlx = (t == 0 && ui > 0) ? 1 : 0;
            PG8_LDB(B0, 0, 0); PG8_LDB(B1, 0, 1); PG8_SCHED; PG8_LDA(At, 0, 0); PG8_STAGE(PG8_SA(1, 1), a1 + hstep, voffA);
            PG8_WAIT_V_RLX(rlx); PG8_WAIT_L(0); PG8_BAR; PG8_MMA(0, 0, At, B0); PG8_MMA(0, 1, At, B1); PG8_BAR; PG8_SCHED;
            PG8_LDA(At, 0, 1); PG8_STAGE(PG8_SB(0, 0), b2, voffB); PG8_STAGE(PG8_SB(0, 1), b2 + hstep, voffB); PG8_STAGE(PG8_SA(0, 0), a2, voffA);
            PG8_WAIT_V_RLX(rlx); PG8_WAIT_L(0); PG8_BAR; PG8_MMA(1, 0, At, B0); PG8_MMA(1, 1, At, B1); PG8_BAR; PG8_SCHED;
            PG8_LDB(B0, 1, 0); PG8_LDB(B1, 1, 1); PG8_SCHED; PG8_LDA(At, 1, 0); PG8_STAGE(PG8_SA(0, 1), a2 + hstep, voffA);
            PG8_WAIT_V(8); PG8_WAIT_L(0); PG8_BAR; PG8_MMA(0, 0, At, B0); PG8_MMA(0, 1, At, B1); PG8_BAR; PG8_SCHED;
            PG8_LDA(At, 1, 1); PG8_STAGE(PG8_SB(1, 0), b3, voffB); PG8_STAGE(PG8_SB(1, 1), b3 + hstep, voffB); PG8_STAGE(PG8_SA(1, 0), a3, voffA);
            PG8_WAIT_V(8); PG8_WAIT_L(0); PG8_BAR; PG8_MMA(1, 0, At, B0); PG8_MMA(1, 1, At, B1); PG8_BAR; PG8_SCHED;
            } else {
            PG8_LDB(B0, 0, 0); PG8_SCHED; PG8_LDA(At, 0, 0); PG8_STAGE(PG8_SA(1, 1), a1 + hstep, voffA);
            PG8_WAIT_L(8); PG8_BAR; PG8_WAIT_L(0); PG8_MMA(0, 0, At, B0); PG8_BAR; PG8_SCHED;
            PG8_LDB(B1, 0, 1); PG8_STAGE(PG8_SB(0, 0), b2, voffB);
            PG8_BAR; PG8_WAIT_L(0); PG8_MMA(0, 1, At, B1); PG8_BAR;
            PG8_LDA(At, 0, 1); PG8_STAGE(PG8_SA(0, 0), a2, voffA);
            PG8_BAR; PG8_WAIT_L(0); PG8_MMA(1, 0, At, B0); PG8_BAR; PG8_SCHED;
            PG8_STAGE(PG8_SB(0, 1), b2 + hstep, voffB);
            PG8_WAIT_V(6); PG8_BAR; PG8_MMA(1, 1, At, B1); PG8_BAR;
            PG8_LDB(B0, 1, 0); PG8_SCHED; PG8_LDA(At, 1, 0); PG8_STAGE(PG8_SA(0, 1), a2 + hstep, voffA);
            PG8_WAIT_L(8); PG8_BAR; PG8_WAIT_L(0); PG8_MMA(0, 0, At, B0); PG8_BAR; PG8_SCHED;
            PG8_LDB(B1, 1, 1); PG8_STAGE(PG8_SB(1, 0), b3, voffB);
            PG8_BAR; PG8_WAIT_L(0); PG8_MMA(0, 1, At, B1); PG8_BAR;
            PG8_LDA(At, 1, 1); PG8_STAGE(PG8_SA(1, 0), a3, voffA);
            PG8_BAR; PG8_WAIT_L(0); PG8_MMA(1, 0, At, B0); PG8_BAR; PG8_SCHED;
            PG8_STAGE(PG8_SB(1, 1), b3 + hstep, voffB);
            PG8_WAIT_V(6); PG8_BAR; PG8_MMA(1, 1, At, B1); PG8_BAR;
            }
        }
        if constexpr (ALIGN_EPI) { if (wr == 0) PG8_BAR; }
        bool keep_acc = false; if constexpr (Epi::CARRY) keep_acc = Epi::carry(cur) && has_next;
        if constexpr (!Epi::AFTER_DRAIN) { (void)E(acc, cur, wr, wc, fr, fq); S.done(cur); }
        if (!has_next) break;
        if (!keep_acc) {
#pragma unroll
        for (int a = 0; a < 2; ++a)
#pragma unroll
            for (int b = 0; b < 2; ++b)
#pragma unroll
                for (int m = 0; m < 4; ++m)
#pragma unroll
                    for (int n = 0; n < 2; ++n) acc[a][b][m][n] = (f32x4){0.f, 0.f, 0.f, 0.f};
        }
        cur = nxt; cA = nA; cB = nB; ++ui;
        if constexpr (ALIGN_EPI) { if (wr == 1) PG8_BAR; }
    }
    PG8_WAIT_V(0);
    if constexpr (!ALIGN_EPI) { if (wr == 0) PG8_BAR; }
    PG8_BAR;
    if constexpr (Epi::AFTER_DRAIN) { E.fused(acc, cur, wr, wc, fr, fq, lds, wid, lane); S.done(cur); }
#undef PG8_SA
#undef PG8_SB
#undef PG8_STAGE
#undef PG8_LDA
#undef PG8_LDB
#undef PG8_MMA
#undef PG8_WAIT_V
#undef PG8_WAIT_V_RLX
#undef PG8_WAIT_L
#undef PG8_BAR
#undef PG8_SCHED
}
}
namespace epi {
using pg8::f32x4; using pg8::u32x4; using pg8::Unit; using pg8::bf16_t;
typedef float f32x2_t __attribute__((ext_vector_type(2))); typedef __bf16 bf16x2_t __attribute__((ext_vector_type(2))); typedef _Float16 h16x2 __attribute__((ext_vector_type(2)));
__device__ __forceinline__ unsigned cvt_pk_bf16(float lo, float hi) { const f32x2_t v = {lo, hi}; const bf16x2_t b = __builtin_convertvector(v, bf16x2_t); return __builtin_bit_cast(unsigned, b); }
constexpr float EPSN = 1e-6f;
constexpr float QSCALE = 0.125f * 1.4426950408889634f;
__device__ __forceinline__ float bflo(unsigned w) { return __uint_as_float(w << 16); }
__device__ __forceinline__ float bfhi(unsigned w) { return __uint_as_float(w & 0xffff0000u); }
__device__ __forceinline__ float swz_xor16(float v) { return __int_as_float(__builtin_amdgcn_ds_swizzle(__float_as_int(v), 0x401F)); }
__device__ __forceinline__ float sum_halves(float v) { auto rr = __builtin_amdgcn_permlane32_swap(__float_as_uint(v), __float_as_uint(v), false, false); return __uint_as_float(rr[0]) + __uint_as_float(rr[1]); }
__device__ __forceinline__ float sum_fq(float v) { v += swz_xor16(v); return sum_halves(v); }
__device__ __forceinline__ void rstd_rows(const float* ss, int rowb, int fq, float (&r)[2][4]) {
    f32x4 a[2][4];
#pragma unroll
    for (int ai = 0; ai < 2; ++ai)
#pragma unroll
        for (int m = 0; m < 4; ++m) a[ai][m] = ((const f32x4*)(ss + (size_t)(rowb + ai * 128 + m * 16) * 16))[fq];
#pragma unroll
    for (int ai = 0; ai < 2; ++ai)
#pragma unroll
        for (int m = 0; m < 4; ++m) { float s = (a[ai][m][0] + a[ai][m][1]) + (a[ai][m][2] + a[ai][m][3]); s = sum_fq(s);
            r[ai][m] = __builtin_amdgcn_rsqf(s * (1.0f / 1024.0f) + EPSN); }
}
__device__ __forceinline__ float sigm(float v) { return __builtin_amdgcn_rcpf(1.0f + __expf(-v)); }

constexpr int PTR_OFF = 131072 + 1024;
__device__ __forceinline__ const float* lds_inptr(PG8_LAS unsigned char* ldsb, int i) {
    const PG8_LAS unsigned* t = (const PG8_LAS unsigned*)(ldsb + PTR_OFF) + 2 * i;
    const unsigned lo = __builtin_amdgcn_readfirstlane(t[0]), hi = __builtin_amdgcn_readfirstlane(t[1]);
    return (const float*)(const __attribute__((address_space(1))) float*)(((unsigned long long)hi << 32) | lo);
}
constexpr size_t EMiB = 1u << 20;
constexpr size_t EI_SS = 66 * EMiB, EI_ROPE = 74 * EMiB, EI_IW = 122 * EMiB, EI_IK = 124 * EMiB, EI_IQ = 132 * EMiB, EI_AQ = 292 * EMiB, EI_AK = 356 * EMiB, EI_AV = 420 * EMiB, EI_BQ = 484 * EMiB, EI_BK = 548 * EMiB, EI_BV = 612 * EMiB, EI_G = 676 * EMiB;
__device__ __forceinline__ void rstd_rows4(const float* ss, int rowh, int fq, float (&r)[4]) {
    f32x4 a[4];
#pragma unroll
    for (int m = 0; m < 4; ++m) a[m] = ((const f32x4*)(ss + (size_t)(rowh + m * 16) * 16))[fq];
#pragma unroll
    for (int m = 0; m < 4; ++m) { float s = (a[m][0] + a[m][1]) + (a[m][2] + a[m][3]); s = sum_fq(s); r[m] = __builtin_amdgcn_rsqf(s * (1.0f / 1024.0f) + EPSN); }
}
constexpr int RSTD_OFF = 131072 + 1024 + 512, RSTD_SLOTS = 8;
template <class Sched> __device__ __forceinline__ void rstd_prepass(PG8_LAS unsigned char* ldsb, const Sched& S, const float* ss, int tid) {
    PG8_LAS int* tab = (PG8_LAS int*)(ldsb + RSTD_OFF); PG8_LAS float* rt = (PG8_LAS float*)(ldsb + RSTD_OFF + 64);
    if (tid == 0) { int n = 0; Unit u;
        for (int i = 0; S.next(i, u); ++i) { bool f = false; for (int k = 0; k < n; ++k) f |= (tab[k] == u.pm); if (!f && n < RSTD_SLOTS) tab[n++] = u.pm; }
        for (int k = n; k < RSTD_SLOTS; ++k) tab[k] = -1; }
    __syncthreads();
    for (int k = 0; k < RSTD_SLOTS; ++k) { const int pm = tab[k]; if (pm < 0) break;
        const int row = pm * 256 + (tid >> 1); const f32x4* p = (const f32x4*)(ss + (size_t)row * 16) + 2 * (tid & 1);
        const f32x4 a = p[0], b = p[1]; float s = ((a[0] + a[1]) + (a[2] + a[3])) + ((b[0] + b[1]) + (b[2] + b[3]));
        s += __int_as_float(__builtin_amdgcn_ds_swizzle(__float_as_int(s), 0x041F));
        if ((tid & 1) == 0) rt[k * 256 + (tid >> 1)] = __builtin_amdgcn_rsqf(s * (1.0f / 1024.0f) + EPSN); }
    __syncthreads();
}
__device__ __forceinline__ const PG8_LAS float* rstd_slot(PG8_LAS unsigned char* ldsb, int pm) {
    const PG8_LAS int* tab = (const PG8_LAS int*)(ldsb + RSTD_OFF); int slot = 0;
#pragma unroll
    for (int k = 1; k < RSTD_SLOTS; ++k) slot = (tab[k] == pm) ? k : slot;
    slot = __builtin_amdgcn_readfirstlane(slot);
    return (const PG8_LAS float*)(ldsb + RSTD_OFF + 64) + slot * 256;
}
__device__ __forceinline__ size_t gate_block(int pm, int t, int wave5, int ai, int mp, int bj5) { return ((size_t)((((pm * 8 + t) * 8 + wave5) * 2 + ai) * 2 + mp) * 2 + bj5) * 1024; }
struct EpiIn {
    static constexpr bool PERM = true, AFTER_DRAIN = false, CARRY = false; static constexpr int VMEM_MIN = 0;
    unsigned char* ws; PG8_LAS unsigned char* ldsb; int layer;
    __device__ __forceinline__ int operator()(const f32x4 (&acc)[2][2][4][2], const Unit& u, int wr, int wc, int fr, int fq) const {
        asm volatile("" : "+v"(fr), "+v"(fq));
        const int pn = u.pn, rowb = u.pm * 256 + wr * 64 + fr;
        const unsigned* rope = (const unsigned*)(ws + EI_ROPE);
        const PG8_LAS float* rt = rstd_slot(ldsb, u.pm) + wr * 64 + fr;
        if (pn >= 14) {
            const int colb = (pn - 14) * 256 + wc * 64 + 8 * fq;
            const float* gbias = lds_inptr(ldsb, 4) + layer * 2048; unsigned char* G8 = ws + EI_G;
            f32x4 bia[2][2];
#pragma unroll
            for (int bj = 0; bj < 2; ++bj)
#pragma unroll
                for (int n = 0; n < 2; ++n) bia[bj][n] = *(const f32x4*)(gbias + colb + 32 * bj + 4 * n);
#pragma unroll
            for (int ai = 0; ai < 2; ++ai) {
#pragma unroll
                for (int mp = 0; mp < 2; ++mp) { uint2 pc[2][2];
#pragma unroll
                  for (int mm = 0; mm < 2; ++mm) { const int m = 2 * mp + mm; const float r = rt[ai * 128 + m * 16];
#pragma unroll
                    for (int bj = 0; bj < 2; ++bj) { f32x4 v0 = acc[ai][bj][m][0] * r + bia[bj][0], v1 = acc[ai][bj][m][1] * r + bia[bj][1];
#pragma unroll
                        for (int i = 0; i < 4; ++i) { v0[i] = __builtin_amdgcn_fmed3f(v0[i], -60.f, 60.f); v1[i] = __builtin_amdgcn_fmed3f(v1[i], -60.f, 60.f); }
                        int w0 = 0, w1 = 0; w0 = __builtin_amdgcn_cvt_pk_fp8_f32(v0[0], v0[1], w0, false); w0 = __builtin_amdgcn_cvt_pk_fp8_f32(v0[2], v0[3], w0, true);
                        w1 = __builtin_amdgcn_cvt_pk_fp8_f32(v1[0], v1[1], w1, false); w1 = __builtin_amdgcn_cvt_pk_fp8_f32(v1[2], v1[3], w1, true);
                        pc[mm][bj] = make_uint2((unsigned)w0, (unsigned)w1); } }
#pragma unroll
                  for (int bj = 0; bj < 2; ++bj) { u32x4 w; w.x = pc[0][bj].x; w.y = pc[0][bj].y; w.z = pc[1][bj].x; w.w = pc[1][bj].y;
                        *(u32x4*)(G8 + gate_block(u.pm, pn - 14, wr * 4 + (wc & 1) * 2 + bj, ai, mp, wc >> 1) + (fq * 16 + fr) * 16) = w; } } }
            return 24;
        }
        size_t doff; int gi = -1; int pitch = 512; bool rp = false; float sc = 1.f;
        int vn = -1, vhalf = 0, vw = 8;
        int kn = -1;
        if (pn < 2)       { doff = EI_AQ + (size_t)((pn * 4 + wc) * 64) * 2; gi = 5; rp = true; sc = QSCALE; }
        else if (pn < 4)  { doff = EI_AK; kn = (pn - 2) * 4 + wc; gi = 6; rp = true; }
        else if (pn < 6)  { doff = EI_AV; vn = (pn - 4) * 4 + wc; }
        else if (pn == 6) { doff = EI_IQ + (size_t)(wc * 64) * 2; pitch = 256; rp = true; }
        else if (pn == 7) {
            if (wc == 0) { doff = EI_IK; pitch = 64; gi = 7; rp = true; kn = 100; }
            else { if (wc == 1) {
                    float* IW = (float*)(ws + EI_IW);
#pragma unroll
                    for (int ai = 0; ai < 2; ++ai)
#pragma unroll
                        for (int m = 0; m < 4; ++m) { const int row = rowb + ai * 128 + m * 16; if (fq == 0) *(f32x4*)(IW + (size_t)row * 4) = acc[ai][0][m][0] * (rt[ai * 128 + m * 16] * 0.5f); } }
                return (wc == 1) ? 1 : 0; } }
        else if (pn < 10) { doff = EI_BQ + (size_t)(((pn - 8) * 4 + wc) * 64) * 2; gi = 8; rp = true; sc = QSCALE; }
        else if (pn < 12) { doff = EI_BK; kn = (pn - 10) * 4 + wc; gi = 9; rp = true; }
        else              { doff = EI_BV; const int sl_ = (pn - 12) * 4 + wc; vn = sl_ >> 1; vhalf = sl_ & 1; vw = 16; }
        bf16_t* dst = (bf16_t*)(ws + doff);
        const float* gn = (gi >= 0) ? lds_inptr(ldsb, gi) + layer * 64 : nullptr;
        float gv[2][8];
#pragma unroll
        for (int bj = 0; bj < 2; ++bj)
#pragma unroll
            for (int j = 0; j < 8; ++j) gv[bj][j] = 1.f;
        if (gn) {
#pragma unroll
            for (int bj = 0; bj < 2; ++bj) { const f32x4 a = *(const f32x4*)(gn + 32 * bj + 8 * fq), b = *(const f32x4*)(gn + 32 * bj + 8 * fq + 4);
                gv[bj][0] = a[0] * sc; gv[bj][1] = a[1] * sc; gv[bj][2] = a[2] * sc; gv[bj][3] = a[3] * sc; gv[bj][4] = b[0] * sc; gv[bj][5] = b[1] * sc; gv[bj][6] = b[2] * sc; gv[bj][7] = b[3] * sc; } }
#pragma unroll
        for (int ai = 0; ai < 2; ++ai) {
            u32x4 cw[4][2];
            if (rp) {
#pragma unroll
                for (int mm = 0; mm < 4; ++mm) { const u32x4* cp = (const u32x4*)(rope + (size_t)(rowb + ai * 128 + mm * 16) * 32 + 8 * fq); cw[mm][0] = cp[0]; cw[mm][1] = cp[1]; } }
#pragma unroll
            for (int mm = 0; mm < 4; ++mm) { const int m = mm; const int row = rowb + ai * 128 + m * 16;
                const float r = rt[ai * 128 + m * 16];
                float v[2][8];
                if (gn) {
                    float q = 0.f;
#pragma unroll
                    for (int bj = 0; bj < 2; ++bj)
#pragma unroll
                        for (int n = 0; n < 2; ++n)
#pragma unroll
                            for (int i = 0; i < 4; ++i) q += acc[ai][bj][m][n][i] * acc[ai][bj][m][n][i];
                    q = sum_fq(q);
                    const float s = r * __builtin_amdgcn_rsqf(q * (r * r) * (1.0f / 64.0f) + EPSN);
#pragma unroll
                    for (int bj = 0; bj < 2; ++bj)
#pragma unroll
                        for (int n = 0; n < 2; ++n)
#pragma unroll
                            for (int i = 0; i < 4; ++i) v[bj][4 * n + i] = (acc[ai][bj][m][n][i] * s) * gv[bj][4 * n + i];
                } else { const float s = r * sc;
#pragma unroll
                    for (int bj = 0; bj < 2; ++bj)
#pragma unroll
                        for (int n = 0; n < 2; ++n)
#pragma unroll
                            for (int i = 0; i < 4; ++i) v[bj][4 * n + i] = acc[ai][bj][m][n][i] * s;
                }
                if (rp) {
#pragma unroll
                    for (int j = 0; j < 8; ++j) { const unsigned cwj = cw[mm][j >> 2][j & 3]; const h16x2 hh = __builtin_bit_cast(h16x2, cwj); const float cs = (float)hh[0], sn = (float)hh[1];
                        const float a = v[0][j], b = v[1][j]; v[0][j] = a * cs - b * sn; v[1][j] = b * cs + a * sn; }
                }
#pragma unroll
                for (int bj = 0; bj < 2; ++bj) { u32x4 w; w.x = cvt_pk_bf16(v[bj][0], v[bj][1]); w.y = cvt_pk_bf16(v[bj][2], v[bj][3]); w.z = cvt_pk_bf16(v[bj][4], v[bj][5]); w.w = cvt_pk_bf16(v[bj][6], v[bj][7]);
                    bf16_t* p_ = (kn == 100) ? dst + (((((size_t)((row >> 11) * 64 + ((row & 2047) >> 5)) * 4 + (2 * bj + (fq >> 1))) * 2 + (fq & 1)) * 32 + (row & 31)) << 3) : (vn >= 0) ? dst + (((((size_t)((row >> 11) * (vw == 16 ? 4 : 8) + vn) * 32 + ((row & 2047) >> 6)) * vw + (vhalf * 8 + 4 * bj + ((row & 63) >> 4))) * 64 + ((row & 15) * 4 + fq)) << 3) : (kn >= 0) ? dst + (((((size_t)((row >> 11) * 8 + kn) * 32 + ((row & 2047) >> 6)) * 8 + (4 * bj + fq)) * 64 + (row & 63)) << 3) : dst + (size_t)row * pitch + 32 * bj + 8 * fq;
                    *(u32x4*)p_ = w; }
            }
        }
        return 24;
    }
};

template <bool SECOND> struct EpiGate {
    static constexpr bool PERM = true, AFTER_DRAIN = false, CARRY = false; static constexpr int VMEM_MIN = SECOND ? 48 : 32;
    const unsigned char* G; bf16_t* T; bf16_t* O;
    __device__ __forceinline__ int operator()(const f32x4 (&acc)[2][2][4][2], const Unit& u, int wr, int wc, int fr, int fq) const {
        const int rowb = u.pm * 256 + wr * 64 + fr, colb = u.pn * 256 + wc * 32 + 8 * fq;
#pragma unroll
        for (int ai = 0; ai < 2; ++ai) {
            uint2 gw[4][2]; u32x4 tw[4][2];
#pragma unroll
            for (int m = 0; m < 4; ++m)
#pragma unroll
                for (int bj = 0; bj < 2; ++bj) { gw[m][bj] = *(const uint2*)(G + (size_t)(rowb + ai * 128 + m * 16) * 2048 + (SECOND ? 1024 : 0) + colb + 128 * bj);
                    if (SECOND) tw[m][bj] = *(const u32x4*)(T + (size_t)(rowb + ai * 128 + m * 16) * 1024 + colb + 128 * bj); }
#pragma unroll
            for (int m = 0; m < 4; ++m) { const int row = rowb + ai * 128 + m * 16;
#pragma unroll
                for (int bj = 0; bj < 2; ++bj) { const int col = colb + 128 * bj; const uint2 g8 = gw[m][bj];
                    const f32x2_t g01 = __builtin_amdgcn_cvt_pk_f32_fp8((int)g8.x, false), g23 = __builtin_amdgcn_cvt_pk_f32_fp8((int)g8.x, true), g45 = __builtin_amdgcn_cvt_pk_f32_fp8((int)g8.y, false), g67 = __builtin_amdgcn_cvt_pk_f32_fp8((int)g8.y, true);
                    const f32x4 a0 = acc[ai][bj][m][0], a1 = acc[ai][bj][m][1];
                    float v[8] = {a0[0] * sigm(g01.x), a0[1] * sigm(g01.y), a0[2] * sigm(g23.x), a0[3] * sigm(g23.y), a1[0] * sigm(g45.x), a1[1] * sigm(g45.y), a1[2] * sigm(g67.x), a1[3] * sigm(g67.y)};
                    if (SECOND) { const u32x4 t = tw[m][bj];
                        v[0] += bflo(t.x); v[1] += bfhi(t.x); v[2] += bflo(t.y); v[3] += bfhi(t.y); v[4] += bflo(t.z); v[5] += bfhi(t.z); v[6] += bflo(t.w); v[7] += bfhi(t.w); }
                    u32x4 w; w.x = cvt_pk_bf16(v[0], v[1]); w.y = cvt_pk_bf16(v[2], v[3]); w.z = cvt_pk_bf16(v[4], v[5]); w.w = cvt_pk_bf16(v[6], v[7]);
                    *(u32x4*)((SECOND ? O : T) + (size_t)row * 1024 + col) = w; } }
        }
        return SECOND ? 48 : 32;
    }
};

struct EpiGatePair {
    static constexpr bool PERM = true, AFTER_DRAIN = false, CARRY = false; static constexpr int VMEM_MIN = 32;
    const unsigned char* G; bf16_t* T; bf16_t* O;
    __device__ __forceinline__ int operator()(const f32x4 (&acc)[2][2][4][2], const Unit& u, int wr, int wc, int fr, int fq) const {
        if (u.pn < 4) { const EpiGate<false> e{G, T, O}; return e(acc, u, wr, wc, fr, fq); }
        const Unit v{u.pm, u.pn - 4}; const EpiGate<true> e{G, T, O}; return e(acc, v, wr, wc, fr, fq);
    }
};

struct EpiGateFused {
    static constexpr bool PERM = true, AFTER_DRAIN = false, CARRY = true; static constexpr int VMEM_MIN = 16;
    const unsigned char* G; bf16_t* O;
    static __device__ __forceinline__ bool carry(const Unit& u) { return u.pn < 4; }
    static __device__ __forceinline__ float ex(float g) { return __builtin_amdgcn_exp2f(g * -1.4426950408889634f); }
    __device__ __forceinline__ int operator()(f32x4 (&acc)[2][2][4][2], const Unit& u, int wr, int wc, int fr, int fq) const {
        const bool first = u.pn < 4;
        const int rowb = u.pm * 256 + wr * 64 + fr, colb = (u.pn & 3) * 256 + wc * 32 + 8 * fq;
        if (first) {
#pragma unroll
            for (int ai = 0; ai < 2; ++ai) {
                uint2 ga[4][2], gb[4][2];
#pragma unroll
                for (int mp = 0; mp < 2; ++mp)
#pragma unroll
                    for (int bj = 0; bj < 2; ++bj) { const int ln16 = (fq * 16 + fr) * 16; const u32x4 qa = *(const u32x4*)(G + gate_block(u.pm, u.pn & 3, wr * 4 + wc, ai, mp, bj) + ln16), qb = *(const u32x4*)(G + gate_block(u.pm, 4 + (u.pn & 3), wr * 4 + wc, ai, mp, bj) + ln16);
                        ga[2 * mp][bj] = make_uint2(qa.x, qa.y); ga[2 * mp + 1][bj] = make_uint2(qa.z, qa.w); gb[2 * mp][bj] = make_uint2(qb.x, qb.y); gb[2 * mp + 1][bj] = make_uint2(qb.z, qb.w); }
#pragma unroll
                for (int m = 0; m < 4; ++m)
#pragma unroll
                    for (int bj = 0; bj < 2; ++bj) {
                        const f32x2_t a01 = __builtin_amdgcn_cvt_pk_f32_fp8((int)ga[m][bj].x, false), a23 = __builtin_amdgcn_cvt_pk_f32_fp8((int)ga[m][bj].x, true), a45 = __builtin_amdgcn_cvt_pk_f32_fp8((int)ga[m][bj].y, false), a67 = __builtin_amdgcn_cvt_pk_f32_fp8((int)ga[m][bj].y, true);
                        const f32x2_t b01 = __builtin_amdgcn_cvt_pk_f32_fp8((int)gb[m][bj].x, false), b23 = __builtin_amdgcn_cvt_pk_f32_fp8((int)gb[m][bj].x, true), b45 = __builtin_amdgcn_cvt_pk_f32_fp8((int)gb[m][bj].y, false), b67 = __builtin_amdgcn_cvt_pk_f32_fp8((int)gb[m][bj].y, true);
                        const float ga8[8] = {a01.x, a01.y, a23.x, a23.y, a45.x, a45.y, a67.x, a67.y}, gb8[8] = {b01.x, b01.y, b23.x, b23.y, b45.x, b45.y, b67.x, b67.y};
#pragma unroll
                        for (int n = 0; n < 2; ++n)
#pragma unroll
                            for (int i = 0; i < 4; ++i) acc[ai][bj][m][n][i] *= (1.0f + ex(gb8[4 * n + i])) * __builtin_amdgcn_rcpf(1.0f + ex(ga8[4 * n + i]));
                    }
            }
            return 32;
        }
#pragma unroll
        for (int ai = 0; ai < 2; ++ai) {
            uint2 gb[4][2];
#pragma unroll
            for (int mp = 0; mp < 2; ++mp)
#pragma unroll
                for (int bj = 0; bj < 2; ++bj) { const u32x4 qb = *(const u32x4*)(G + gate_block(u.pm, 4 + (u.pn & 3), wr * 4 + wc, ai, mp, bj) + (fq * 16 + fr) * 16); gb[2 * mp][bj] = make_uint2(qb.x, qb.y); gb[2 * mp + 1][bj] = make_uint2(qb.z, qb.w); }
#pragma unroll
            for (int m = 0; m < 4; ++m) { const int row = rowb + ai * 128 + m * 16;
#pragma unroll
                for (int bj = 0; bj < 2; ++bj) { const int col = colb + 128 * bj;
                    const f32x2_t b01 = __builtin_amdgcn_cvt_pk_f32_fp8((int)gb[m][bj].x, false), b23 = __builtin_amdgcn_cvt_pk_f32_fp8((int)gb[m][bj].x, true), b45 = __builtin_amdgcn_cvt_pk_f32_fp8((int)gb[m][bj].y, false), b67 = __builtin_amdgcn_cvt_pk_f32_fp8((int)gb[m][bj].y, true);
                    const f32x4 a0 = acc[ai][bj][m][0], a1 = acc[ai][bj][m][1];
                    const float v[8] = {a0[0] * sigm(b01.x), a0[1] * sigm(b01.y), a0[2] * sigm(b23.x), a0[3] * sigm(b23.y), a1[0] * sigm(b45.x), a1[1] * sigm(b45.y), a1[2] * sigm(b67.x), a1[3] * sigm(b67.y)};
                    u32x4 w; w.x = cvt_pk_bf16(v[0], v[1]); w.y = cvt_pk_bf16(v[2], v[3]); w.z = cvt_pk_bf16(v[4], v[5]); w.w = cvt_pk_bf16(v[6], v[7]);
                    *(u32x4*)(O + (size_t)row * 1024 + col) = w; } }
        }
        return 32;
    }
};

struct EpiRes {
    static constexpr bool PERM = true, AFTER_DRAIN = false, CARRY = false; static constexpr int VMEM_MIN = 40;
    bf16_t* XB; float* ssout; float* fout; bf16_t* XO;
    __device__ __forceinline__ int operator()(const f32x4 (&acc)[2][2][4][2], const Unit& u, int wr, int wc, int fr, int fq) const {
        const int rowb = u.pm * 256 + wr * 64 + fr, colb = u.pn * 256 + wc * 32 + 8 * fq;
        u32x4 bw[2][4][2];
#pragma unroll
        for (int ai = 0; ai < 2; ++ai)
#pragma unroll
            for (int m = 0; m < 4; ++m)
#pragma unroll
                for (int bj = 0; bj < 2; ++bj) bw[ai][m][bj] = *(const u32x4*)(XB + (size_t)(rowb + ai * 128 + m * 16) * 1024 + colb + 128 * bj);
#pragma unroll
        for (int ai = 0; ai < 2; ++ai)
#pragma unroll
            for (int m = 0; m < 4; ++m) { const int row = rowb + ai * 128 + m * 16; float q = 0.f;
#pragma unroll
                for (int bj = 0; bj < 2; ++bj) { const size_t off = (size_t)row * 1024 + colb + 128 * bj; const u32x4 b = bw[ai][m][bj];
                    const f32x4 o0 = (f32x4){bflo(b.x), bfhi(b.x), bflo(b.y), bfhi(b.y)} + acc[ai][bj][m][0], o1 = (f32x4){bflo(b.z), bfhi(b.z), bflo(b.w), bfhi(b.w)} + acc[ai][bj][m][1];
                    if (fout) { *(f32x4*)(fout + off) = o0; *(f32x4*)(fout + off + 4) = o1; }
                    u32x4 w; w.x = cvt_pk_bf16(o0[0], o0[1]); w.y = cvt_pk_bf16(o0[2], o0[3]); w.z = cvt_pk_bf16(o1[0], o1[1]); w.w = cvt_pk_bf16(o1[2], o1[3]);
                    if (!fout) *(u32x4*)(XO + off) = w;
                    q += ((o0[0] * o0[0] + o0[1] * o0[1]) + (o0[2] * o0[2] + o0[3] * o0[3])) + ((o1[0] * o1[0] + o1[1] * o1[1]) + (o1[2] * o1[2] + o1[3] * o1[3])); }
                q = sum_fq(q);
                if (fq == 0 && !fout) ssout[(size_t)row * 16 + u.pn * 4 + wc] = q; }
        return 40;
    }
};

struct EpiSwiglu {
    static constexpr bool PERM = true, AFTER_DRAIN = false, CARRY = false; static constexpr int VMEM_MIN = 8;
    PG8_LAS unsigned char* ldsb; bf16_t* ACT;
    __device__ __forceinline__ int operator()(const f32x4 (&acc)[2][2][4][2], const Unit& u, int wr, int wc, int fr, int fq) const {
        const int rowb = u.pm * 256 + wr * 64 + fr, colb = u.pn * 128 + wc * 32 + 8 * fq;
        const PG8_LAS float* rt = rstd_slot(ldsb, u.pm) + wr * 64 + fr;
#pragma unroll
        for (int ai = 0; ai < 2; ++ai)
#pragma unroll
            for (int m = 0; m < 4; ++m) { const int row = rowb + ai * 128 + m * 16; const float r = rt[ai * 128 + m * 16];
                float a[8];
#pragma unroll
                for (int n = 0; n < 2; ++n)
#pragma unroll
                    for (int i = 0; i < 4; ++i) { const float g = acc[ai][0][m][n][i] * r, up = acc[ai][1][m][n][i] * r; a[4 * n + i] = (g * sigm(g)) * up; }
                u32x4 w; w.x = cvt_pk_bf16(a[0], a[1]); w.y = cvt_pk_bf16(a[2], a[3]); w.z = cvt_pk_bf16(a[4], a[5]); w.w = cvt_pk_bf16(a[6], a[7]);
                *(u32x4*)(ACT + (size_t)row * 2816 + colb) = w; }
        return 16;
    }
};

template <int MODE> struct EpiProbe {
    static constexpr bool PERM = true, AFTER_DRAIN = false, CARRY = false; static constexpr int VMEM_MIN = 0;
    bf16_t* ACT;
    __device__ __forceinline__ int operator()(const f32x4 (&acc)[2][2][4][2], const Unit& u, int wr, int wc, int fr, int fq) const {
#pragma unroll
        for (int ai = 0; ai < 2; ++ai)
#pragma unroll
            for (int bj = 0; bj < 2; ++bj)
#pragma unroll
                for (int m = 0; m < 4; ++m) asm volatile("" :: "v"(acc[ai][bj][m][0]), "v"(acc[ai][bj][m][1]));
        if (MODE == 0) return 0;
        const int rowb = u.pm * 256 + wr * 64 + fr, colb = u.pn * 128 + wc * 32 + 8 * fq;
#pragma unroll
        for (int ai = 0; ai < 2; ++ai)
#pragma unroll
            for (int m = 0; m < 4; ++m) { const int row = rowb + ai * 128 + m * 16; u32x4 w; w.x = cvt_pk_bf16(acc[ai][0][m][0][0], acc[ai][0][m][0][1]); w.y = cvt_pk_bf16(acc[ai][0][m][0][2], acc[ai][0][m][0][3]); w.z = cvt_pk_bf16(acc[ai][1][m][1][0], acc[ai][1][m][1][1]); w.w = cvt_pk_bf16(acc[ai][1][m][1][2], acc[ai][1][m][1][3]);
                *(u32x4*)(ACT + (size_t)row * 2816 + colb) = w; }
        return 8;
    }
};
}
#include <hip/hip_bf16.h>
#include <cmath>
namespace attn_body {
using bf16=__hip_bfloat16;
using bf16x8=__attribute__((ext_vector_type(8)))short;
using s16x4=__attribute__((ext_vector_type(4)))short;
using f32x16=__attribute__((ext_vector_type(16)))float;
using u32x4=__attribute__((ext_vector_type(4)))unsigned;
constexpr int SEQ=2048,D=64,DM=512;
constexpr int NW=8,QBLK=32,QB=QBLK*NW,KVBLK=64,NQB=SEQ/QB;
constexpr int ATTN_PITCH=DM, ATTN_UNIT_ROWS=QB;
__device__ __forceinline__ int crow(int r,int hi){return (r&3)+8*(r>>2)+4*hi;}
#define SBAR() __builtin_amdgcn_sched_barrier(0)
__device__ __forceinline__ void cmask(f32x16&p0,f32x16&p1,int jb,int qrel,int hi){
  const float NEG=-INFINITY; int qh=qrel-64*jb-4*hi; asm volatile("":"+v"(qh));
  #pragma unroll
  for(int r=0;r<16;++r){const int c=(r&3)+8*(r>>2); if(c>qh)p0[r]=NEG; if(c+32>qh)p1[r]=NEG;}
}

constexpr int NSLOT=3, SLOTB=8192;
constexpr int LDS_K=0, LDS_V=NSLOT*SLOTB, LDS_WS=2*NSLOT*SLOTB, LDS_OST=LDS_WS+NW*64*4, LDS_BYTES=LDS_OST+NW*4096;
constexpr float C2=0.125f*1.4426950408889634f;
__device__ __forceinline__ void glds16(const void*gsrc,unsigned lds_dst){unsigned keep;
  asm volatile("s_mov_b32 %0, m0\n\ts_mov_b32 m0, %2\n\ts_nop 0\n\tglobal_load_lds_dwordx4 %1, off\n\ts_mov_b32 m0, %0":"=&s"(keep):"v"(gsrc),"s"(lds_dst):"memory");}
__device__ __forceinline__ float max3f(float a,float b,float c){float r;asm("v_max3_f32 %0, %1, %2, %3":"=v"(r):"v"(a),"v"(b),"v"(c));return r;}
__device__ __forceinline__ float max2f(float a,float b){float r;asm("v_max_f32_e32 %0, %1, %2":"=v"(r):"v"(a),"v"(b));return r;}
__device__ __forceinline__ float fadd_s(float a,float b){float r;asm("v_add_f32_e32 %0, %1, %2":"=v"(r):"v"(a),"v"(b));return r;}
__device__ __forceinline__ float fsub_s(float a,float b){float r;asm("v_sub_f32_e32 %0, %1, %2":"=v"(r):"v"(a),"v"(b));return r;}
typedef float f32x2_t __attribute__((ext_vector_type(2))); typedef __bf16 bf16x2_t __attribute__((ext_vector_type(2)));
__device__ __forceinline__ unsigned cvtpk_s(float lo,float hi){f32x2_t v={lo,hi};bf16x2_t b=__builtin_convertvector(v,bf16x2_t);return __builtin_bit_cast(unsigned,b);}
#define WAIT_BAR(N) asm volatile("s_waitcnt vmcnt(" #N ") lgkmcnt(0)\n\ts_barrier":::"memory")

__device__ __forceinline__ void qkt(f32x16&p0,f32x16&p1,const char*Kslot,const bf16x8*qr,const f32x16&negm,int r32,int hi){
  const char*kb=Kslot+hi*1024+r32*16;
  #pragma unroll
  for(int d0=0;d0<4;++d0){
    const bf16x8 b0=*reinterpret_cast<const bf16x8*>(kb+d0*2048);
    const bf16x8 b1=*reinterpret_cast<const bf16x8*>(kb+d0*2048+512);
    if(d0==0){p0=__builtin_amdgcn_mfma_f32_32x32x16_bf16(b0,qr[0],negm,0,0,0);p1=__builtin_amdgcn_mfma_f32_32x32x16_bf16(b1,qr[0],negm,0,0,0);}
    else{p0=__builtin_amdgcn_mfma_f32_32x32x16_bf16(b0,qr[d0],p0,0,0,0);p1=__builtin_amdgcn_mfma_f32_32x32x16_bf16(b1,qr[d0],p1,0,0,0);}}
}
typedef __attribute__((address_space(3))) const char* lds_cptr;
typedef short v4i16_t __attribute__((ext_vector_type(4)));
__device__ __forceinline__ void kload8(bf16x8*kf,lds_cptr kp){
  kf[0]=*(const __attribute__((address_space(3))) bf16x8*)(kp);      kf[1]=*(const __attribute__((address_space(3))) bf16x8*)(kp+512);
  kf[2]=*(const __attribute__((address_space(3))) bf16x8*)(kp+2048); kf[3]=*(const __attribute__((address_space(3))) bf16x8*)(kp+2560);
  kf[4]=*(const __attribute__((address_space(3))) bf16x8*)(kp+4096); kf[5]=*(const __attribute__((address_space(3))) bf16x8*)(kp+4608);
  kf[6]=*(const __attribute__((address_space(3))) bf16x8*)(kp+6144); kf[7]=*(const __attribute__((address_space(3))) bf16x8*)(kp+6656);
}
__device__ __forceinline__ void kload2(bf16x8*kf,lds_cptr kp,int j){ kf[2*j]=*(const __attribute__((address_space(3))) bf16x8*)(kp+j*2048); kf[2*j+1]=*(const __attribute__((address_space(3))) bf16x8*)(kp+j*2048+512); }
__device__ __forceinline__ s16x4 vtr(lds_cptr p){ return __builtin_bit_cast(s16x4,__builtin_amdgcn_ds_read_tr16_b64_v4i16((__attribute__((address_space(3))) v4i16_t*)p)); }
__device__ __forceinline__ float rowmax(const f32x16&p0,const f32x16&p1){
  float a=max3f(p0[0],p0[1],p1[0]),b=max3f(p0[2],p0[3],p1[1]);a=max3f(a,p1[2],p1[3]);
  #pragma unroll
  for(int r=4;r<16;r+=4){a=max3f(a,p0[r],p0[r+1]);b=max3f(b,p0[r+2],p0[r+3]);a=max3f(a,p1[r],p1[r+1]);b=max3f(b,p1[r+2],p1[r+3]);}
  const float m=max2f(a,b);
  auto rr=__builtin_amdgcn_permlane32_swap(__float_as_uint(m),__float_as_uint(m),false,false);
  return max2f(__uint_as_float(rr[0]),__uint_as_float(rr[1]));
}
template<int NO> __device__ __forceinline__ void pv(f32x16*o,int vb,bf16x8 pa0,bf16x8 pa1,bf16x8 pa2,bf16x8 pa3){
  #pragma unroll
  for(int d0=0;d0<NO;++d0){s16x4 lo[4],hi[4];
    #pragma unroll
    for(int ks=0;ks<4;++ks){
      asm volatile("ds_read_b64_tr_b16 %0,%1 offset:%c2":"=&v"(lo[ks]):"v"(vb),"i"(d0*4096+ks*1024):"memory");
      asm volatile("ds_read_b64_tr_b16 %0,%1 offset:%c2":"=&v"(hi[ks]):"v"(vb),"i"(d0*4096+ks*1024+512):"memory");}
    asm volatile("s_waitcnt lgkmcnt(0)":::"memory");SBAR();
    #define PK(k) (bf16x8){lo[k][0],lo[k][1],lo[k][2],lo[k][3],hi[k][0],hi[k][1],hi[k][2],hi[k][3]}
    o[d0]=__builtin_amdgcn_mfma_f32_32x32x16_bf16(pa0,PK(0),o[d0],0,0,0);
    o[d0]=__builtin_amdgcn_mfma_f32_32x32x16_bf16(pa1,PK(1),o[d0],0,0,0);
    o[d0]=__builtin_amdgcn_mfma_f32_32x32x16_bf16(pa2,PK(2),o[d0],0,0,0);
    o[d0]=__builtin_amdgcn_mfma_f32_32x32x16_bf16(pa3,PK(3),o[d0],0,0,0);
    #undef PK
  }
}

#ifndef ATTN_STORE16
#define ATTN_STORE16(p,v) (*(u32x4*)(p)=(v))
#endif
template<int THRL,bool TOPK,bool DV> __device__ __forceinline__ void attn_unit(int b,int qb,const bf16*Qc,const bf16*__restrict__ Kc,const bf16*__restrict__ Vc,bf16*Oc,const unsigned*__restrict__ mk,char*shm,const int wave_in,const bool cmb=false,const bf16*Oprev=nullptr,const float*__restrict__ subg=nullptr,const float lam=0.f,const float oscale=0.f){
  int lane_; asm volatile("v_mbcnt_lo_u32_b32 %0, -1, 0\n\tv_mbcnt_hi_u32_b32 %0, -1, %0":"=v"(lane_)); const int lane=lane_,r32=lane&31,hi=lane>>5; const int wid=wave_in;
  const long rowbase=(long)b*SEQ; const int q0=qb*QB;
  constexpr int VSL=DV?2:1, NO=DV?4:2, LW=LDS_V+NSLOT*SLOTB*VSL, LO=LW+NW*64*4;
  const bf16*Qw=Qc+(rowbase+q0+wid*QBLK)*DM;
  const bf16*Kh=Kc+rowbase*DM,*Vh=Vc+rowbase*DM;
  const unsigned lds0=(unsigned)(uintptr_t)shm;
  float*wsf=(float*)(shm+LW)+wid*64;
  const bf16*ksrc=Kh+wid*512+lane*8;
  const bf16*vsrc=Vh+wid*512+lane*8;
  const unsigned kdst=lds0+LDS_K+wid*1024, vdst=lds0+LDS_V+wid*1024;
  #define DMA_K(t,slot) glds16(ksrc+(long)(t)*(KVBLK*64),(unsigned)__builtin_amdgcn_readfirstlane(kdst+(slot)))
  #define DMA_V(t,slot) do{ glds16(vsrc+(long)(t)*(DV?8192:4096),(unsigned)__builtin_amdgcn_readfirstlane(vdst+VSL*(slot))); if(DV){ glds16(vsrc+(long)(t)*8192+4096,(unsigned)__builtin_amdgcn_readfirstlane(vdst+VSL*(slot)+8192)); } }while(0)
  const int vb0=(int)(lds0+LDS_V)+((lane>>4)&1)*32+(lane&3)*8+(4*hi+((lane&15)>>2))*64;
  const char*Kbase=shm+LDS_K; bf16x8 kf[8];
  const lds_cptr shm3=(lds_cptr)shm; const lds_cptr kp0=shm3+LDS_K+hi*1024+r32*16; const lds_cptr vp0=shm3+LDS_V+((lane>>4)&1)*32+(lane&3)*8+(4*hi+((lane&15)>>2))*64;
  const int NT=(q0+QB)/KVBLK;
  DMA_K(0,0);DMA_V(0,0);DMA_K(1,SLOTB);
  bf16x8 qr[4];
  #pragma unroll
  for(int d0=0;d0<4;++d0)qr[d0]=*reinterpret_cast<const bf16x8*>(&Qw[(long)r32*DM+d0*16+hi*8]);
  float mhat=0.f,l_reg=0.f;f32x16 o[NO]; _Pragma("unroll") for(int d_=0;d_<NO;++d_)o[d_]=f32x16{};f32x16 negm=f32x16{}; if(!DV){asm volatile("":"+v"(negm));}
  const int qrel=wid*QBLK+r32;
  const unsigned*mrow=TOPK?(mk+((size_t)(b*64+qb*8+wid)*32)*64+r32*2):nullptr; const int sh4=4*hi; unsigned mw0=0u,mw1=0u; uint2 mwl=make_uint2(0u,0u);
  #define MLOAD(t) do{ if(TOPK){ mwl=*reinterpret_cast<const uint2*>(mrow+(size_t)(t)*64); } }while(0)
  #define MSHIFT() do{ if(TOPK){ mw0=mwl.x>>sh4; mw1=mwl.y>>sh4; asm volatile("":"+v"(mw0),"+v"(mw1)); } }while(0)
  #define MBIT(W,r) ((unsigned)__builtin_amdgcn_sbfe((int)(W),((r)&3)+8*((r)>>2),1))
  #define MAND(X,r,W) do{ if(TOPK){ X[r]=__uint_as_float(__float_as_uint(X[r])&MBIT(W,r)); } }while(0)
  MLOAD(0);
  #define CMASK(P0,P1,t) do{int jb_=(t)-(NT-4); if(jb_>=0)cmask(P0,P1,jb_,qrel,hi);}while(0)
  bool resc=false;
  #define START(P0,P1) do{ const float rm=rowmax(P0,P1); resc=false; \
    { const float dl=rm; mhat=fadd_s(mhat,dl); \
      _Pragma("unroll") for(int r=0;r<16;++r){P0[r]=fsub_s(P0[r],dl);P1[r]=fsub_s(P1[r],dl);} \
      if(!DV){ _Pragma("unroll") for(int r=0;r<16;++r)negm[r]=-mhat; asm volatile("":"+v"(negm)); } } \
    _Pragma("unroll") for(int r=0;r<16;++r)P0[r]=__builtin_amdgcn_exp2f(P0[r]); }while(0)
  #define RESC() do{ if(resc){ asm volatile("s_waitcnt lgkmcnt(0)":::"memory"); \
      _Pragma("unroll") for(int d_=0;d_<NO;++d_) _Pragma("unroll") for(int r=0;r<16;++r)o[d_][r]*=wsf[crow(r,hi)]; } }while(0)
  f32x16 pA0,pA1,pB0,pB1;
  int sl_prev=0,sl_cur=0,sl_next=SLOTB;
  #define ROT() do{sl_prev=sl_cur;sl_cur=sl_next;sl_next=(sl_next==(NSLOT-1)*SLOTB)?0:sl_next+SLOTB;}while(0)
  #define WAIT_BAR_KV() do{ if(DV){WAIT_BAR(3);}else{WAIT_BAR(2);} }while(0)
  #define WAIT_BAR_V() do{ if(DV){WAIT_BAR(2);}else{WAIT_BAR(1);} }while(0)
  DMA_K(2,2*SLOTB);
  WAIT_BAR(3);
  qkt(pA0,pA1,Kbase,qr,negm,r32,hi);    asm volatile("s_nop 15\n\ts_nop 7":"+v"(pA0),"+v"(pA1));CMASK(pA0,pA1,0);
  START(pA0,pA1);
  _Pragma("unroll") for(int r=0;r<16;++r)pA1[r]=__builtin_amdgcn_exp2f(pA1[r]);
  if(TOPK){ MSHIFT(); _Pragma("unroll") for(int r=0;r<16;++r){ MAND(pA0,r,mw0); MAND(pA1,r,mw1); } }
  WAIT_BAR(0);
  DMA_K(3,0);DMA_V(1,SLOTB);
  ROT();
  kload8(kf,kp0+sl_cur);
  WAIT_BAR_KV();
  s16x4 vlo[8],vhi[8]; u32x4 pw0,pw1,pw2,pw3;
  #define PKW(P,B) cvtpk_s(P[B],P[B+1])
  #define PAF(k) __builtin_bit_cast(bf16x8,pw##k)
  #define VFR(i) (bf16x8){vlo[i][0],vlo[i][1],vlo[i][2],vlo[i][3],vhi[i][0],vhi[i][1],vhi[i][2],vhi[i][3]}
  #define PIN(x) asm volatile("":"+v"(x))
  #define MX3(a,b,c) __builtin_fmaxf(__builtin_fmaxf((a),(b)),(c))
  #define GAPA(MF,A0,A1,A2,A3,W0,W1,PW) do{ MF; sacc2+=(f32x2_t){A0,A1}; sacc2+=(f32x2_t){A2,A3}; PIN(sacc2); W0; W1; PIN(PW); SBAR(); }while(0)
  #define EX(v) (DV?__builtin_amdgcn_exp2f((v)-mhat):__builtin_amdgcn_exp2f(v))
  #define QKC0 (DV?f32x16{}:negm)
  #define GAPB(MF,X,B,W) do{ MF; if(DV){ const f32x2_t t0_=(f32x2_t){X[B],X[B+1]}-(f32x2_t){mhat,mhat}, t1_=(f32x2_t){X[B+2],X[B+3]}-(f32x2_t){mhat,mhat}; X[B]=__builtin_amdgcn_exp2f(t0_.x); X[B+1]=__builtin_amdgcn_exp2f(t0_.y); X[B+2]=__builtin_amdgcn_exp2f(t1_.x); X[B+3]=__builtin_amdgcn_exp2f(t1_.y); } else { X[B]=EX(X[B]); X[B+1]=EX(X[B+1]); X[B+2]=EX(X[B+2]); X[B+3]=EX(X[B+3]); } MAND(X,B,W); MAND(X,B+1,W); MAND(X,B+2,W); MAND(X,B+3,W); PIN(X); SBAR(); }while(0)
  #define VRD(i) do{ vlo[i]=vtr(vp_+(((i)>>2)*4096+((i)&3)*1024)); vhi[i]=vtr(vp_+(((i)>>2)*4096+((i)&3)*1024+512)); }while(0)
  #define KRD(G,j) do{ if(G){ kload2(kf,kp0+sl_next,j); SBAR(); } }while(0)
  #define VRD2(i) do{ if(DV){ vlo[i]=vtr(vp_+(8192+((i)>>2)*4096+((i)&3)*1024)); vhi[i]=vtr(vp_+(8192+((i)>>2)*4096+((i)&3)*1024+512)); SBAR(); } }while(0)
  #define STEP(C0,C1,P0,P1,t,GK,GV,GL) do{ SBAR(); MLOAD(t); \
    const lds_cptr vp_=vp0+VSL*sl_prev; \
    VRD(0); SBAR(); f32x2_t sacc2={P0[0],P0[1]}; \
    GAPA(C0=__builtin_amdgcn_mfma_f32_32x32x16_bf16(kf[0],qr[0],QKC0,0,0,0), P0[2],P0[3],P0[4],P0[5],     pw0[0]=PKW(P0,0), pw0[1]=PKW(P0,2), pw0); \
    VRD(4); SBAR(); GAPA(C1=__builtin_amdgcn_mfma_f32_32x32x16_bf16(kf[1],qr[0],QKC0,0,0,0), P0[6],P0[7],P0[8],P0[9],     pw0[2]=PKW(P0,4), pw0[3]=PKW(P0,6), pw0); \
    VRD(1); SBAR(); GAPA(C0=__builtin_amdgcn_mfma_f32_32x32x16_bf16(kf[2],qr[1],C0,0,0,0),   P0[10],P0[11],P0[12],P0[13], pw1[0]=PKW(P0,8), pw1[1]=PKW(P0,10), pw1); \
    VRD(5); SBAR(); GAPA(C1=__builtin_amdgcn_mfma_f32_32x32x16_bf16(kf[3],qr[1],C1,0,0,0),   P0[14],P0[15],P1[0],P1[1],   pw1[2]=PKW(P0,12),pw1[3]=PKW(P0,14), pw1); \
    VRD(2); SBAR(); GAPA(C0=__builtin_amdgcn_mfma_f32_32x32x16_bf16(kf[4],qr[2],C0,0,0,0),   P1[2],P1[3],P1[4],P1[5],     pw2[0]=PKW(P1,0), pw2[1]=PKW(P1,2), pw2); \
    VRD(6); SBAR(); GAPA(C1=__builtin_amdgcn_mfma_f32_32x32x16_bf16(kf[5],qr[2],C1,0,0,0),   P1[6],P1[7],P1[8],P1[9],     pw2[2]=PKW(P1,4), pw2[3]=PKW(P1,6), pw2); \
    VRD(3); SBAR(); GAPA(C0=__builtin_amdgcn_mfma_f32_32x32x16_bf16(kf[6],qr[3],C0,0,0,0),   P1[10],P1[11],P1[12],P1[13], pw3[0]=PKW(P1,8), pw3[1]=PKW(P1,10), pw3); \
    VRD(7); SBAR(); GAPA(C1=__builtin_amdgcn_mfma_f32_32x32x16_bf16(kf[7],qr[3],C1,0,0,0),   P1[14],P1[15],0.f,0.f,       pw3[2]=PKW(P1,12),pw3[3]=PKW(P1,14), pw3); \
    l_reg+=sacc2.x+sacc2.y; \
    MSHIFT(); if(GK){DMA_K((t)+3,sl_cur);} if(GV){DMA_V((t)+1,sl_next);} \
    CMASK(C0,C1,t); \
    { float a=MX3(C0[0],C0[1],C1[0]),b=MX3(C0[2],C0[3],C1[1]); a=MX3(a,C1[2],C1[3]); \
      _Pragma("unroll") for(int r=4;r<16;r+=4){a=MX3(a,C0[r],C0[r+1]);b=MX3(b,C0[r+2],C0[r+3]);a=MX3(a,C1[r],C1[r+1]);b=MX3(b,C1[r+2],C1[r+3]);} \
      float rm=__builtin_fmaxf(a,b); { auto rr=__builtin_amdgcn_permlane32_swap(__float_as_uint(rm),__float_as_uint(rm),false,false); rm=__builtin_fmaxf(__uint_as_float(rr[0]),__uint_as_float(rr[1])); } \
      resc=false; \
      if(DV) rm-=mhat; \
      if(__builtin_expect(__any(rm>(float)THRL),0)){ const float dl=__builtin_fmaxf(rm,0.f); mhat+=dl; \
        if(!DV){ _Pragma("unroll") for(int r=0;r<16;++r){C0[r]-=dl;C1[r]-=dl;} \
        _Pragma("unroll") for(int r=0;r<16;++r)negm[r]=-mhat; asm volatile("":"+v"(negm)); } \
        const float f=__builtin_amdgcn_exp2f(-dl); l_reg*=f; if(hi==0)wsf[r32]=f; resc=true; } } \
    SBAR(); \
    GAPB(o[0]=__builtin_amdgcn_mfma_f32_32x32x16_bf16(PAF(0),VFR(0),o[0],0,0,0), C0,0,mw0); VRD2(0); \
    GAPB(o[1]=__builtin_amdgcn_mfma_f32_32x32x16_bf16(PAF(0),VFR(4),o[1],0,0,0), C0,4,mw0); VRD2(4); \
    KRD(GL,0); GAPB(o[0]=__builtin_amdgcn_mfma_f32_32x32x16_bf16(PAF(1),VFR(1),o[0],0,0,0), C0,8,mw0); VRD2(1); \
    KRD(GL,1); GAPB(o[1]=__builtin_amdgcn_mfma_f32_32x32x16_bf16(PAF(1),VFR(5),o[1],0,0,0), C0,12,mw0); VRD2(5); \
    KRD(GL,2); GAPB(o[0]=__builtin_amdgcn_mfma_f32_32x32x16_bf16(PAF(2),VFR(2),o[0],0,0,0), C1,0,mw1); VRD2(2); \
    KRD(GL,3); GAPB(o[1]=__builtin_amdgcn_mfma_f32_32x32x16_bf16(PAF(2),VFR(6),o[1],0,0,0), C1,4,mw1); VRD2(6); \
    GAPB(o[0]=__builtin_amdgcn_mfma_f32_32x32x16_bf16(PAF(3),VFR(3),o[0],0,0,0), C1,8,mw1); VRD2(3); \
    GAPB(o[1]=__builtin_amdgcn_mfma_f32_32x32x16_bf16(PAF(3),VFR(7),o[1],0,0,0), C1,12,mw1); VRD2(7); \
    if(DV){ \
      o[2]=__builtin_amdgcn_mfma_f32_32x32x16_bf16(PAF(0),VFR(0),o[2],0,0,0); o[3]=__builtin_amdgcn_mfma_f32_32x32x16_bf16(PAF(0),VFR(4),o[3],0,0,0); \
      o[2]=__builtin_amdgcn_mfma_f32_32x32x16_bf16(PAF(1),VFR(1),o[2],0,0,0); o[3]=__builtin_amdgcn_mfma_f32_32x32x16_bf16(PAF(1),VFR(5),o[3],0,0,0); \
      o[2]=__builtin_amdgcn_mfma_f32_32x32x16_bf16(PAF(2),VFR(2),o[2],0,0,0); o[3]=__builtin_amdgcn_mfma_f32_32x32x16_bf16(PAF(2),VFR(6),o[3],0,0,0); \
      o[2]=__builtin_amdgcn_mfma_f32_32x32x16_bf16(PAF(3),VFR(3),o[2],0,0,0); o[3]=__builtin_amdgcn_mfma_f32_32x32x16_bf16(PAF(3),VFR(7),o[3],0,0,0); SBAR(); } \
    }while(0)
  int t=1;
  #undef CMASK
  #define CMASK(P0,P1,t) do{}while(0)
  for(;t+5<NT;t+=2){
    STEP(pB0,pB1,pA0,pA1,t,true,true,true);     WAIT_BAR_KV(); RESC(); ROT();
    STEP(pA0,pA1,pB0,pB1,t+1,true,true,true);   WAIT_BAR_KV(); RESC(); ROT();
  }
  #undef CMASK
  #define CMASK(P0,P1,t) do{int jb_=(t)-(NT-4); if(jb_>=0)cmask(P0,P1,jb_,qrel,hi);}while(0)
  #define ENDW(tt) do{ if((tt)+3<NT){WAIT_BAR_KV();} else if((tt)+2<NT){WAIT_BAR_V();} else {WAIT_BAR(0);} }while(0)
  for(;t+3<NT;t+=2){
    STEP(pB0,pB1,pA0,pA1,t,(t+3<NT),(t+1<NT),(t+1<NT));       ENDW(t);   RESC(); ROT();
    STEP(pA0,pA1,pB0,pB1,t+1,(t+4<NT),(t+2<NT),(t+2<NT));     ENDW(t+1); RESC(); ROT();
  }
  STEP(pB0,pB1,pA0,pA1,NT-3,false,true,true);   ENDW(NT-3); RESC(); ROT();
  if(wid>=4){
    STEP(pA0,pA1,pB0,pB1,NT-2,false,true,true);   ENDW(NT-2); RESC(); ROT();
    if(wid>=6){ STEP(pB0,pB1,pA0,pA1,NT-1,false,false,false); RESC(); } else { pB0=pA0; pB1=pA1; sl_cur=sl_prev; }
  } else { DMA_V(NT-1,sl_next); ENDW(NT-2); ROT(); sl_cur=sl_next; }
  {
  { float sacc=pB0[0]+pB0[1]; _Pragma("unroll") for(int r=2;r<16;++r)sacc+=pB0[r]; _Pragma("unroll") for(int r=0;r<16;++r)sacc+=pB1[r]; l_reg+=sacc;
    pw0=(u32x4){PKW(pB0,0),PKW(pB0,2),PKW(pB0,4),PKW(pB0,6)};pw1=(u32x4){PKW(pB0,8),PKW(pB0,10),PKW(pB0,12),PKW(pB0,14)};pw2=(u32x4){PKW(pB1,0),PKW(pB1,2),PKW(pB1,4),PKW(pB1,6)};pw3=(u32x4){PKW(pB1,8),PKW(pB1,10),PKW(pB1,12),PKW(pB1,14)};
    SBAR(); pv<NO>(o,vb0+VSL*sl_cur,PAF(0),PAF(1),PAF(2),PAF(3)); }
  }
  #undef PKW
  #undef PAF
  #undef VFR
  #undef PIN
  #undef MX3
  #undef GAPA
  #undef GAPB
  #undef EX
  #undef QKC0
  #undef VRD
  #undef KRD
  #undef VRD2
  #undef STEP
  #undef ENDW
  {auto rr=__builtin_amdgcn_permlane32_swap(__float_as_uint(l_reg),__float_as_uint(l_reg),false,false);l_reg=__uint_as_float(rr[0])+__uint_as_float(rr[1]);}
  if(hi==0)wsf[32+r32]=l_reg;asm volatile("s_waitcnt lgkmcnt(0)":::"memory");
  float rli[16];
  #pragma unroll
  for(int r=0;r<16;++r)rli[r]=__builtin_amdgcn_rcpf(wsf[32+crow(r,hi)]);
  bf16*Ow=Oc+(rowbase+q0+wid*QBLK)*DM;
  if(DV&&cmb){
    bf16*stg=(bf16*)(shm+LO)+wid*2048; const bf16*Pw=Oprev+(rowbase+q0+wid*QBLK)*DM; const int ch=lane&7;
    float dd[2][4][8],ssq[4]={0.f,0.f,0.f,0.f},gg[2][8];
    #pragma unroll
    for(int hh=0;hh<2;++hh){ const float4 g0=*reinterpret_cast<const float4*>(subg+hh*64+ch*8),g1=*reinterpret_cast<const float4*>(subg+hh*64+ch*8+4);
      gg[hh][0]=g0.x*oscale;gg[hh][1]=g0.y*oscale;gg[hh][2]=g0.z*oscale;gg[hh][3]=g0.w*oscale;gg[hh][4]=g1.x*oscale;gg[hh][5]=g1.y*oscale;gg[hh][6]=g1.z*oscale;gg[hh][7]=g1.w*oscale; }
    #pragma unroll
    for(int hh=0;hh<2;++hh){
      u32x4 pv4[4];
      #pragma unroll
      for(int i=0;i<4;++i)pv4[i]=*reinterpret_cast<const u32x4*>(Pw+(long)(i*8+(lane>>3))*DM+hh*64+ch*8);
      #pragma unroll
      for(int r=0;r<16;++r){const int orow=crow(r,hi);
        #pragma unroll
        for(int d0=0;d0<2;++d0)stg[orow*64+d0*32+r32]=__float2bfloat16(o[2*hh+d0][r]*rli[r]);}
      asm volatile("s_waitcnt lgkmcnt(0)":::"memory");
      #pragma unroll
      for(int i=0;i<4;++i){const int row=i*8+(lane>>3); const u32x4 v=*(const u32x4*)(stg+row*64+ch*8); const u32x4 p=pv4[i];
        #pragma unroll
        for(int j=0;j<4;++j){ const float a0=__uint_as_float(p[j]<<16),a1=__uint_as_float(p[j]&0xffff0000u),b0=__uint_as_float(v[j]<<16),b1=__uint_as_float(v[j]&0xffff0000u);
          const float e0=a0-lam*b0,e1=a1-lam*b1; dd[hh][i][2*j]=e0; dd[hh][i][2*j+1]=e1; ssq[i]+=e0*e0+e1*e1; } }
      asm volatile("s_waitcnt lgkmcnt(0)":::"memory"); }
    #pragma unroll
    for(int i=0;i<4;++i){ float q=ssq[i];
      q+=__int_as_float(__builtin_amdgcn_ds_swizzle(__float_as_int(q),0x041F)); q+=__int_as_float(__builtin_amdgcn_ds_swizzle(__float_as_int(q),0x081F)); q+=__int_as_float(__builtin_amdgcn_ds_swizzle(__float_as_int(q),0x101F));
      const float rn=__builtin_amdgcn_rsqf(q*(1.0f/128.0f)+1e-6f); const int row=i*8+(lane>>3);
      #pragma unroll
      for(int hh=0;hh<2;++hh){ u32x4 w;
        #pragma unroll
        for(int j=0;j<4;++j)w[j]=cvtpk_s(dd[hh][i][2*j]*rn*gg[hh][2*j],dd[hh][i][2*j+1]*rn*gg[hh][2*j+1]);
        ATTN_STORE16(Ow+(long)row*DM+hh*64+ch*8,w); } }
  } else
  { bf16*stg=(bf16*)(shm+LO)+wid*2048;
    #pragma unroll
    for(int hh=0;hh<NO/2;++hh){
      #pragma unroll
      for(int r=0;r<16;++r){const int orow=crow(r,hi);
        #pragma unroll
        for(int d0=0;d0<2;++d0)stg[orow*64+d0*32+r32]=__float2bfloat16(o[2*hh+d0][r]*rli[r]);}
      asm volatile("s_waitcnt lgkmcnt(0)":::"memory");
      #pragma unroll
      for(int i=0;i<4;++i){const int row=i*8+(lane>>3),ch=lane&7; const u32x4 v=*(const u32x4*)(stg+row*64+ch*8); ATTN_STORE16(Ow+(long)row*DM+hh*64+ch*8,v);}
      asm volatile("s_waitcnt lgkmcnt(0)":::"memory"); } }
  asm volatile("s_waitcnt lgkmcnt(0)\n\ts_barrier":::"memory");
  #undef DMA_K
  #undef DMA_V
  #undef CMASK
  #undef START
  #undef RESC
  #undef ROT
  #undef WAIT_BAR_KV
  #undef WAIT_BAR_V
  #undef MLOAD
  #undef MSHIFT
  #undef MBIT
  #undef MAND
}
constexpr int ATTN_LDS_BYTES=LDS_BYTES;
#undef SBAR
#undef WAIT_BAR
}
#define GAS __attribute__((address_space(1)))
#define LAS __attribute__((address_space(3)))
typedef unsigned short bf16;
typedef unsigned v4u __attribute__((ext_vector_type(4)));
typedef float f32x4 __attribute__((ext_vector_type(4)));
typedef short bf16x8 __attribute__((ext_vector_type(8)));
typedef GAS unsigned gu32;
typedef GAS unsigned long long gu64;
#define RLX_AGENT __ATOMIC_RELAXED, __HIP_MEMORY_SCOPE_AGENT
#define LDS_WAIT() asm volatile("s_waitcnt lgkmcnt(0)" ::: "memory")
#define VM_WAIT() asm volatile("s_waitcnt vmcnt(0)" ::: "memory")
__device__ __forceinline__ unsigned long long rt() { return __builtin_amdgcn_s_memrealtime(); }
__device__ __forceinline__ unsigned f2bf(float f) { unsigned u = __builtin_bit_cast(unsigned, f); return (u + 0x7fffu + ((u >> 16) & 1u)) >> 16; }
__device__ __forceinline__ unsigned pk2(float lo, float hi) { return f2bf(lo) | (f2bf(hi) << 16); }

#define XB_TMO      128
#define XB_XCNT(j)  (256  + 64 * (j))
#define XB_XSUB(j)  (1280 + 64 * (j))
#define XB_XGEN(j)  (2304 + 64 * (j))
#define XB_TOP      3328
#define XB_TOPGEN   3392
#define XCD_BAR_WORDS 3456
#define XB_SPIN_CAP (1u << 18)

__device__ __forceinline__ unsigned xb_ld(unsigned* p)              { return __hip_atomic_load(p, __ATOMIC_RELAXED, __HIP_MEMORY_SCOPE_AGENT); }
__device__ __forceinline__ unsigned xb_add(unsigned* p, unsigned v) { return __hip_atomic_fetch_add(p, v, __ATOMIC_RELAXED, __HIP_MEMORY_SCOPE_AGENT); }
__device__ __forceinline__ unsigned xb_xcc_id() { return (unsigned)__builtin_amdgcn_s_getreg((3 << 11) | 20) & 0xFu; }
#define XB_SPIN(cond, bar) do { unsigned _sp = 0; while (cond) { __builtin_amdgcn_s_sleep(1); \
    if ((++_sp & 255u) == 0u) { if (xb_ld(&(bar)[XB_TMO])) break; if (_sp > XB_SPIN_CAP) { atomicAdd(&(bar)[XB_TMO], 1u); break; } } } } while (0)

struct XcdBarrier {
    unsigned* bar; unsigned x;
    volatile LAS unsigned* st;
};

__device__ __forceinline__ XcdBarrier xcd_barrier_post(unsigned* bar, volatile LAS unsigned* st) {
    XcdBarrier b; b.bar = bar; b.x = xb_xcc_id(); b.st = st;
    if (threadIdx.x == 0) (void)xb_add(&bar[XB_XCNT(b.x)], 1u);
    return b;
}
__device__ __forceinline__ void xcd_barrier_complete(unsigned* bar, unsigned x, unsigned& nloc, unsigned& nx) {
    const unsigned G = gridDim.x * gridDim.y * gridDim.z;
    unsigned sum, cnt, mine, sp = 0u;
    for (;;) {
        sum = 0u; cnt = 0u; mine = 0u;
#pragma unroll
        for (unsigned j = 0; j < 16; ++j) { const unsigned c = xb_ld(&bar[XB_XCNT(j)]); sum += c; cnt += (c > 0u) ? 1u : 0u; mine = (j == x) ? c : mine; }
        if (sum == G) break;
        __builtin_amdgcn_s_sleep(1);
        if ((++sp & 255u) == 0u) { if (xb_ld(&bar[XB_TMO])) break; if (sp > XB_SPIN_CAP) { atomicAdd(&bar[XB_TMO], 1u); break; } }
    }
    nloc = mine > 0u ? mine : 1u; nx = cnt > 0u ? cnt : 1u;
}

__device__ __forceinline__ void xcd_barrier(const XcdBarrier& b, const bool leader_thread  ) {
    asm volatile("s_waitcnt vmcnt(0)" ::: "memory");
    __syncthreads();
    if (leader_thread) {
        unsigned* bar = b.bar;
        __builtin_amdgcn_s_waitcnt(0);
        unsigned nloc = b.st[0], nx = b.st[1];
        if (nloc == 0u) { xcd_barrier_complete(bar, b.x, nloc, nx); b.st[0] = nloc; b.st[1] = nx; }
        const unsigned old = xb_add(&bar[XB_XSUB(b.x)], 1u);
        const unsigned gen = old / nloc;
        if (old + 1u == (gen + 1u) * nloc) {
            __builtin_amdgcn_fence(__ATOMIC_RELEASE, "agent");
            asm volatile("s_waitcnt vmcnt(0)" ::: "memory");
            const unsigned og = xb_add(&bar[XB_TOP], 1u);
            const unsigned tg = og / nx;
            if (og + 1u == (tg + 1u) * nx) xb_add(&bar[XB_TOPGEN], 1u);
            else XB_SPIN(xb_ld(&bar[XB_TOPGEN]) == tg, bar);
            __builtin_amdgcn_fence(__ATOMIC_ACQUIRE, "agent");
            xb_add(&bar[XB_XGEN(b.x)], 1u);
            asm volatile("s_waitcnt vmcnt(0)" ::: "memory");
        } else {
            XB_SPIN(xb_ld(&bar[XB_XGEN(b.x)]) == gen, bar);
            __builtin_amdgcn_fence(__ATOMIC_ACQUIRE, "agent");
            asm volatile("s_waitcnt vmcnt(0)" ::: "memory");
        }
    }
    __syncthreads();
}
namespace topk {
#define TK_LAS __attribute__((address_space(3)))
typedef short bf16x8 __attribute__((ext_vector_type(8)));
typedef float f32x16 __attribute__((ext_vector_type(16)));
typedef float f32x4 __attribute__((ext_vector_type(4)));
typedef float f32x2 __attribute__((ext_vector_type(2)));
__device__ __forceinline__ unsigned fkey(float s) { const unsigned uu = __float_as_uint(s); return uu ^ ((unsigned)((int)uu >> 31) | 0x80000000u); }
__device__ __forceinline__ float kfloat(unsigned k) { return __uint_as_float((k & 0x80000000u) ? (k ^ 0x80000000u) : ~k); }
typedef unsigned u32x4 __attribute__((ext_vector_type(4)));
typedef unsigned short bf16_t;
constexpr int KSEL = 256;
__device__ __forceinline__ int crow0(int r) { return (r & 3) + 8 * (r >> 2); }
__device__ __forceinline__ unsigned half_sum(unsigned c) { auto rr = __builtin_amdgcn_permlane32_swap(c, c, false, false); return rr[0] + rr[1]; }
__device__ __forceinline__ unsigned half_or(unsigned c) { auto rr = __builtin_amdgcn_permlane32_swap(c, c, false, false); return rr[0] | rr[1]; }

__device__ __forceinline__ void unit(int b, int g, const bf16_t* __restrict__ IQ, const bf16_t* __restrict__ IK, const float* __restrict__ IW, unsigned* __restrict__ MASK, TK_LAS unsigned char* lds, const int wave_in) {
    int lane_; asm volatile("v_mbcnt_lo_u32_b32 %0, -1, 0\n\tv_mbcnt_hi_u32_b32 %0, -1, %0" : "=v"(lane_));
    const int lane = lane_, r32 = lane & 31, hi = lane >> 5;
    const int w = wave_in, tid = w * 64 + lane;
    const int nt = g / 2 + 1;
    const int ntb = 4 * (g / 8) + 4;
    const int q = 32 * g + r32;
    const size_t rowq = (size_t)b * 2048 + q;
    const bool dotopk = (g >= 8);
    TK_LAS unsigned* cnt = (TK_LAS unsigned*)lds;
    TK_LAS unsigned* flag = (TK_LAS unsigned*)(lds + 2048);
    f32x2 sc[4][2][8];
    unsigned T = 0u, X = 2047u;
    if (dotopk) {
        if (tid == 0) flag[0] = 0u;
        const f32x4 wq = *(const f32x4*)(IW + rowq * 4);
        TK_LAS unsigned char* qlds = lds + 4096;
        { const bf16_t* qg = IQ + ((size_t)b * 2048 + 32 * g) * 256;
#pragma unroll
          for (int i = 0; i < 2; ++i) { const int pc = tid + 512 * i, row = pc >> 5, c16 = pc & 31; const u32x4 v = *(const u32x4*)(qg + row * 256 + c16 * 8); *(TK_LAS u32x4*)(qlds + row * 528 + c16 * 16) = v; } }
        __syncthreads();
        const TK_LAS unsigned char* qrd = qlds + r32 * 528 + hi * 16;
        const bf16_t* kbase = IK + (size_t)b * (2048 * 64) + lane * 8;
        bf16x8 kf[2][4];
        if (w < nt) {
#pragma unroll
            for (int d0 = 0; d0 < 4; ++d0) kf[0][d0] = *(const bf16x8*)(kbase + (size_t)(2 * w) * 2048 + d0 * 512);
        }
#pragma unroll
        for (int st = 0; st < 8; ++st) {
            const int jj = st >> 1, p = st & 1, tile = w + 8 * jj;
            if (st + 1 < 8) { const int jn = (st + 1) >> 1, pn = (st + 1) & 1, tn = w + 8 * jn;
                if (tn < nt) {
#pragma unroll
                    for (int d0 = 0; d0 < 4; ++d0) kf[(st + 1) & 1][d0] = *(const bf16x8*)(kbase + (size_t)(2 * tn + pn) * 2048 + d0 * 512);
                } }
            if (tile < nt) {
                f32x16 s = {0.f, 0.f, 0.f, 0.f, 0.f, 0.f, 0.f, 0.f, 0.f, 0.f, 0.f, 0.f, 0.f, 0.f, 0.f, 0.f};
#pragma unroll
                for (int h = 0; h < 4; ++h) {
                    f32x16 pp = {0.f, 0.f, 0.f, 0.f, 0.f, 0.f, 0.f, 0.f, 0.f, 0.f, 0.f, 0.f, 0.f, 0.f, 0.f, 0.f};
#pragma unroll
                    for (int d0 = 0; d0 < 4; ++d0) { const bf16x8 qf = *(const TK_LAS bf16x8*)(qrd + h * 128 + d0 * 32); pp = __builtin_amdgcn_mfma_f32_32x32x16_bf16(kf[st & 1][d0], qf, pp, 0, 0, 0); }
                    const float wh = wq[h];
#pragma unroll
                    for (int r = 0; r < 16; ++r) s[r] = __builtin_fmaf(wh, __builtin_fmaxf(pp[r], 0.f), s[r]);
                }
#pragma unroll
                for (int r = 0; r < 8; ++r) {
                    const float kp0 = (float)(64 * tile + 32 * p + crow0(2 * r) + 4 * hi + 1) * -0x1p-100f, kp1 = (float)(64 * tile + 32 * p + crow0(2 * r + 1) + 4 * hi + 1) * -0x1p-100f;
                    sc[jj][p][r] = (f32x2){s[2 * r] == 0.f ? kp0 : s[2 * r], s[2 * r + 1] == 0.f ? kp1 : s[2 * r + 1]}; }
                if (tile == nt - 1) {
#pragma unroll
                    for (int r = 0; r < 16; ++r) { const int kpos = 64 * tile + 32 * p + crow0(r) + 4 * hi; if (kpos > q) sc[jj][p][r >> 1][r & 1] = -INFINITY; }
                }
            } else {
#pragma unroll
                for (int r = 0; r < 8; ++r) sc[jj][p][r] = (f32x2){-INFINITY, -INFINITY};
            }
        }
        int par = 0;
        unsigned prefix = 0u, ge = 0u;
#define TK_REDUCE(c, tot) do { const unsigned c_ = half_sum(c); if (hi == 0) cnt[par * 256 + r32 * 8 + w] = c_; __syncthreads(); \
            const u32x4 a_ = *(const TK_LAS u32x4*)(cnt + par * 256 + r32 * 8), b_ = *(const TK_LAS u32x4*)(cnt + par * 256 + r32 * 8 + 4); \
            tot = ((a_.x + a_.y) + (a_.z + a_.w)) + ((b_.x + b_.y) + (b_.z + b_.w)); par ^= 1; } while (0)
        const f32x2 big2 = {0x1p100f, 0x1p100f};
        for (int bit = 31; bit >= 0; --bit) {
            const unsigned cand = prefix | (1u << bit);
            const float addend = (cand == 0x80000000u) ? 1.0f : -kfloat(cand - 1u) * 0x1p100f;
            const f32x2 add2 = {addend, addend};
            f32x2 c2 = {0.f, 0.f}, c3 = {0.f, 0.f};
#pragma unroll
            for (int jj = 0; jj < 4; ++jj) if (w + 8 * jj < nt) {
#pragma unroll
                for (int p = 0; p < 2; ++p)
#pragma unroll
                    for (int r = 0; r < 8; r += 2) { f32x2 i0, i1;
                        asm("v_pk_fma_f32 %2, %4, %6, %7 op_sel_hi:[1,0,0] clamp\n\tv_pk_fma_f32 %3, %5, %6, %7 op_sel_hi:[1,0,0] clamp\n\tv_pk_add_f32 %0, %0, %2\n\tv_pk_add_f32 %1, %1, %3"
                            : "+v"(c2), "+v"(c3), "=&v"(i0), "=&v"(i1) : "v"(sc[jj][p][r]), "v"(sc[jj][p][r + 1]), "v"(big2), "v"(add2)); }
            }
            c2 += c3;
            const unsigned c = (unsigned)(c2.x + c2.y);
            unsigned tot; TK_REDUCE(c, tot);
            if (tot >= (unsigned)KSEL) { prefix = cand; ge = tot; }
            if (__all(ge == (unsigned)KSEL)) break;
        }
        T = prefix;
#pragma unroll
        for (int jj = 0; jj < 4; ++jj) if (w + 8 * jj < nt) {
#pragma unroll
            for (int p = 0; p < 2; ++p)
#pragma unroll
                for (int r = 0; r < 8; ++r) { f32x2 v = sc[jj][p][r]; v.x = __uint_as_float(fkey(v.x)); v.y = __uint_as_float(fkey(v.y)); sc[jj][p][r] = v; }
        }
#define TK_KEY(jj, p, r) __float_as_uint(sc[jj][p][(r) >> 1][(r) & 1])
        if (ge != (unsigned)KSEL) flag[0] = 1u;
        __syncthreads();
        const bool tie = flag[0] != 0u;
        if (tie) {
            unsigned c = 0u;
#pragma unroll
            for (int jj = 0; jj < 4; ++jj) if (w + 8 * jj < nt) {
#pragma unroll
                for (int p = 0; p < 2; ++p)
#pragma unroll
                    for (int r = 0; r < 16; ++r) c += (TK_KEY(jj, p, r) == T) ? 1u : 0u;
            }
            unsigned ceq; TK_REDUCE(c, ceq);
            const unsigned need = (unsigned)KSEL - (ge - ceq);
            unsigned px = 0u;
            for (int bit = 10; bit >= 0; --bit) {
                const unsigned cand = px | (1u << bit);
                unsigned c2 = 0u;
#pragma unroll
                for (int jj = 0; jj < 4; ++jj) if (w + 8 * jj < nt) {
#pragma unroll
                    for (int p = 0; p < 2; ++p)
#pragma unroll
                        for (int r = 0; r < 16; ++r) { const unsigned kpos = (unsigned)(64 * (w + 8 * jj) + 32 * p + crow0(r) + 4 * hi); c2 += (TK_KEY(jj, p, r) == T && kpos < cand) ? 1u : 0u; }
                }
                unsigned tot; TK_REDUCE(c2, tot);
                if (tot < need) px = cand;
            }
            X = px;
        }
#undef TK_REDUCE
    }
#pragma unroll
    for (int jj = 0; jj < 4; ++jj) {
        const int tile = w + 8 * jj;
        if (tile < ntb) {
            unsigned w0 = 0u, w1 = 0u;
            if (tile < nt) {
#pragma unroll
                for (int r = 0; r < 16; ++r) {
                    const int kpos = 64 * tile + crow0(r) + 4 * hi;
                    bool s0, s1;
                    if (dotopk) { const unsigned k0 = TK_KEY(jj, 0, r), k1 = TK_KEY(jj, 1, r);
                        s0 = (k0 > T) || (k0 == T && (unsigned)kpos <= X); s1 = (k1 > T) || (k1 == T && (unsigned)(kpos + 32) <= X); }
                    else { s0 = kpos <= q; s1 = kpos + 32 <= q; }
                    w0 |= (s0 ? 1u : 0u) << crow0(r); w1 |= (s1 ? 1u : 0u) << crow0(r);
                }
                w0 <<= 4 * hi; w1 <<= 4 * hi;
                w0 = half_or(w0); w1 = half_or(w1);
            }
            if (hi == 0) *(uint2*)(MASK + (((size_t)(b * 64 + g) * 32 + tile) * 64 + r32 * 2)) = make_uint2(w0, w1);
        }
    }
    __syncthreads();
}
#undef TK_LAS
#undef TK_KEY
}
constexpr int NB = 32, SEQ = 2048, DMODEL = 1024, M = NB * SEQ;
constexpr int NIN = 5632;
constexpr int DIN = 5444;
constexpr int FF = 2816, NF1 = 2 * FF;
constexpr int NLAYER = 2, NPHASE = 1 + 8 * NLAYER;
constexpr float LAM_INIT0 = 0.2f, LAM_INIT1 = 0.35550906759096934f;
#ifndef MK_PER_PHASE
#define MK_PER_PHASE 0
#endif

constexpr size_t MiB = 1u << 20;
constexpr size_t WS_CTL = 0, CTL_ZERO_BYTES = 64 * 1024;
constexpr size_t WS_W = 2 * MiB, W_LAYER = 32 * MiB;
constexpr size_t OFF_IN = 0, OFF_UA = 11 * MiB, OFF_UB = 12 * MiB, OFF_O = 13 * MiB, OFF_F1 = 15 * MiB, OFF_F2 = 26 * MiB;
constexpr size_t WS_SS = 66 * MiB;
constexpr size_t WS_ROPE = 74 * MiB;
constexpr size_t WS_MASK = 90 * MiB, MASK_LAYER = 16 * MiB;
constexpr size_t WS_IW = 122 * MiB, WS_IK = 124 * MiB, WS_IQ = 132 * MiB;
constexpr size_t WS_XB = 164 * MiB;
constexpr size_t WS_AQ = 292 * MiB, WS_AK = 356 * MiB, WS_AV = 420 * MiB, WS_BQ = 484 * MiB, WS_BK = 548 * MiB, WS_BV = 612 * MiB, WS_G = 676 * MiB, WS_END = 932 * MiB;
constexpr size_t WS_YA = WS_AQ, WS_YB = WS_BQ, WS_TMP = WS_AK, WS_MRG = WS_BK, WS_ACT = WS_AQ;
static_assert(WS_ACT + (size_t)M * FF * 2 <= WS_G, "ACT overlay must stay clear of the gates");

constexpr int NWAVES = 8;
constexpr int RING_BYTES = 131072, LDSCTL_OFF = RING_BYTES, MISC_OFF = LDSCTL_OFF + 320, LDS_BYTES = 147456;
constexpr int CW_BAR = 4096;
constexpr int SCL_OFF = 131072 + 1024 + 256;

struct TrItem { const float* W; const float* gain; bf16* WT; int Nsrc, k0, c0, nv, K, p0; };
__device__ __forceinline__ void tr_load(const TrItem& t, f32x4 (&v)[8], float (&gk)[8], int lane) {
    const int c4 = lane & 7, r8 = lane >> 3; const bool ok = 4 * c4 < t.nv;
#pragma unroll
    for (int i = 0; i < 8; ++i) { const int kk = 8 * i + r8; v[i] = (f32x4){0.f, 0.f, 0.f, 0.f};
        if (ok) v[i] = *(const GAS f32x4*)(t.W + (size_t)(t.k0 + kk) * t.Nsrc + t.c0 + 4 * c4);
        gk[i] = t.gain ? t.gain[t.k0 + kk] : 1.0f; }
}
__device__ __forceinline__ void tr_store(const TrItem& t, const f32x4 (&v)[8], const float (&gk)[8], LAS float* scr, int lane) {
    const int c4 = lane & 7, r8 = lane >> 3;
#pragma unroll
    for (int i = 0; i < 8; ++i) { const int kk = 8 * i + r8; LAS float* s_ = scr + kk * 33 + 4 * c4; s_[0] = v[i].x * gk[i]; s_[1] = v[i].y * gk[i]; s_[2] = v[i].z * gk[i]; s_[3] = v[i].w * gk[i]; }
    LDS_WAIT(); asm volatile("" ::: "memory");
    const int c = lane & 7;
#pragma unroll
    for (int jj = 0; jj < 4; ++jj) { const int n = (lane >> 3) + 8 * jj; const LAS float* s = scr + (8 * c) * 33 + n;
        v4u o; o.x = pk2(s[0 * 33], s[1 * 33]); o.y = pk2(s[2 * 33], s[3 * 33]); o.z = pk2(s[4 * 33], s[5 * 33]); o.w = pk2(s[6 * 33], s[7 * 33]);
        *(GAS v4u*)(t.WT + (size_t)(t.p0 + n) * t.K + t.k0 + 8 * c) = o; }
    LDS_WAIT(); asm volatile("" ::: "memory");
}
__device__ __forceinline__ void src_in(int tile, int s, int bj, int& c0, int& nv) {
    const int d0 = 32 * bj; nv = 32;
    if (tile < 2) c0 = (tile * 4 + s) * 64 + d0;
    else if (tile < 4) c0 = 512 + ((tile - 2) * 4 + s) * 64 + d0;
    else if (tile < 6) c0 = 1024 + ((tile - 4) * 4 + s) * 64 + d0;
    else if (tile == 6) c0 = 1536 + s * 64 + d0;
    else if (tile == 7) { if (s == 0) c0 = 1792 + d0; else if (s == 1 && bj == 0) { c0 = 1856; nv = 4; } else { c0 = 0; nv = 0; } }
    else if (tile < 10) c0 = 1860 + ((tile - 8) * 4 + s) * 64 + d0;
    else if (tile < 12) c0 = 2372 + ((tile - 10) * 4 + s) * 64 + d0;
    else if (tile < 14) c0 = 2884 + ((tile - 12) * 4 + s) * 64 + d0;
    else c0 = 3396 + ((tile - 14) * 4 + s) * 64 + d0;
}
__device__ __forceinline__ float wave_sum(float v) {
    v += __int_as_float(__builtin_amdgcn_ds_swizzle(__float_as_int(v), 0x041F)); v += __int_as_float(__builtin_amdgcn_ds_swizzle(__float_as_int(v), 0x081F));
    v += __int_as_float(__builtin_amdgcn_ds_swizzle(__float_as_int(v), 0x101F)); v += __int_as_float(__builtin_amdgcn_ds_swizzle(__float_as_int(v), 0x201F));
    v += __int_as_float(__builtin_amdgcn_ds_swizzle(__float_as_int(v), 0x401F)); return epi::sum_halves(v);
}
__device__ __forceinline__ int lane_id_asm() { int l; asm volatile("v_mbcnt_lo_u32_b32 %0, -1, 0\n\tv_mbcnt_hi_u32_b32 %0, -1, %0" : "=v"(l)); return l; }
__constant__ double INV_FREQ[32] = {1.0, 0.7498942093324559, 0.5623413251903491, 0.4216965034285822, 0.31622776601683794, 0.23713737056616552, 0.1778279410038923, 0.1333521432163324, 0.1, 0.07498942093324558,
    0.05623413251903491, 0.042169650342858224, 0.03162277660168379, 0.023713737056616554, 0.01778279410038923, 0.01333521432163324, 0.01, 0.007498942093324558, 0.005623413251903491, 0.004216965034285823,
    0.0031622776601683794, 0.0023713737056616554, 0.0017782794100389228, 0.001333521432163324, 0.001, 0.0007498942093324559, 0.0005623413251903491, 0.00042169650342858224, 0.00031622776601683794,
    0.00023713737056616554, 0.00017782794100389227, 0.0001333521432163324};
__device__ __forceinline__ void sincos_d(double x, float& c, float& s) {
    const double n = __builtin_rint(x * 0.15915494309189535);
    double r = __builtin_fma(-n, 6.283185307179586, x); r = __builtin_fma(-n, 2.4492935982947064e-16, r);
    const double r2 = r * r;
    double ts = r, ss = r, tc = 1.0, cc = 1.0;
#pragma unroll
    for (int k = 1; k <= 14; ++k) { ts *= r2 * (-1.0 / (double)((2 * k) * (2 * k + 1))); ss += ts; tc *= r2 * (-1.0 / (double)((2 * k - 1) * (2 * k))); cc += tc; }
    c = (float)cc; s = (float)ss;
}

struct Args { const float* in[18]; float* out; unsigned char* ws; int ph_lo, ph_hi; };

__device__ __forceinline__ void p0_prologue(unsigned char* ws, LAS unsigned char* ldsb, int vcu, int G, int wave, int lane) {
    LAS float* scr = (LAS float*)(ldsb + wave * 16384);
    const int gw = vcu * NWAVES + wave, NGW = G * NWAVES;
    constexpr int I_IN = 16 * 176, I_U = 8 * 32, I_O = 16 * 32, I_F1 = 16 * 176, I_F2 = 44 * 32, I_L = I_IN + 2 * I_U + I_O + I_F1 + I_F2;
    for (int ph_ = 0; ph_ < 2; ++ph_) {
    if (((ph_ ^ (wave >> 2)) & 1) == 0) {
    auto decode = [&](int it, TrItem& t) {
        const int l = it / I_L; int r = it - l * I_L;
        unsigned char* wl = ws + WS_W + (size_t)l * W_LAYER;
        if (r < I_IN) { const int kb = r / 176, pb = r - kb * 176, tile = pb >> 3, wb = pb & 7; int c0, nv; src_in(tile, wb & 3, wb >> 2, c0, nv);
            t = TrItem{epi::lds_inptr(ldsb, 3) + (size_t)l * DMODEL * DIN, epi::lds_inptr(ldsb, 2) + l * DMODEL, (bf16*)(wl + OFF_IN), DIN, 64 * kb, c0, nv, DMODEL, 32 * pb}; return; }
        r -= I_IN;
        if (r < I_U) { const int kb = r >> 5, nb = r & 31; t = TrItem{epi::lds_inptr(ldsb, 12) + (size_t)l * 512 * 1024, nullptr, (bf16*)(wl + OFF_UA), 1024, 64 * kb, 32 * nb, 32, 512, 32 * nb}; return; }
        r -= I_U;
        if (r < I_U) { const int kb = r >> 5, nb = r & 31; t = TrItem{epi::lds_inptr(ldsb, 13) + (size_t)l * 512 * 1024, nullptr, (bf16*)(wl + OFF_UB), 1024, 64 * kb, 32 * nb, 32, 512, 32 * nb}; return; }
        r -= I_U;
        if (r < I_O) { const int kb = r >> 5, nb = r & 31; t = TrItem{epi::lds_inptr(ldsb, 14) + (size_t)l * 1024 * 1024, nullptr, (bf16*)(wl + OFF_O), 1024, 64 * kb, 32 * nb, 32, 1024, 32 * nb}; return; }
        r -= I_O;
        if (r < I_F1) { const int kb = r / 176, pb = r - kb * 176, tile = pb >> 3, wb = pb & 7; const int c0 = 128 * tile + 32 * (wb & 3) + ((wb >> 2) ? FF : 0);
            t = TrItem{epi::lds_inptr(ldsb, 16) + (size_t)l * DMODEL * NF1, epi::lds_inptr(ldsb, 15) + l * DMODEL, (bf16*)(wl + OFF_F1), NF1, 64 * kb, c0, 32, DMODEL, 32 * pb}; return; }
        r -= I_F1;
        { const int kb = r >> 5, nb = r & 31; t = TrItem{epi::lds_inptr(ldsb, 17) + (size_t)l * FF * 1024, nullptr, (bf16*)(wl + OFF_F2), 1024, 64 * kb, 32 * nb, 32, FF, 32 * nb}; }
    };
    { TrItem cur, nxt; f32x4 va[8], vb[8]; float ga[8], gb[8];
      int it = gw; if (it < NLAYER * I_L) { decode(it, cur); tr_load(cur, va, ga, lane); }
      for (; it < NLAYER * I_L; it += NGW) { const bool hn = it + NGW < NLAYER * I_L;
          if (hn) { decode(it + NGW, nxt); tr_load(nxt, vb, gb, lane); }
          tr_store(cur, va, ga, scr, lane);
          if (hn) { cur = nxt;
#pragma unroll
              for (int i = 0; i < 8; ++i) { va[i] = vb[i]; ga[i] = gb[i]; } } } }
#if defined(DBG_FILL)
    { unsigned* fp = (unsigned*)(ws + DBG_FILL); for (size_t i = (size_t)gw * 64 + lane; i < (size_t)32 * MiB; i += (size_t)NGW * 64) fp[i] = 0x3f803f80u + ((unsigned)i & 0x3fu) * 0x00010001u; }
#endif
    } else {
    const float* x = epi::lds_inptr(ldsb, 0); const int* pos = (const int*)epi::lds_inptr(ldsb, 1);
    bf16* XB = (bf16*)(ws + WS_XB); float* SS0 = (float*)(ws + WS_SS); float* ROPE = (float*)(ws + WS_ROPE);
    for (int m0 = gw; m0 < M; m0 += 4 * NGW) {
        f32x4 v[4][4]; float s[4];
#pragma unroll
        for (int u = 0; u < 4; ++u) { const int m = m0 + u * NGW; const GAS f32x4* xr = (const GAS f32x4*)(x + (size_t)(m < M ? m : gw) * DMODEL) + lane;
#pragma unroll
            for (int j = 0; j < 4; ++j) v[u][j] = xr[64 * j]; }
#pragma unroll
        for (int u = 0; u < 4; ++u) { float t = 0.f;
#pragma unroll
            for (int j = 0; j < 4; ++j) t += (v[u][j].x * v[u][j].x + v[u][j].y * v[u][j].y) + (v[u][j].z * v[u][j].z + v[u][j].w * v[u][j].w);
            s[u] = wave_sum(t); }
#pragma unroll
        for (int u = 0; u < 4; ++u) { const int m = m0 + u * NGW; if (m < M) {
            GAS unsigned long long* o8 = (GAS unsigned long long*)(XB + (size_t)m * DMODEL) + lane;
#pragma unroll
            for (int j = 0; j < 4; ++j) o8[64 * j] = (unsigned long long)pk2(v[u][j].x, v[u][j].y) | ((unsigned long long)pk2(v[u][j].z, v[u][j].w) << 32);
            if (lane < 16) SS0[(size_t)m * 16 + lane] = (lane == 0) ? s[u] : 0.f; } }
    }
    { const int fi = lane & 31; int m = gw + (lane >> 5) * NGW; int pn_ = (m < M) ? pos[m] : 0;
      for (; m - (lane >> 5) * NGW < M; m += 2 * NGW) { const int pc = pn_; const int mn = m + 2 * NGW; if (mn < M) pn_ = pos[mn];
        if (m < M) { const double ang = (double)pc * INV_FREQ[fi]; float c, sn; sincos_d(ang, c, sn); const epi::h16x2 hh = {(_Float16)c, (_Float16)sn}; ((unsigned*)ROPE)[(size_t)m * 32 + fi] = __builtin_bit_cast(unsigned, hh); } } }
    }
    }
}
static_assert(epi::EI_SS == WS_SS && epi::EI_ROPE == WS_ROPE && epi::EI_IW == WS_IW && epi::EI_IK == WS_IK && epi::EI_IQ == WS_IQ && epi::EI_AQ == WS_AQ && epi::EI_AK == WS_AK && epi::EI_AV == WS_AV && epi::EI_BQ == WS_BQ && epi::EI_BK == WS_BK && epi::EI_BV == WS_BV && epi::EI_G == WS_G && epi::PTR_OFF >= MISC_OFF + 128 && epi::PTR_OFF + 18 * 8 <= SCL_OFF && SCL_OFF + 64 <= epi::RSTD_OFF && epi::RSTD_OFF + 64 + epi::RSTD_SLOTS * 1024 <= LDS_BYTES, "EpiIn offsets vs the d_ws / LDS map");
#define VNATB(b_, h_) ((long)((b_) * 4 + (h_)) * (2048 * 128) - (long)(b_) * 2048 * 512)
#define KNAT(b_, hs_) ((long)((b_) * 8 + (hs_)) * (2048 * 64) - (long)(b_) * 2048 * 512)
__global__ void __launch_bounds__(NWAVES * 64, 2) mega_fwd(Args args) {
    extern __shared__ __attribute__((aligned(16))) unsigned char lds[];
    LAS unsigned char* ldsb = (LAS unsigned char*)lds;
    volatile LAS unsigned* MISC = (volatile LAS unsigned*)(ldsb + MISC_OFF);
    const int tid = threadIdx.x; int wave_ = __builtin_amdgcn_readfirstlane(tid >> 6); asm volatile("" : "+s"(wave_)); const int wave = wave_;
    const int G = gridDim.x; const int bx = blockIdx.x;
    const int vcu = (G % 8 == 0) ? (bx % 8) * (G / 8) + bx / 8 : bx;
    unsigned char* ws = args.ws;
    gu32* ctl = (gu32*)(ws + WS_CTL);
    for (int u = tid; u < (LDS_BYTES - LDSCTL_OFF) / 4; u += NWAVES * 64) ((LAS unsigned*)(ldsb + LDSCTL_OFF))[u] = 0u;
    __syncthreads();
    if (!MK_PER_PHASE) (void)xcd_barrier_post((unsigned*)(ctl + CW_BAR), MISC + 8);
#define GRID_BAR() do { if (!MK_PER_PHASE) { XcdBarrier b_; b_.bar = (unsigned*)(SCLP(0) + WS_CTL + (size_t)CW_BAR * 4); b_.x = xb_xcc_id(); b_.st = MISC + 8; xcd_barrier(b_, wave == 0 && lane_id_asm() == 0); } } while (0)
    if (tid == 0) { LAS unsigned* sw = (LAS unsigned*)(ldsb + SCL_OFF); const unsigned long long pw = (unsigned long long)args.ws, po = (unsigned long long)args.out;
        sw[0] = (unsigned)pw; sw[1] = (unsigned)(pw >> 32); sw[2] = (unsigned)po; sw[3] = (unsigned)(po >> 32); sw[4] = (unsigned)G; sw[5] = (unsigned)bx; sw[6] = (unsigned)vcu; sw[7] = (unsigned)args.ph_lo; sw[8] = (unsigned)args.ph_hi; }
#define SCL(i) ((int)__builtin_amdgcn_readfirstlane(((const LAS unsigned*)(ldsb + SCL_OFF))[i]))
#define SCLP(i) ((unsigned char*)(GAS unsigned char*)(((unsigned long long)(unsigned)SCL((i) + 1) << 32) | (unsigned)SCL(i)))
#ifndef PH_EN
#define PH_EN 0x1ff
#endif
#define PHT(k) ((k) == 0 ? 0 : (((k) - 1) & 7) + 1)
#define IN(k) (((PH_EN >> PHT(k)) & 1) && SCL(7) <= (k) && (k) < SCL(8))
#define BOTH(k) (IN(k) && IN((k) + 1))
#ifndef DBG_REP
#define DBG_REP 0
#endif
#define NREP(t) (((DBG_REP >> (t)) & 1) ? 2 : 1)

    if (tid < 18) { const unsigned long long p = (unsigned long long)args.in[tid]; ((LAS unsigned*)(ldsb + epi::PTR_OFF))[2 * tid] = (unsigned)p; ((LAS unsigned*)(ldsb + epi::PTR_OFF))[2 * tid + 1] = (unsigned)(p >> 32); }
    __syncthreads();
#define INP(i) epi::lds_inptr(ldsb, (i))
#define WSL() unsigned char* wsl = SCLP(0); float* const outp = (float*)SCLP(2); const int Gp = SCL(4), bxp = SCL(5), vcup = SCL(6); const int wavep = wave; (void)outp; (void)Gp; (void)bxp; (void)vcup

    if (IN(0)) { for (int rep_ = 0; rep_ < NREP(0); ++rep_) { int l_ = lane_id_asm(); p0_prologue(SCLP(0), ldsb, SCL(6), SCL(4), wave, l_); } if (BOTH(0)) GRID_BAR(); }

#pragma unroll
    for (int l = 0; l < NLAYER; ++l) {
        const int pb = 1 + 8 * l;
        if (IN(pb + 0)) {
for (int rep_ = 0; rep_ < NREP(1); ++rep_) {
            WSL();
            pg8::Gemm g{(const bf16*)(wsl + WS_XB), (const bf16*)(wsl + WS_W + (size_t)l * W_LAYER + OFF_IN), M, NIN, DMODEL}; pg8::StaticOrder S; S.init(M, NIN, Gp, bxp);
            epi::rstd_prepass(ldsb, S, (const float*)(wsl + WS_SS), wavep * 64 + lane_id_asm());
            epi::EpiIn E{wsl, ldsb, l};
            pg8::gemm_phase<epi::EpiIn, pg8::StaticOrder, true, true>(ldsb, g, S, E, wavep);
}
            if (BOTH(pb + 0)) GRID_BAR();
        }
        if (IN(pb + 1)) {
{
            WSL();
            const bf16* IQ = (const bf16*)(wsl + WS_IQ); const bf16* IK = (const bf16*)(wsl + WS_IK); const float* IW = (const float*)(wsl + WS_IW); unsigned* MASK = (unsigned*)(wsl + WS_MASK + (size_t)l * MASK_LAYER);
            for (int i0 = 0;; ++i0) { const int i = (NREP(2) == 2) ? (i0 >> 1) : i0; const int L = i * Gp + vcup; if (L >= NB * 64) break;
                const int v = L & 255, ii = L >> 8, b = v >> 3, j = v & 7, g = 16 * (ii >> 1) + ((ii & 1) ? 15 - j : j);
                topk::unit(b, g, IQ, IK, IW, MASK, ldsb, wavep); }
}
            if (BOTH(pb + 1)) GRID_BAR();
        }
        if (IN(pb + 2)) {
#if !defined(NO_A)
            { WSL();
              const attn_body::bf16 *AQ = (const attn_body::bf16*)(wsl + WS_AQ), *AK = (const attn_body::bf16*)(wsl + WS_AK), *AV = (const attn_body::bf16*)(wsl + WS_AV); attn_body::bf16* YA = (attn_body::bf16*)(wsl + WS_YA);
              const unsigned* MASK = (const unsigned*)(wsl + WS_MASK + (size_t)l * MASK_LAYER);
              for (int i = 0;; ++i) { const int L = i * Gp + vcup; if (L >= NB * 64) break;
                const int v = L & 255, he = L >> 8, b = v >> 3, qb = ((v & 7) + he) & 7;
#if defined(DBG_PROBEA)
                attn_body::attn_unit<8, true, false>(b, qb, AQ + he * 64, AK + he * 64, AV + he * 64, (attn_body::bf16*)outp + he * 64, MASK, (char*)lds, wavep);
#endif
                attn_body::attn_unit<8, true, false>(b, qb, AQ + he * 64, AK + KNAT(b, he), AV + KNAT(b, he), YA + he * 64, MASK, (char*)lds, wavep); } }
#endif
#if !defined(NO_B)
for (int rep_ = 0; rep_ < NREP(3); ++rep_) {
            { WSL();
              const attn_body::bf16 *BQ = (const attn_body::bf16*)(wsl + WS_BQ), *BK = (const attn_body::bf16*)(wsl + WS_BK), *BV = (const attn_body::bf16*)(wsl + WS_BV); attn_body::bf16* OB = (attn_body::bf16*)outp;
              const float* dl = INP(10) + l * 256; const float lam_init = (l == 0) ? LAM_INIT0 : LAM_INIT1; const int ln_ = lane_id_asm();
              const float lam = expf(wave_sum(dl[ln_] * dl[64 + ln_])) - expf(wave_sum(dl[128 + ln_] * dl[192 + ln_])) + lam_init;
              const float* sub = INP(11) + l * 128; attn_body::bf16* YBp = (attn_body::bf16*)(wsl + WS_YB);
              for (int i = 0;; ++i) { const int L = i * Gp + vcup; if (L >= NB * 64) break;
                const int v = L & 255, e = L >> 8, b = v >> 3, h = e >> 1, c = e & 1, qb = (h & 1) ? 7 - (v & 7) : (v & 7);
                if (c == 0) attn_body::attn_unit<8, false, true>(b, qb, BQ + (2 * h) * 64, BK + KNAT(b, 2 * h), BV + VNATB(b, h), OB + h * 128, nullptr, (char*)lds, wavep);
                else        attn_body::attn_unit<8, false, true>(b, qb, BQ + (2 * h + 1) * 64, BK + KNAT(b, 2 * h + 1), BV + VNATB(b, h), YBp + h * 128, nullptr, (char*)lds, wavep, true, OB + h * 128, sub, lam, 1.0f - lam_init); } }
}
#endif
            if (BOTH(pb + 2)) GRID_BAR();
        }
        if (IN(pb + 4)) {
for (int rep_ = 0; rep_ < NREP(5); ++rep_) {
            { WSL(); pg8::Gemm g{(const bf16*)(wsl + WS_YA), (const bf16*)(wsl + WS_W + (size_t)l * W_LAYER + OFF_UA), M, 2 * DMODEL, 512, (const bf16*)(wsl + WS_YB), 4}; pg8::PairOrder S; S.init(M, DMODEL, Gp, bxp);
              epi::EpiGateFused E{(const unsigned char*)(wsl + WS_G), (bf16*)(wsl + WS_MRG)}; pg8::gemm_phase<epi::EpiGateFused, pg8::PairOrder, false, true>(ldsb, g, S, E, wavep); }
}
            if (BOTH(pb + 4)) GRID_BAR();
        }
        if (IN(pb + 5)) {
            WSL();
            pg8::Gemm g{(const bf16*)(wsl + WS_MRG), (const bf16*)(wsl + WS_W + (size_t)l * W_LAYER + OFF_O), M, DMODEL, DMODEL}; pg8::StaticOrder S; S.init(M, DMODEL, Gp, bxp);
#if defined(DBG_PROBE6)
            { epi::EpiProbe<0> E0{nullptr}; pg8::gemm_phase<epi::EpiProbe<0>, pg8::StaticOrder, true, true>(ldsb, g, S, E0, wavep); }
#endif
#if defined(DBG_PROBE6E)
            { epi::EpiRes E0{(bf16*)(wsl + WS_XB), (float*)(wsl + WS_G + 128 * MiB), nullptr, (bf16*)(wsl + WS_G)}; pg8::gemm_phase<epi::EpiRes, pg8::StaticOrder, true, true>(ldsb, g, S, E0, wavep); }
#endif
            epi::EpiRes E{(bf16*)(wsl + WS_XB), (float*)(wsl + WS_SS + 4 * MiB), nullptr, (bf16*)(wsl + WS_XB)};
            pg8::gemm_phase<epi::EpiRes, pg8::StaticOrder, true, true>(ldsb, g, S, E, wavep);
            if (BOTH(pb + 5)) GRID_BAR();
        }
        if (IN(pb + 6)) {
for (int rep_ = 0; rep_ < NREP(7); ++rep_) {
            WSL();
            pg8::Gemm g{(const bf16*)(wsl + WS_XB), (const bf16*)(wsl + WS_W + (size_t)l * W_LAYER + OFF_F1), M, NF1, DMODEL}; pg8::StaticOrder S; S.init(M, NF1, Gp, bxp);
#if defined(DBG_PROBE7)
            if (rep_ == 0) { epi::EpiProbe<DBG_PROBE7> E0{(bf16*)(wsl + WS_ACT)}; pg8::gemm_phase<epi::EpiProbe<DBG_PROBE7>, pg8::StaticOrder, true, true>(ldsb, g, S, E0, wavep); continue; }
#endif
            epi::rstd_prepass(ldsb, S, (const float*)(wsl + WS_SS + 4 * MiB), wavep * 64 + lane_id_asm());
            epi::EpiSwiglu E{ldsb, (bf16*)(wsl + WS_ACT)};
            pg8::gemm_phase<epi::EpiSwiglu, pg8::StaticOrder, true, true>(ldsb, g, S, E, wavep);
}
            if (BOTH(pb + 6)) GRID_BAR();
        }
        if (IN(pb + 7)) {
            WSL();
            pg8::Gemm g{(const bf16*)(wsl + WS_ACT), (const bf16*)(wsl + WS_W + (size_t)l * W_LAYER + OFF_F2), M, DMODEL, FF}; pg8::StaticOrder S; S.init(M, DMODEL, Gp, bxp);
#if defined(DBG_PROBE8)
            { epi::EpiProbe<0> E0{nullptr}; pg8::gemm_phase<epi::EpiProbe<0>, pg8::StaticOrder, true, true>(ldsb, g, S, E0, wavep); }
#endif
#if defined(DBG_PROBE8E)
            { epi::EpiRes E0{(bf16*)(wsl + WS_XB), (float*)(wsl + WS_G + 128 * MiB), nullptr, (bf16*)(wsl + WS_G)}; pg8::gemm_phase<epi::EpiRes, pg8::StaticOrder, true, true>(ldsb, g, S, E0, wavep); }
#endif
            epi::EpiRes E{(bf16*)(wsl + WS_XB), (float*)(wsl + WS_SS), (l == NLAYER - 1) ? outp : nullptr, (bf16*)(wsl + WS_XB)};
            pg8::gemm_phase<epi::EpiRes, pg8::StaticOrder, true, true>(ldsb, g, S, E, wavep);
            if (BOTH(pb + 7)) GRID_BAR();
        }
    }
#undef INP
#undef WSL
#undef IN
#undef BOTH
#undef GRID_BAR
}


#if defined(DBG_STOP)
struct DumpArgs { const unsigned short* p[16]; unsigned long long n[16]; float* out; int nb; int pad; };
__global__ void dbg_dump(DumpArgs d) {
    const size_t i0 = (size_t)blockIdx.x * blockDim.x + threadIdx.x, stride = (size_t)gridDim.x * blockDim.x;
    for (size_t i = i0; i < (size_t)M * DMODEL; i += stride) { float s = 0.f;
        for (int b = 0; b < d.nb; ++b) { const unsigned short w = d.p[b][i % d.n[b]]; float f = __uint_as_float((unsigned)w << 16); if (!(f == f) || fabsf(f) > 1e30f) f = 12345.f; s += f; }
        d.out[i] = s; }
}
#endif
extern "C" void kernel_launch(void* const* d_in, const int* in_sizes, int n_in, void* d_out, int out_size, void* d_ws, size_t ws_size, hipStream_t stream) {
    static int grid = 0;
    if (grid == 0) {
        if (n_in != 18 || in_sizes[0] != M * DMODEL || out_size != M * DMODEL || ws_size < WS_END) { fprintf(stderr, "kernel_launch: unexpected shapes (n_in %d, in0 %d, out %d, ws %zu)\n", n_in, n_in > 0 ? in_sizes[0] : -1, out_size, ws_size); grid = -1; return; }
        int dev = 0, cus = 0, per_cu = 0;
        if (hipGetDevice(&dev) != hipSuccess || hipDeviceGetAttribute(&cus, hipDeviceAttributeMultiprocessorCount, dev) != hipSuccess) { grid = -1; return; }
        if (hipFuncSetAttribute((const void*)mega_fwd, hipFuncAttributeMaxDynamicSharedMemorySize, LDS_BYTES) != hipSuccess) { fprintf(stderr, "kernel_launch: hipFuncSetAttribute failed\n"); grid = -1; return; }
        if (hipOccupancyMaxActiveBlocksPerMultiprocessor(&per_cu, (const void*)mega_fwd, NWAVES * 64, LDS_BYTES) != hipSuccess || per_cu < 1) fprintf(stderr, "kernel_launch: occupancy query reports %d\n", per_cu);
        (void)hipGetLastError();
        grid = cus;
    }
    if (grid < 0) return;
    if (hipMemsetAsync((char*)d_ws + WS_CTL, 0, CTL_ZERO_BYTES, stream) != hipSuccess) return;
    Args a{};
    for (int i = 0; i < 18; ++i) a.in[i] = (const float*)d_in[i];
    a.out = (float*)d_out; a.ws = (unsigned char*)d_ws;
#if defined(DBG_STOP)
    for (int p = 0; p < DBG_STOP; ++p) { a.ph_lo = p; a.ph_hi = p + 1; hipLaunchKernelGGL(mega_fwd, dim3(grid), dim3(NWAVES * 64), LDS_BYTES, stream, a); }
    { DumpArgs d{}; unsigned char* w = (unsigned char*)d_ws; int n = 0;
      const size_t offs[] = {DBG_BUFS}; const size_t lens[] = {DBG_LENS};
      for (size_t q = 0; q < sizeof(offs) / sizeof(offs[0]); ++q) { d.p[n] = (const unsigned short*)(w + offs[q]); d.n[n] = lens[q] / 2; ++n; }
      d.out = (float*)d_out; d.nb = n; hipLaunchKernelGGL(dbg_dump, dim3(2048), dim3(256), 0, stream, d); }
#elif MK_PER_PHASE
    for (int p = 0; p < NPHASE; ++p) { a.ph_lo = p; a.ph_hi = p + 1; hipLaunchKernelGGL(mega_fwd, dim3(grid), dim3(NWAVES * 64), LDS_BYTES, stream, a); }
#else
    a.ph_lo = 0; a.ph_hi = NPHASE;
    hipLaunchKernelGGL(mega_fwd, dim3(grid), dim3(NWAVES * 64), LDS_BYTES, stream, a);
#endif
    const hipError_t le = hipPeekAtLastError();
    if (le != hipSuccess) fprintf(stderr, "kernel_launch: launch failed: %s\n", hipGetErrorName(le));
}
```

```cpp
#include <hip/hip_runtime.h>
#include <cstdio>
#include <cstdint>
namespace pg8 {
#define PG8_LAS __attribute__((address_space(3)))
typedef unsigned short bf16_t;
typedef short bf16x8 __attribute__((ext_vector_type(8)));
typedef float f32x4 __attribute__((ext_vector_type(4)));
typedef unsigned u32x4 __attribute__((ext_vector_type(4)));
constexpr int BM = 256, BK = 64, HALF = 128, HTB = HALF * BK * 2  , STAGE_BYTES = 8 * HTB, NXCD = 8, WGM = 8;

__host__ __device__ __forceinline__ int lds_byte(int r, int c) { const int st = (r >> 4) * 2 + (c >> 5), rr = r & 15, cc = c & 31, ob = rr * 64 + cc * 2; return st * 1024 + (ob ^ (((ob >> 9) & 1) << 5)); }
__host__ __device__ __forceinline__ void stage_rc(int b, int& R, int& C) { const int st = b / 1024, sb = b % 1024, swz = sb ^ (((sb >> 9) & 1) << 5); R = (st >> 1) * 16 + swz / 64; C = (st & 1) * 32 + (swz % 64) / 2; }
__host__ __device__ __forceinline__ int perm32(int rho) { const int n = rho >> 4, i = rho & 15; return 8 * (i >> 2) + 4 * n + (i & 3); }

struct Unit { int pm, pn; };
struct Gemm { const bf16_t* A; const bf16_t* Bt; int M, N, K; const bf16_t* A2 = nullptr; int nsplit = 1 << 30; };

struct StaticOrder {
    int nM, nN, nwg, G, c;
    __host__ __device__ void init(int M, int N, int G_, int c_) { nM = M / BM; nN = N / BM; nwg = nM * nN; G = G_; c = c_; }
    __host__ __device__ bool next(int i, Unit& u) const {
        const long L = (long)i * G + c; if (L >= nwg) return false;
        int wgid = (int)L; { const int q = nwg / NXCD, r = nwg % NXCD, xcd = wgid % NXCD, off = wgid / NXCD; wgid = (xcd < r ? xcd * (q + 1) : r * (q + 1) + (xcd - r) * q) + off; }
        const int nig = WGM * nN, gid = wgid / nig, fm = gid * WGM, gsz = (nM - fm) < WGM ? (nM - fm) : WGM;
        u.pm = fm + ((wgid % nig) % gsz); u.pn = (wgid % nig) / gsz; return true;
    }
    __device__ __forceinline__ void a_ready(const Unit&) const {}
    __device__ __forceinline__ void done(const Unit&) const {}
};

struct PairOrder {
    StaticOrder s;
    __host__ __device__ void init(int M, int N, int G_, int c_) { s.init(M, N, G_, c_); }
    __host__ __device__ bool next(int i, Unit& u) const { if (!s.next(i >> 1, u)) return false; u.pn += (i & 1) * s.nN; return true; }
    __device__ __forceinline__ void a_ready(const Unit&) const {}
    __device__ __forceinline__ void done(const Unit&) const {}
};

__device__ __forceinline__ unsigned cvt_pk_bf16(float lo, float hi) { unsigned r; asm volatile("v_cvt_pk_bf16_f32 %0, %1, %2" : "=v"(r) : "v"(lo), "v"(hi)); return r; }
typedef float f32x2 __attribute__((ext_vector_type(2)));
template <int N> __device__ __forceinline__ void pg8_wait_vm() { asm volatile("s_waitcnt vmcnt(%0)" :: "n"(N) : "memory"); }
__device__ __forceinline__ void pg8_wait_vm_relaxed(int rl) { if (rl >= 48) pg8_wait_vm<56>(); else if (rl >= 40) pg8_wait_vm<48>(); else if (rl >= 32) pg8_wait_vm<40>(); else if (rl >= 24) pg8_wait_vm<32>(); else if (rl >= 16) pg8_wait_vm<24>(); else pg8_wait_vm<8>(); }
__device__ __forceinline__ int pg8_lane_id() { int l; asm volatile("v_mbcnt_lo_u32_b32 %0, -1, 0\n\tv_mbcnt_hi_u32_b32 %0, -1, %0" : "=v"(l)); return l; }
template <class Epi, class Sched, bool ALIGN_EPI = false, bool SP2 = false>
__device__ __forceinline__ void gemm_phase(PG8_LAS unsigned char* lds, const Gemm g, const Sched& S, const Epi& E, const int wave_in  ) {
    int tid_ = wave_in * 64 + pg8_lane_id();
    const int tid = tid_, wid = __builtin_amdgcn_readfirstlane(tid >> 6), lane = tid & 63, wr = wid >> 2, wc = wid & 3, fr = lane & 15, fq = lane >> 4;
    const int K = g.K, nt = K / BK;
    unsigned voffA[2], voffB[2];
#pragma unroll
    for (int i = 0; i < 2; ++i) { int R, C; stage_rc(tid * 16 + i * 8192, R, C); const int Rb = Epi::PERM ? ((R & ~31) + perm32(R & 31)) : R;
        voffA[i] = (unsigned)(R * K + C) * 2u; voffB[i] = (unsigned)(Rb * K + C) * 2u; }
    const size_t kstep = (size_t)(BK * 2);
    const size_t hstep = (size_t)HALF * K * 2;
    const size_t tstep = 2 * hstep;
    const unsigned ldsw = (unsigned)wid * 1024u;
    const int aoff = lds_byte(wr * 64 + fr, fq * 8), boff = lds_byte(wc * 32 + fr, fq * 8);
#define PG8_SA(b, h) (((b) * 2 + (h)) * HTB)
#define PG8_SB(b, h) ((4 + (b) * 2 + (h)) * HTB)
#define PG8_STAGE(bufoff, gbase, voff) do { _Pragma("unroll") for (int _i = 0; _i < 2; ++_i) \
        __builtin_amdgcn_global_load_lds((const unsigned*)((const char*)(gbase) + (voff)[_i]), (PG8_LAS unsigned*)(lds + (bufoff) + ldsw + _i * 8192), 16, 0, 0); } while (0)
#define PG8_LDA(dst, b, h) do { _Pragma("unroll") for (int m = 0; m < 4; ++m) _Pragma("unroll") for (int k = 0; k < 2; ++k) dst[m][k] = *(const PG8_LAS bf16x8*)(lds + PG8_SA(b, h) + aoff + m * 2048 + k * 1024); } while (0)
#define PG8_LDB(dst, b, h) do { _Pragma("unroll") for (int n = 0; n < 2; ++n) _Pragma("unroll") for (int k = 0; k < 2; ++k) dst[n][k] = *(const PG8_LAS bf16x8*)(lds + PG8_SB(b, h) + boff + n * 2048 + k * 1024); } while (0)
#define PG8_MMA(ai, bj, At, Bt) do { __builtin_amdgcn_s_setprio(1); _Pragma("unroll") for (int m = 0; m < 4; ++m) _Pragma("unroll") for (int n = 0; n < 2; ++n) _Pragma("unroll") for (int k = 0; k < 2; ++k) \
        acc[ai][bj][m][n] = __builtin_amdgcn_mfma_f32_16x16x32_bf16(Bt[n][k], At[m][k], acc[ai][bj][m][n], 0, 0, 0); __builtin_amdgcn_s_setprio(0); } while (0)
#define PG8_WAIT_V(n) asm volatile("s_waitcnt vmcnt(" #n ")" ::: "memory")
#define PG8_WAIT_V_RLX(flag) asm volatile("s_cmp_eq_u32 %0, 0\n\ts_cbranch_scc1 1f\n\ts_waitcnt vmcnt(%1)\n\ts_branch 2f\n1:\n\ts_waitcnt vmcnt(8)\n2:" :: "s"(__builtin_amdgcn_readfirstlane(flag)), "n"(8 + Epi::VMEM_MIN) : "memory", "scc")
#define PG8_WAIT_L(n) asm volatile("s_waitcnt lgkmcnt(" #n ")" ::: "memory")
#define PG8_BAR __builtin_amdgcn_s_barrier()
#define PG8_SCHED __builtin_amdgcn_sched_barrier(0)
    Unit cur, nxt; int ui = 0;
    if (!S.next(0, cur)) return;
    f32x4 acc[2][2][4][2];
#pragma unroll
    for (int a = 0; a < 2; ++a)
#pragma unroll
        for (int b = 0; b < 2; ++b)
#pragma unroll
            for (int m = 0; m < 4; ++m)
#pragma unroll
                for (int n = 0; n < 2; ++n) acc[a][b][m][n] = (f32x4){0.f, 0.f, 0.f, 0.f};
    bf16x8 At[4][2], B0[2][2], B1[2][2];
    const char* cA = (const char*)(cur.pn >= g.nsplit ? g.A2 : g.A) + (size_t)cur.pm * tstep; const char* cB = (const char*)g.Bt + (size_t)cur.pn * tstep;
    S.a_ready(cur);
    if constexpr (SP2) {
        PG8_STAGE(PG8_SB(0, 0), cB, voffB); PG8_STAGE(PG8_SB(0, 1), cB + hstep, voffB); PG8_STAGE(PG8_SA(0, 0), cA, voffA); PG8_STAGE(PG8_SA(0, 1), cA + hstep, voffA);
        if (wr == 1) PG8_BAR;
        PG8_WAIT_V(2); PG8_BAR;
        PG8_STAGE(PG8_SB(1, 0), cB + kstep, voffB); PG8_STAGE(PG8_SA(1, 0), cA + kstep, voffA); PG8_STAGE(PG8_SB(1, 1), cB + hstep + kstep, voffB);
        PG8_WAIT_V(6); PG8_BAR;
    } else {
        PG8_STAGE(PG8_SB(0, 0), cB, voffB); PG8_STAGE(PG8_SA(0, 0), cA, voffA); PG8_STAGE(PG8_SB(0, 1), cB + hstep, voffB); PG8_STAGE(PG8_SA(0, 1), cA + hstep, voffA);
        if (wr == 1) PG8_BAR;
        PG8_WAIT_V(4); PG8_BAR;
        PG8_STAGE(PG8_SB(1, 0), cB + kstep, voffB); PG8_STAGE(PG8_SA(1, 0), cA + kstep, voffA); PG8_STAGE(PG8_SB(1, 1), cB + hstep + kstep, voffB);
        PG8_WAIT_V(6); PG8_BAR;
    }
    for (;;) {
        const bool has_next = S.next(ui + 1, nxt);
        const char* nA = has_next ? (const char*)(nxt.pn >= g.nsplit ? g.A2 : g.A) + (size_t)nxt.pm * tstep : cA; const char* nB = has_next ? (const char*)g.Bt + (size_t)nxt.pn * tstep : cB;
        for (int t = 0; t < nt; t += 2) {
            const bool last = (t == nt - 2);
            const char* a1 = cA + (size_t)(t + 1) * kstep;
            const char* a2 = last ? nA : cA + (size_t)(t + 2) * kstep; const char* b2 = last ? nB : cB + (size_t)(t + 2) * kstep;
            const char* a3 = a2 + kstep; const char* b3 = b2 + kstep;
            if (last && has_next) S.a_ready(nxt);
            if constexpr (SP2) {
            const int rlx = (t == 0 && ui > 0) ? 1 : 0;
            PG8_LDB(B0, 0, 0); PG8_LDB(B1, 0, 1); PG8_SCHED; PG8_LDA(At, 0, 0); PG8_STAGE(PG8_SA(1, 1), a1 + hstep, voffA);
            PG8_WAIT_V_RLX(rlx); PG8_WAIT_L(0); PG8_BAR; PG8_MMA(0, 0, At, B0); PG8_MMA(0, 1, At, B1); PG8_BAR; PG8_SCHED;
            PG8_LDA(At, 0, 1); PG8_STAGE(PG8_SB(0, 0), b2, voffB); PG8_STAGE(PG8_SB(0, 1), b2 + hstep, voffB); PG8_STAGE(PG8_SA(0, 0), a2, voffA);
            PG8_WAIT_V_RLX(rlx); PG8_WAIT_L(0); PG8_BAR; PG8_MMA(1, 0, At, B0); PG8_MMA(1, 1, At, B1); PG8_BAR; PG8_SCHED;
            PG8_LDB(B0, 1, 0); PG8_LDB(B1, 1, 1); PG8_SCHED; PG8_LDA(At, 1, 0); PG8_STAGE(PG8_SA(0, 1), a2 + hstep, voffA);
            PG8_WAIT_V(8); PG8_WAIT_L(0); PG8_BAR; PG8_MMA(0, 0, At, B0); PG8_MMA(0, 1, At, B1); PG8_BAR; PG8_SCHED;
            PG8_LDA(At, 1, 1); PG8_STAGE(PG8_SB(1, 0), b3, voffB); PG8_STAGE(PG8_SB(1, 1), b3 + hstep, voffB); PG8_STAGE(PG8_SA(1, 0), a3, voffA);
            PG8_WAIT_V(8); PG8_WAIT_L(0); PG8_BAR; PG8_MMA(1, 0, At, B0); PG8_MMA(1, 1, At, B1); PG8_BAR; PG8_SCHED;
            } else {
            PG8_LDB(B0, 0, 0); PG8_SCHED; PG8_LDA(At, 0, 0); PG8_STAGE(PG8_SA(1, 1), a1 + hstep, voffA);
            PG8_WAIT_L(8); PG8_BAR; PG8_WAIT_L(0); PG8_MMA(0, 0, At, B0); PG8_BAR; PG8_SCHED;
            PG8_LDB(B1, 0, 1); PG8_STAGE(PG8_SB(0, 0), b2, voffB);
            PG8_BAR; PG8_WAIT_L(0); PG8_MMA(0, 1, At, B1); PG8_BAR;
            PG8_LDA(At, 0, 1); PG8_STAGE(PG8_SA(0, 0), a2, voffA);
            PG8_BAR; PG8_WAIT_L(0); PG8_MMA(1, 0, At, B0); PG8_BAR; PG8_SCHED;
            PG8_STAGE(PG8_SB(0, 1), b2 + hstep, voffB);
            PG8_WAIT_V(6); PG8_BAR; PG8_MMA(1, 1, At, B1); PG8_BAR;
            PG8_LDB(B0, 1, 0); PG8_SCHED; PG8_LDA(At, 1, 0); PG8_STAGE(PG8_SA(0, 1), a2 + hstep, voffA);
            PG8_WAIT_L(8); PG8_BAR; PG8_WAIT_L(0); PG8_MMA(0, 0, At, B0); PG8_BAR; PG8_SCHED;
            PG8_LDB(B1, 1, 1); PG8_STAGE(PG8_SB(1, 0), b3, voffB);
            PG8_BAR; PG8_WAIT_L(0); PG8_MMA(0, 1, At, B1); PG8_BAR;
            PG8_LDA(At, 1, 1); PG8_STAGE(PG8_SA(1, 0), a3, voffA);
            PG8_BAR; PG8_WAIT_L(0); PG8_MMA(1, 0, At, B0); PG8_BAR; PG8_SCHED;
            PG8_STAGE(PG8_SB(1, 1), b3 + hstep, voffB);
            PG8_WAIT_V(6); PG8_BAR; PG8_MMA(1, 1, At, B1); PG8_BAR;
            }
        }
        if constexpr (ALIGN_EPI) { if (wr == 0) PG8_BAR; }
        bool keep_acc = false; if constexpr (Epi::CARRY) keep_acc = Epi::carry(cur) && has_next;
        if constexpr (!Epi::AFTER_DRAIN) { (void)E(acc, cur, wr, wc, fr, fq); S.done(cur); }
        if (!has_next) break;
        if (!keep_acc) {
#pragma unroll
        for (int a = 0; a < 2; ++a)
#pragma unroll
            for (int b = 0; b < 2; ++b)
#pragma unroll
                for (int m = 0; m < 4; ++m)
#pragma unroll
                    for (int n = 0; n < 2; ++n) acc[a][b][m][n] = (f32x4){0.f, 0.f, 0.f, 0.f};
        }
        cur = nxt; cA = nA; cB = nB; ++ui;
        if constexpr (ALIGN_EPI) { if (wr == 1) PG8_BAR; }
    }
    PG8_WAIT_V(0);
    if constexpr (!ALIGN_EPI) { if (wr == 0) PG8_BAR; }
    PG8_BAR;
    if constexpr (Epi::AFTER_DRAIN) { E.fused(acc, cur, wr, wc, fr, fq, lds, wid, lane); S.done(cur); }
#undef PG8_SA
#undef PG8_SB
#undef PG8_STAGE
#undef PG8_LDA
#undef PG8_LDB
#undef PG8_MMA
#undef PG8_WAIT_V
#undef PG8_WAIT_V_RLX
#undef PG8_WAIT_L
#undef PG8_BAR
#undef PG8_SCHED
}
}
namespace epi {
using pg8::f32x4; using pg8::u32x4; using pg8::Unit; using pg8::bf16_t;
typedef float f32x2_t __attribute__((ext_vector_type(2))); typedef __bf16 bf16x2_t __attribute__((ext_vector_type(2))); typedef _Float16 h16x2 __attribute__((ext_vector_type(2)));
__device__ __forceinline__ unsigned cvt_pk_bf16(float lo, float hi) { const f32x2_t v = {lo, hi}; const bf16x2_t b = __builtin_convertvector(v, bf16x2_t); return __builtin_bit_cast(unsigned, b); }
constexpr float EPSN = 1e-6f;
constexpr float QSCALE = 0.125f * 1.4426950408889634f;
__device__ __forceinline__ float bflo(unsigned w) { return __uint_as_float(w << 16); }
__device__ __forceinline__ float bfhi(unsigned w) { return __uint_as_float(w & 0xffff0000u); }
__device__ __forceinline__ float swz_xor16(float v) { return __int_as_float(__builtin_amdgcn_ds_swizzle(__float_as_int(v), 0x401F)); }
__device__ __forceinline__ float sum_halves(float v) { auto rr = __builtin_amdgcn_permlane32_swap(__float_as_uint(v), __float_as_uint(v), false, false); return __uint_as_float(rr[0]) + __uint_as_float(rr[1]); }
__device__ __forceinline__ float sum_fq(float v) { v += swz_xor16(v); return sum_halves(v); }
__device__ __forceinline__ void rstd_rows(const float* ss, int rowb, int fq, float (&r)[2][4]) {
    f32x4 a[2][4];
#pragma unroll
    for (int ai = 0; ai < 2; ++ai)
#pragma unroll
        for (int m = 0; m < 4; ++m) a[ai][m] = ((const f32x4*)(ss + (size_t)(rowb + ai * 128 + m * 16) * 16))[fq];
#pragma unroll
    for (int ai = 0; ai < 2; ++ai)
#pragma unroll
        for (int m = 0; m < 4; ++m) { float s = (a[ai][m][0] + a[ai][m][1]) + (a[ai][m][2] + a[ai][m][3]); s = sum_fq(s);
            r[ai][m] = __builtin_amdgcn_rsqf(s * (1.0f / 1024.0f) + EPSN); }
}
__device__ __forceinline__ float sigm(float v) { return __builtin_amdgcn_rcpf(1.0f + __expf(-v)); }

constexpr int PTR_OFF = 131072 + 1024;
__device__ __forceinline__ const float* lds_inptr(PG8_LAS unsigned char* ldsb, int i) {
    const PG8_LAS unsigned* t = (const PG8_LAS unsigned*)(ldsb + PTR_OFF) + 2 * i;
    const unsigned lo = __builtin_amdgcn_readfirstlane(t[0]), hi = __builtin_amdgcn_readfirstlane(t[1]);
    return (const float*)(const __attribute__((address_space(1))) float*)(((unsigned long long)hi << 32) | lo);
}
constexpr size_t EMiB = 1u << 20;
constexpr size_t EI_SS = 66 * EMiB, EI_ROPE = 74 * EMiB, EI_IW = 122 * EMiB, EI_IK = 124 * EMiB, EI_IQ = 132 * EMiB, EI_AQ = 292 * EMiB, EI_AK = 356 * EMiB, EI_AV = 420 * EMiB, EI_BQ = 484 * EMiB, EI_BK = 548 * EMiB, EI_BV = 612 * EMiB, EI_G = 676 * EMiB;
__device__ __forceinline__ void rstd_rows4(const float* ss, int rowh, int fq, float (&r)[4]) {
    f32x4 a[4];
#pragma unroll
    for (int m = 0; m < 4; ++m) a[m] = ((const f32x4*)(ss + (size_t)(rowh + m * 16) * 16))[fq];
#pragma unroll
    for (int m = 0; m < 4; ++m) { float s = (a[m][0] + a[m][1]) + (a[m][2] + a[m][3]); s = sum_fq(s); r[m] = __builtin_amdgcn_rsqf(s * (1.0f / 1024.0f) + EPSN); }
}
constexpr int RSTD_OFF = 131072 + 1024 + 512, RSTD_SLOTS = 8;
template <class Sched> __device__ __forceinline__ void rstd_prepass(PG8_LAS unsigned char* ldsb, const Sched& S, const float* ss, int tid) {
    PG8_LAS int* tab = (PG8_LAS int*)(ldsb + RSTD_OFF); PG8_LAS float* rt = (PG8_LAS float*)(ldsb + RSTD_OFF + 64);
    if (tid == 0) { int n = 0; Unit u;
        for (int i = 0; S.next(i, u); ++i) { bool f = false; for (int k = 0; k < n; ++k) f |= (tab[k] == u.pm); if (!f && n < RSTD_SLOTS) tab[n++] = u.pm; }
        for (int k = n; k < RSTD_SLOTS; ++k) tab[k] = -1; }
    __syncthreads();
    for (int k = 0; k < RSTD_SLOTS; ++k) { const int pm = tab[k]; if (pm < 0) break;
        const int row = pm * 256 + (tid >> 1); const f32x4* p = (const f32x4*)(ss + (size_t)row * 16) + 2 * (tid & 1);
        const f32x4 a = p[0], b = p[1]; float s = ((a[0] + a[1]) + (a[2] + a[3])) + ((b[0] + b[1]) + (b[2] + b[3]));
        s += __int_as_float(__builtin_amdgcn_ds_swizzle(__float_as_int(s), 0x041F));
        if ((tid & 1) == 0) rt[k * 256 + (tid >> 1)] = __builtin_amdgcn_rsqf(s * (1.0f / 1024.0f) + EPSN); }
    __syncthreads();
}
__device__ __forceinline__ const PG8_LAS float* rstd_slot(PG8_LAS unsigned char* ldsb, int pm) {
    const PG8_LAS int* tab = (const PG8_LAS int*)(ldsb + RSTD_OFF); int slot = 0;
#pragma unroll
    for (int k = 1; k < RSTD_SLOTS; ++k) slot = (tab[k] == pm) ? k : slot;
    slot = __builtin_amdgcn_readfirstlane(slot);
    return (const PG8_LAS float*)(ldsb + RSTD_OFF + 64) + slot * 256;
}
__device__ __forceinline__ size_t gate_block(int pm, int t, int wave5, int ai, int mp, int bj5) { return ((size_t)((((pm * 8 + t) * 8 + wave5) * 2 + ai) * 2 + mp) * 2 + bj5) * 1024; }
constexpr float GATE_SC = -1.4426950408889634f;
struct EpiIn {
    static constexpr bool PERM = true, AFTER_DRAIN = false, CARRY = false; static constexpr int VMEM_MIN = 0;
    unsigned char* ws; PG8_LAS unsigned char* ldsb; int layer;
    __device__ __forceinline__ int operator()(const f32x4 (&acc)[2][2][4][2], const Unit& u, int wr, int wc, int fr, int fq) const {
        asm volatile("" : "+v"(fr), "+v"(fq));
        const int pn = u.pn, rowb = u.pm * 256 + wr * 64 + fr;
        const unsigned* rope = (const unsigned*)(ws + EI_ROPE);
        const PG8_LAS float* rt = rstd_slot(ldsb, u.pm) + wr * 64 + fr;
        if (pn >= 14) {
            const int colb = (pn - 14) * 256 + wc * 64 + 8 * fq;
            const float* gbias = lds_inptr(ldsb, 4) + layer * 2048; unsigned char* G8 = ws + EI_G;
            f32x4 bia[2][2];
#pragma unroll
            for (int bj = 0; bj < 2; ++bj)
#pragma unroll
                for (int n = 0; n < 2; ++n) bia[bj][n] = *(const f32x4*)(gbias + colb + 32 * bj + 4 * n) * GATE_SC;
#pragma unroll
            for (int ai = 0; ai < 2; ++ai) {
#pragma unroll
                for (int mp = 0; mp < 2; ++mp) { uint2 pc[2][2];
#pragma unroll
                  for (int mm = 0; mm < 2; ++mm) { const int m = 2 * mp + mm; const float r = rt[ai * 128 + m * 16] * GATE_SC;
#pragma unroll
                    for (int bj = 0; bj < 2; ++bj) { f32x4 v0 = acc[ai][bj][m][0] * r + bia[bj][0], v1 = acc[ai][bj][m][1] * r + bia[bj][1];
#pragma unroll
                        for (int i = 0; i < 4; ++i) { v0[i] = __builtin_amdgcn_fmed3f(v0[i], -86.f, 86.f); v1[i] = __builtin_amdgcn_fmed3f(v1[i], -86.f, 86.f); }
                        int w0 = 0, w1 = 0; w0 = __builtin_amdgcn_cvt_pk_fp8_f32(v0[0], v0[1], w0, false); w0 = __builtin_amdgcn_cvt_pk_fp8_f32(v0[2], v0[3], w0, true);
                        w1 = __builtin_amdgcn_cvt_pk_fp8_f32(v1[0], v1[1], w1, false); w1 = __builtin_amdgcn_cvt_pk_fp8_f32(v1[2], v1[3], w1, true);
                        pc[mm][bj] = make_uint2((unsigned)w0, (unsigned)w1); } }
#pragma unroll
                  for (int bj = 0; bj < 2; ++bj) { u32x4 w; w.x = pc[0][bj].x; w.y = pc[0][bj].y; w.z = pc[1][bj].x; w.w = pc[1][bj].y;
                        *(u32x4*)(G8 + gate_block(u.pm, pn - 14, wr * 4 + (wc & 1) * 2 + bj, ai, mp, wc >> 1) + (fq * 16 + fr) * 16) = w; } } }
            return 24;
        }
        size_t doff; int gi = -1; int pitch = 512; bool rp = false; float sc = 1.f;
        int vn = -1, vhalf = 0, vw = 8;
        int kn = -1;
        if (pn < 2)       { doff = EI_AQ + (size_t)((pn * 4 + wc) * 64) * 2; gi = 5; rp = true; sc = QSCALE; }
        else if (pn < 4)  { doff = EI_AK; kn = (pn - 2) * 4 + wc; gi = 6; rp = true; }
        else if (pn < 6)  { doff = EI_AV; vn = (pn - 4) * 4 + wc; }
        else if (pn == 6) { doff = EI_IQ + (size_t)(wc * 64) * 2; pitch = 256; rp = true; }
        else if (pn == 7) {
            if (wc == 0) { doff = EI_IK; pitch = 64; gi = 7; rp = true; kn = 100; }
            else { if (wc == 1) {
                    float* IW = (float*)(ws + EI_IW);
#pragma unroll
                    for (int ai = 0; ai < 2; ++ai)
#pragma unroll
                        for (int m = 0; m < 4; ++m) { const int row = rowb + ai * 128 + m * 16; if (fq == 0) *(f32x4*)(IW + (size_t)row * 4) = acc[ai][0][m][0] * (rt[ai * 128 + m * 16] * 0.5f); } }
                return (wc == 1) ? 1 : 0; } }
        else if (pn < 10) { doff = EI_BQ + (size_t)(((pn - 8) * 4 + wc) * 64) * 2; gi = 8; rp = true; sc = QSCALE; }
        else if (pn < 12) { doff = EI_BK; kn = (pn - 10) * 4 + wc; gi = 9; rp = true; }
        else              { doff = EI_BV; const int sl_ = (pn - 12) * 4 + wc; vn = sl_ >> 1; vhalf = sl_ & 1; vw = 16; }
        bf16_t* dst = (bf16_t*)(ws + doff);
        const float* gn = (gi >= 0) ? lds_inptr(ldsb, gi) + layer * 64 : nullptr;
        float gv[2][8];
#pragma unroll
        for (int bj = 0; bj < 2; ++bj)
#pragma unroll
            for (int j = 0; j < 8; ++j) gv[bj][j] = 1.f;
        if (gn) {
#pragma unroll
            for (int bj = 0; bj < 2; ++bj) { const f32x4 a = *(const f32x4*)(gn + 32 * bj + 8 * fq), b = *(const f32x4*)(gn + 32 * bj + 8 * fq + 4);
                gv[bj][0] = a[0] * sc; gv[bj][1] = a[1] * sc; gv[bj][2] = a[2] * sc; gv[bj][3] = a[3] * sc; gv[bj][4] = b[0] * sc; gv[bj][5] = b[1] * sc; gv[bj][6] = b[2] * sc; gv[bj][7] = b[3] * sc; } }
#pragma unroll
        for (int ai = 0; ai < 2; ++ai) {
            u32x4 cw[4][2];
            if (rp) {
#pragma unroll
                for (int mm = 0; mm < 4; ++mm) { const u32x4* cp = (const u32x4*)(rope + (size_t)(rowb + ai * 128 + mm * 16) * 32 + 8 * fq); cw[mm][0] = cp[0]; cw[mm][1] = cp[1]; } }
#pragma unroll
            for (int mm = 0; mm < 4; ++mm) { const int m = mm; const int row = rowb + ai * 128 + m * 16;
                const float r = rt[ai * 128 + m * 16];
                float v[2][8];
                if (gn) {
                    float q = 0.f;
#pragma unroll
                    for (int bj = 0; bj < 2; ++bj)
#pragma unroll
                        for (int n = 0; n < 2; ++n)
#pragma unroll
                            for (int i = 0; i < 4; ++i) q += acc[ai][bj][m][n][i] * acc[ai][bj][m][n][i];
                    q = sum_fq(q);
                    const float s = r * __builtin_amdgcn_rsqf(q * (r * r) * (1.0f / 64.0f) + EPSN);
#pragma unroll
                    for (int bj = 0; bj < 2; ++bj)
#pragma unroll
                        for (int n = 0; n < 2; ++n)
#pragma unroll
                            for (int i = 0; i < 4; ++i) v[bj][4 * n + i] = (acc[ai][bj][m][n][i] * s) * gv[bj][4 * n + i];
                } else { const float s = r * sc;
#pragma unroll
                    for (int bj = 0; bj < 2; ++bj)
#pragma unroll
                        for (int n = 0; n < 2; ++n)
#pragma unroll
                            for (int i = 0; i < 4; ++i) v[bj][4 * n + i] = acc[ai][bj][m][n][i] * s;
                }
                if (rp) {
#pragma unroll
                    for (int j = 0; j < 8; ++j) { const unsigned cwj = cw[mm][j >> 2][j & 3]; const h16x2 hh = __builtin_bit_cast(h16x2, cwj); const float cs = (float)hh[0], sn = (float)hh[1];
                        const float a = v[0][j], b = v[1][j]; v[0][j] = a * cs - b * sn; v[1][j] = b * cs + a * sn; }
                }
#pragma unroll
                for (int bj = 0; bj < 2; ++bj) { u32x4 w; w.x = cvt_pk_bf16(v[bj][0], v[bj][1]); w.y = cvt_pk_bf16(v[bj][2], v[bj][3]); w.z = cvt_pk_bf16(v[bj][4], v[bj][5]); w.w = cvt_pk_bf16(v[bj][6], v[bj][7]);
                    bf16_t* p_ = (kn == 100) ? dst + (((((size_t)((row >> 11) * 64 + ((row & 2047) >> 5)) * 4 + (2 * bj + (fq >> 1))) * 2 + (fq & 1)) * 32 + (row & 31)) << 3) : (vn >= 0) ? dst + (((((size_t)((row >> 11) * (vw == 16 ? 4 : 8) + vn) * 32 + ((row & 2047) >> 6)) * vw + (vhalf * 8 + 4 * bj + ((row & 63) >> 4))) * 64 + ((row & 15) * 4 + fq)) << 3) : (kn >= 0) ? dst + (((((size_t)((row >> 11) * 8 + kn) * 32 + ((row & 2047) >> 6)) * 8 + (4 * bj + fq)) * 64 + (row & 63)) << 3) : dst + (size_t)row * pitch + 32 * bj + 8 * fq;
                    *(u32x4*)p_ = w; }
            }
        }
        return 24;
    }
};

template <bool SECOND> struct EpiGate {
    static constexpr bool PERM = true, AFTER_DRAIN = false, CARRY = false; static constexpr int VMEM_MIN = SECOND ? 48 : 32;
    const unsigned char* G; bf16_t* T; bf16_t* O;
    __device__ __forceinline__ int operator()(const f32x4 (&acc)[2][2][4][2], const Unit& u, int wr, int wc, int fr, int fq) const {
        const int rowb = u.pm * 256 + wr * 64 + fr, colb = u.pn * 256 + wc * 32 + 8 * fq;
#pragma unroll
        for (int ai = 0; ai < 2; ++ai) {
            uint2 gw[4][2]; u32x4 tw[4][2];
#pragma unroll
            for (int m = 0; m < 4; ++m)
#pragma unroll
                for (int bj = 0; bj < 2; ++bj) { gw[m][bj] = *(const uint2*)(G + (size_t)(rowb + ai * 128 + m * 16) * 2048 + (SECOND ? 1024 : 0) + colb + 128 * bj);
                    if (SECOND) tw[m][bj] = *(const u32x4*)(T + (size_t)(rowb + ai * 128 + m * 16) * 1024 + colb + 128 * bj); }
#pragma unroll
            for (int m = 0; m < 4; ++m) { const int row = rowb + ai * 128 + m * 16;
#pragma unroll
                for (int bj = 0; bj < 2; ++bj) { const int col = colb + 128 * bj; const uint2 g8 = gw[m][bj];
                    const f32x2_t g01 = __builtin_amdgcn_cvt_pk_f32_fp8((int)g8.x, false), g23 = __builtin_amdgcn_cvt_pk_f32_fp8((int)g8.x, true), g45 = __builtin_amdgcn_cvt_pk_f32_fp8((int)g8.y, false), g67 = __builtin_amdgcn_cvt_pk_f32_fp8((int)g8.y, true);
                    const f32x4 a0 = acc[ai][bj][m][0], a1 = acc[ai][bj][m][1];
                    float v[8] = {a0[0] * sigm(g01.x), a0[1] * sigm(g01.y), a0[2] * sigm(g23.x), a0[3] * sigm(g23.y), a1[0] * sigm(g45.x), a1[1] * sigm(g45.y), a1[2] * sigm(g67.x), a1[3] * sigm(g67.y)};
                    if (SECOND) { const u32x4 t = tw[m][bj];
                        v[0] += bflo(t.x); v[1] += bfhi(t.x); v[2] += bflo(t.y); v[3] += bfhi(t.y); v[4] += bflo(t.z); v[5] += bfhi(t.z); v[6] += bflo(t.w); v[7] += bfhi(t.w); }
                    u32x4 w; w.x = cvt_pk_bf16(v[0], v[1]); w.y = cvt_pk_bf16(v[2], v[3]); w.z = cvt_pk_bf16(v[4], v[5]); w.w = cvt_pk_bf16(v[6], v[7]);
                    *(u32x4*)((SECOND ? O : T) + (size_t)row * 1024 + col) = w; } }
        }
        return SECOND ? 48 : 32;
    }
};

struct EpiGatePair {
    static constexpr bool PERM = true, AFTER_DRAIN = false, CARRY = false; static constexpr int VMEM_MIN = 32;
    const unsigned char* G; bf16_t* T; bf16_t* O;
    __device__ __forceinline__ int operator()(const f32x4 (&acc)[2][2][4][2], const Unit& u, int wr, int wc, int fr, int fq) const {
        if (u.pn < 4) { const EpiGate<false> e{G, T, O}; return e(acc, u, wr, wc, fr, fq); }
        const Unit v{u.pm, u.pn - 4}; const EpiGate<true> e{G, T, O}; return e(acc, v, wr, wc, fr, fq);
    }
};

struct EpiGateFused {
    static constexpr bool PERM = true, AFTER_DRAIN = false, CARRY = true; static constexpr int VMEM_MIN = 16;
    const unsigned char* G; bf16_t* O;
    static __device__ __forceinline__ bool carry(const Unit& u) { return u.pn < 4; }
    static __device__ __forceinline__ float ex(float g) { return __builtin_amdgcn_exp2f(g); }
    __device__ __forceinline__ int operator()(f32x4 (&acc)[2][2][4][2], const Unit& u, int wr, int wc, int fr, int fq) const {
        const bool first = u.pn < 4;
        const int rowb = u.pm * 256 + wr * 64 + fr, colb = (u.pn & 3) * 256 + wc * 32 + 8 * fq;
        if (first) {
#pragma unroll
            for (int ai = 0; ai < 2; ++ai) {
                uint2 ga[4][2], gb[4][2];
#pragma unroll
                for (int mp = 0; mp < 2; ++mp)
#pragma unroll
                    for (int bj = 0; bj < 2; ++bj) { const int ln16 = (fq * 16 + fr) * 16; const u32x4 qa = *(const u32x4*)(G + gate_block(u.pm, u.pn & 3, wr * 4 + wc, ai, mp, bj) + ln16), qb = *(const u32x4*)(G + gate_block(u.pm, 4 + (u.pn & 3), wr * 4 + wc, ai, mp, bj) + ln16);
                        ga[2 * mp][bj] = make_uint2(qa.x, qa.y); ga[2 * mp + 1][bj] = make_uint2(qa.z, qa.w); gb[2 * mp][bj] = make_uint2(qb.x, qb.y); gb[2 * mp + 1][bj] = make_uint2(qb.z, qb.w); }
#pragma unroll
                for (int m = 0; m < 4; ++m)
#pragma unroll
                    for (int bj = 0; bj < 2; ++bj) {
                        const f32x2_t a01 = __builtin_amdgcn_cvt_pk_f32_fp8((int)ga[m][bj].x, false), a23 = __builtin_amdgcn_cvt_pk_f32_fp8((int)ga[m][bj].x, true), a45 = __builtin_amdgcn_cvt_pk_f32_fp8((int)ga[m][bj].y, false), a67 = __builtin_amdgcn_cvt_pk_f32_fp8((int)ga[m][bj].y, true);
                        const f32x2_t b01 = __builtin_amdgcn_cvt_pk_f32_fp8((int)gb[m][bj].x, false), b23 = __builtin_amdgcn_cvt_pk_f32_fp8((int)gb[m][bj].x, true), b45 = __builtin_amdgcn_cvt_pk_f32_fp8((int)gb[m][bj].y, false), b67 = __builtin_amdgcn_cvt_pk_f32_fp8((int)gb[m][bj].y, true);
                        const float ga8[8] = {a01.x, a01.y, a23.x, a23.y, a45.x, a45.y, a67.x, a67.y}, gb8[8] = {b01.x, b01.y, b23.x, b23.y, b45.x, b45.y, b67.x, b67.y};
#pragma unroll
                        for (int n = 0; n < 2; ++n)
#pragma unroll
                            for (int i = 0; i < 4; ++i) acc[ai][bj][m][n][i] *= (1.0f + ex(gb8[4 * n + i])) * __builtin_amdgcn_rcpf(1.0f + ex(ga8[4 * n + i]));
                    }
            }
            return 32;
        }
#pragma unroll
        for (int ai = 0; ai < 2; ++ai) {
            uint2 gb[4][2];
#pragma unroll
            for (int mp = 0; mp < 2; ++mp)
#pragma unroll
                for (int bj = 0; bj < 2; ++bj) { const u32x4 qb = *(const u32x4*)(G + gate_block(u.pm, 4 + (u.pn & 3), wr * 4 + wc, ai, mp, bj) + (fq * 16 + fr) * 16); gb[2 * mp][bj] = make_uint2(qb.x, qb.y); gb[2 * mp + 1][bj] = make_uint2(qb.z, qb.w); }
#pragma unroll
            for (int m = 0; m < 4; ++m) { const int row = rowb + ai * 128 + m * 16;
#pragma unroll
                for (int bj = 0; bj < 2; ++bj) { const int col = colb + 128 * bj;
                    const f32x2_t b01 = __builtin_amdgcn_cvt_pk_f32_fp8((int)gb[m][bj].x, false), b23 = __builtin_amdgcn_cvt_pk_f32_fp8((int)gb[m][bj].x, true), b45 = __builtin_amdgcn_cvt_pk_f32_fp8((int)gb[m][bj].y, false), b67 = __builtin_amdgcn_cvt_pk_f32_fp8((int)gb[m][bj].y, true);
                    const f32x4 a0 = acc[ai][bj][m][0], a1 = acc[ai][bj][m][1];
                    auto sg = [](float g) { return __builtin_amdgcn_rcpf(1.0f + __builtin_amdgcn_exp2f(g)); };
                    const float v[8] = {a0[0] * sg(b01.x), a0[1] * sg(b01.y), a0[2] * sg(b23.x), a0[3] * sg(b23.y), a1[0] * sg(b45.x), a1[1] * sg(b45.y), a1[2] * sg(b67.x), a1[3] * sg(b67.y)};
                    u32x4 w; w.x = cvt_pk_bf16(v[0], v[1]); w.y = cvt_pk_bf16(v[2], v[3]); w.z = cvt_pk_bf16(v[4], v[5]); w.w = cvt_pk_bf16(v[6], v[7]);
                    *(u32x4*)(O + (size_t)row * 1024 + col) = w; } }
        }
        return 32;
    }
};

struct EpiRes {
    static constexpr bool PERM = true, AFTER_DRAIN = false, CARRY = false; static constexpr int VMEM_MIN = 40;
    bf16_t* XB; float* ssout; float* fout; bf16_t* XO;
    __device__ __forceinline__ int operator()(const f32x4 (&acc)[2][2][4][2], const Unit& u, int wr, int wc, int fr, int fq) const {
        const int rowb = u.pm * 256 + wr * 64 + fr, colb = u.pn * 256 + wc * 32 + 8 * fq;
        u32x4 bw[2][4][2];
#pragma unroll
        for (int ai = 0; ai < 2; ++ai)
#pragma unroll
            for (int m = 0; m < 4; ++m)
#pragma unroll
                for (int bj = 0; bj < 2; ++bj) bw[ai][m][bj] = *(const u32x4*)(XB + (size_t)(rowb + ai * 128 + m * 16) * 1024 + colb + 128 * bj);
#pragma unroll
        for (int ai = 0; ai < 2; ++ai)
#pragma unroll
            for (int m = 0; m < 4; ++m) { const int row = rowb + ai * 128 + m * 16; float q = 0.f;
#pragma unroll
                for (int bj = 0; bj < 2; ++bj) { const size_t off = (size_t)row * 1024 + colb + 128 * bj; const u32x4 b = bw[ai][m][bj];
                    const f32x4 o0 = (f32x4){bflo(b.x), bfhi(b.x), bflo(b.y), bfhi(b.y)} + acc[ai][bj][m][0], o1 = (f32x4){bflo(b.z), bfhi(b.z), bflo(b.w), bfhi(b.w)} + acc[ai][bj][m][1];
                    if (fout) { *(f32x4*)(fout + off) = o0; *(f32x4*)(fout + off + 4) = o1; }
                    u32x4 w; w.x = cvt_pk_bf16(o0[0], o0[1]); w.y = cvt_pk_bf16(o0[2], o0[3]); w.z = cvt_pk_bf16(o1[0], o1[1]); w.w = cvt_pk_bf16(o1[2], o1[3]);
                    if (!fout) *(u32x4*)(XO + off) = w;
                    q += ((o0[0] * o0[0] + o0[1] * o0[1]) + (o0[2] * o0[2] + o0[3] * o0[3])) + ((o1[0] * o1[0] + o1[1] * o1[1]) + (o1[2] * o1[2] + o1[3] * o1[3])); }
                q = sum_fq(q);
                if (fq == 0 && !fout) ssout[(size_t)row * 16 + u.pn * 4 + wc] = q; }
        return 40;
    }
};

struct EpiSwiglu {
    static constexpr bool PERM = true, AFTER_DRAIN = false, CARRY = false; static constexpr int VMEM_MIN = 8;
    PG8_LAS unsigned char* ldsb; bf16_t* ACT;
    __device__ __forceinline__ int operator()(const f32x4 (&acc)[2][2][4][2], const Unit& u, int wr, int wc, int fr, int fq) const {
        const int rowb = u.pm * 256 + wr * 64 + fr, colb = u.pn * 128 + wc * 32 + 8 * fq;
        const PG8_LAS float* rt = rstd_slot(ldsb, u.pm) + wr * 64 + fr;
#pragma unroll
        for (int ai = 0; ai < 2; ++ai)
#pragma unroll
            for (int m = 0; m < 4; ++m) { const int row = rowb + ai * 128 + m * 16; const float r = rt[ai * 128 + m * 16];
                float a[8];
#pragma unroll
                for (int n = 0; n < 2; ++n)
#pragma unroll
                    for (int i = 0; i < 4; ++i) { const float g = acc[ai][0][m][n][i] * r, up = acc[ai][1][m][n][i] * r; a[4 * n + i] = (g * sigm(g)) * up; }
                u32x4 w; w.x = cvt_pk_bf16(a[0], a[1]); w.y = cvt_pk_bf16(a[2], a[3]); w.z = cvt_pk_bf16(a[4], a[5]); w.w = cvt_pk_bf16(a[6], a[7]);
                *(u32x4*)(ACT + (size_t)row * 2816 + colb) = w; }
        return 16;
    }
};

template <int MODE> struct EpiProbe {
    static constexpr bool PERM = true, AFTER_DRAIN = false, CARRY = false; static constexpr int VMEM_MIN = 0;
    bf16_t* ACT;
    __device__ __forceinline__ int operator()(const f32x4 (&acc)[2][2][4][2], const Unit& u, int wr, int wc, int fr, int fq) const {
#pragma unroll
        for (int ai = 0; ai < 2; ++ai)
#pragma unroll
            for (int bj = 0; bj < 2; ++bj)
#pragma unroll
                for (int m = 0; m < 4; ++m) asm volatile("" :: "v"(acc[ai][bj][m][0]), "v"(acc[ai][bj][m][1]));
        if (MODE == 0) return 0;
        const int rowb = u.pm * 256 + wr * 64 + fr, colb = u.pn * 128 + wc * 32 + 8 * fq;
#pragma unroll
        for (int ai = 0; ai < 2; ++ai)
#pragma unroll
            for (int m = 0; m < 4; ++m) { const int row = rowb + ai * 128 + m * 16; u32x4 w; w.x = cvt_pk_bf16(acc[ai][0][m][0][0], acc[ai][0][m][0][1]); w.y = cvt_pk_bf16(acc[ai][0][m][0][2], acc[ai][0][m][0][3]); w.z = cvt_pk_bf16(acc[ai][1][m][1][0], acc[ai][1][m][1][1]); w.w = cvt_pk_bf16(acc[ai][1][m][1][2], acc[ai][1][m][1][3]);
                *(u32x4*)(ACT + (size_t)row * 2816 + colb) = w; }
        return 8;
    }
};
}
#include <hip/hip_bf16.h>
#include <cmath>
namespace attn_body {
using bf16=__hip_bfloat16;
using bf16x8=__attribute__((ext_vector_type(8)))short;
using s16x4=__attribute__((ext_vector_type(4)))short;
using f32x16=__attribute__((ext_vector_type(16)))float;
using u32x4=__attribute__((ext_vector_type(4)))unsigned;
constexpr int SEQ=2048,D=64,DM=512;
constexpr int NW=8,QBLK=32,QB=QBLK*NW,KVBLK=64,NQB=SEQ/QB;
constexpr int ATTN_PITCH=DM, ATTN_UNIT_ROWS=QB;
__device__ __forceinline__ int crow(int r,int hi){return (r&3)+8*(r>>2)+4*hi;}
#define SBAR() __builtin_amdgcn_sched_barrier(0)
__device__ __forceinline__ void cmask(f32x16&p0,f32x16&p1,int jb,int qrel,int hi){
  const float NEG=-INFINITY; int qh=qrel-64*jb-4*hi; asm volatile("":"+v"(qh));
  #pragma unroll
  for(int r=0;r<16;++r){const int c=(r&3)+8*(r>>2); if(c>qh)p0[r]=NEG; if(c+32>qh)p1[r]=NEG;}
}

constexpr int NSLOT=3, SLOTB=8192;
constexpr int LDS_K=0, LDS_V=NSLOT*SLOTB, LDS_WS=2*NSLOT*SLOTB, LDS_OST=LDS_WS+NW*64*4, LDS_BYTES=LDS_OST+NW*4096;
constexpr float C2=0.125f*1.4426950408889634f;
__device__ __forceinline__ void glds16(const void*gsrc,unsigned lds_dst){unsigned keep;
  asm volatile("s_mov_b32 %0, m0\n\ts_mov_b32 m0, %2\n\ts_nop 0\n\tglobal_load_lds_dwordx4 %1, off\n\ts_mov_b32 m0, %0":"=&s"(keep):"v"(gsrc),"s"(lds_dst):"memory");}
__device__ __forceinline__ float max3f(float a,float b,float c){float r;asm("v_max3_f32 %0, %1, %2, %3":"=v"(r):"v"(a),"v"(b),"v"(c));return r;}
__device__ __forceinline__ float max2f(float a,float b){float r;asm("v_max_f32_e32 %0, %1, %2":"=v"(r):"v"(a),"v"(b));return r;}
__device__ __forceinline__ float fadd_s(float a,float b){float r;asm("v_add_f32_e32 %0, %1, %2":"=v"(r):"v"(a),"v"(b));return r;}
__device__ __forceinline__ float fsub_s(float a,float b){float r;asm("v_sub_f32_e32 %0, %1, %2":"=v"(r):"v"(a),"v"(b));return r;}
typedef float f32x2_t __attribute__((ext_vector_type(2))); typedef __bf16 bf16x2_t __attribute__((ext_vector_type(2)));
__device__ __forceinline__ unsigned cvtpk_s(float lo,float hi){f32x2_t v={lo,hi};bf16x2_t b=__builtin_convertvector(v,bf16x2_t);return __builtin_bit_cast(unsigned,b);}
#define WAIT_BAR(N) asm volatile("s_waitcnt vmcnt(" #N ") lgkmcnt(0)\n\ts_barrier":::"memory")

__device__ __forceinline__ void qkt(f32x16&p0,f32x16&p1,const char*Kslot,const bf16x8*qr,const f32x16&negm,int r32,int hi){
  const char*kb=Kslot+hi*1024+r32*16;
  #pragma unroll
  for(int d0=0;d0<4;++d0){
    const bf16x8 b0=*reinterpret_cast<const bf16x8*>(kb+d0*2048);
    const bf16x8 b1=*reinterpret_cast<const bf16x8*>(kb+d0*2048+512);
    if(d0==0){p0=__builtin_amdgcn_mfma_f32_32x32x16_bf16(b0,qr[0],negm,0,0,0);p1=__builtin_amdgcn_mfma_f32_32x32x16_bf16(b1,qr[0],negm,0,0,0);}
    else{p0=__builtin_amdgcn_mfma_f32_32x32x16_bf16(b0,qr[d0],p0,0,0,0);p1=__builtin_amdgcn_mfma_f32_32x32x16_bf16(b1,qr[d0],p1,0,0,0);}}
}
typedef __attribute__((address_space(3))) const char* lds_cptr;
typedef short v4i16_t __attribute__((ext_vector_type(4)));
__device__ __forceinline__ void kload8(bf16x8*kf,lds_cptr kp){
  kf[0]=*(const __attribute__((address_space(3))) bf16x8*)(kp);      kf[1]=*(const __attribute__((address_space(3))) bf16x8*)(kp+512);
  kf[2]=*(const __attribute__((address_space(3))) bf16x8*)(kp+2048); kf[3]=*(const __attribute__((address_space(3))) bf16x8*)(kp+2560);
  kf[4]=*(const __attribute__((address_space(3))) bf16x8*)(kp+4096); kf[5]=*(const __attribute__((address_space(3))) bf16x8*)(kp+4608);
  kf[6]=*(const __attribute__((address_space(3))) bf16x8*)(kp+6144); kf[7]=*(const __attribute__((address_space(3))) bf16x8*)(kp+6656);
}
__device__ __forceinline__ void kload2(bf16x8*kf,lds_cptr kp,int j){ kf[2*j]=*(const __attribute__((address_space(3))) bf16x8*)(kp+j*2048); kf[2*j+1]=*(const __attribute__((address_space(3))) bf16x8*)(kp+j*2048+512); }
__device__ __forceinline__ s16x4 vtr(lds_cptr p){ return __builtin_bit_cast(s16x4,__builtin_amdgcn_ds_read_tr16_b64_v4i16((__attribute__((address_space(3))) v4i16_t*)p)); }
__device__ __forceinline__ float rowmax(const f32x16&p0,const f32x16&p1){
  float a=max3f(p0[0],p0[1],p1[0]),b=max3f(p0[2],p0[3],p1[1]);a=max3f(a,p1[2],p1[3]);
  #pragma unroll
  for(int r=4;r<16;r+=4){a=max3f(a,p0[r],p0[r+1]);b=max3f(b,p0[r+2],p0[r+3]);a=max3f(a,p1[r],p1[r+1]);b=max3f(b,p1[r+2],p1[r+3]);}
  const float m=max2f(a,b);
  auto rr=__builtin_amdgcn_permlane32_swap(__float_as_uint(m),__float_as_uint(m),false,false);
  return max2f(__uint_as_float(rr[0]),__uint_as_float(rr[1]));
}
template<int NO> __device__ __forceinline__ void pv(f32x16*o,int vb,bf16x8 pa0,bf16x8 pa1,bf16x8 pa2,bf16x8 pa3){
  #pragma unroll
  for(int d0=0;d0<NO;++d0){s16x4 lo[4],hi[4];
    #pragma unroll
    for(int ks=0;ks<4;++ks){
      asm volatile("ds_read_b64_tr_b16 %0,%1 offset:%c2":"=&v"(lo[ks]):"v"(vb),"i"(d0*4096+ks*1024):"memory");
      asm volatile("ds_read_b64_tr_b16 %0,%1 offset:%c2":"=&v"(hi[ks]):"v"(vb),"i"(d0*4096+ks*1024+512):"memory");}
    asm volatile("s_waitcnt lgkmcnt(0)":::"memory");SBAR();
    #define PK(k) (bf16x8){lo[k][0],lo[k][1],lo[k][2],lo[k][3],hi[k][0],hi[k][1],hi[k][2],hi[k][3]}
    o[d0]=__builtin_amdgcn_mfma_f32_32x32x16_bf16(pa0,PK(0),o[d0],0,0,0);
    o[d0]=__builtin_amdgcn_mfma_f32_32x32x16_bf16(pa1,PK(1),o[d0],0,0,0);
    o[d0]=__builtin_amdgcn_mfma_f32_32x32x16_bf16(pa2,PK(2),o[d0],0,0,0);
    o[d0]=__builtin_amdgcn_mfma_f32_32x32x16_bf16(pa3,PK(3),o[d0],0,0,0);
    #undef PK
  }
}

#ifndef ATTN_STORE16
#define ATTN_STORE16(p,v) (*(u32x4*)(p)=(v))
#endif
template<int THRL,bool TOPK,bool DV> __device__ __forceinline__ void attn_unit(int b,int qb,const bf16*Qc,const bf16*__restrict__ Kc,const bf16*__restrict__ Vc,bf16*Oc,const unsigned*__restrict__ mk,char*shm,const int wave_in,const bool cmb=false,const bf16*Oprev=nullptr,const float*__restrict__ subg=nullptr,const float lam=0.f,const float oscale=0.f){
  int lane_; asm volatile("v_mbcnt_lo_u32_b32 %0, -1, 0\n\tv_mbcnt_hi_u32_b32 %0, -1, %0":"=v"(lane_)); const int lane=lane_,r32=lane&31,hi=lane>>5; const int wid=wave_in;
  const long rowbase=(long)b*SEQ; const int q0=qb*QB;
  constexpr int VSL=DV?2:1, NO=DV?4:2, LW=LDS_V+NSLOT*SLOTB*VSL, LO=LW+NW*64*4;
  const bf16*Qw=Qc+(rowbase+q0+wid*QBLK)*DM;
  const bf16*Kh=Kc+rowbase*DM,*Vh=Vc+rowbase*DM;
  const unsigned lds0=(unsigned)(uintptr_t)shm;
  float*wsf=(float*)(shm+LW)+wid*64;
  const bf16*ksrc=Kh+wid*512+lane*8;
  const bf16*vsrc=Vh+wid*512+lane*8;
  const unsigned kdst=lds0+LDS_K+wid*1024, vdst=lds0+LDS_V+wid*1024;
  #define DMA_K(t,slot) glds16(ksrc+(long)(t)*(KVBLK*64),(unsigned)__builtin_amdgcn_readfirstlane(kdst+(slot)))
  #define DMA_V(t,slot) do{ glds16(vsrc+(long)(t)*(DV?8192:4096),(unsigned)__builtin_amdgcn_readfirstlane(vdst+VSL*(slot))); if(DV){ glds16(vsrc+(long)(t)*8192+4096,(unsigned)__builtin_amdgcn_readfirstlane(vdst+VSL*(slot)+8192)); } }while(0)
  const int vb0=(int)(lds0+LDS_V)+((lane>>4)&1)*32+(lane&3)*8+(4*hi+((lane&15)>>2))*64;
  const char*Kbase=shm+LDS_K; bf16x8 kf[8];
  const lds_cptr shm3=(lds_cptr)shm; const lds_cptr kp0=shm3+LDS_K+hi*1024+r32*16; const lds_cptr vp0=shm3+LDS_V+((lane>>4)&1)*32+(lane&3)*8+(4*hi+((lane&15)>>2))*64;
  const int NT=(q0+QB)/KVBLK;
  DMA_K(0,0);DMA_V(0,0);DMA_K(1,SLOTB);
  bf16x8 qr[4];
  #pragma unroll
  for(int d0=0;d0<4;++d0)qr[d0]=*reinterpret_cast<const bf16x8*>(&Qw[(long)r32*DM+d0*16+hi*8]);
  float mhat=0.f,l_reg=0.f;f32x16 o[NO]; _Pragma("unroll") for(int d_=0;d_<NO;++d_)o[d_]=f32x16{};f32x16 negm=f32x16{}; if(!DV){asm volatile("":"+v"(negm));}
  const int qrel=wid*QBLK+r32;
  const unsigned*mrow=TOPK?(mk+((size_t)(b*64+qb*8+wid)*32)*64+r32*2):nullptr; const int sh4=4*hi; unsigned mw0=0u,mw1=0u; uint2 mwl=make_uint2(0u,0u);
  #define MLOAD(t) do{ if(TOPK){ mwl=*reinterpret_cast<const uint2*>(mrow+(size_t)(t)*64); } }while(0)
  #define MSHIFT() do{ if(TOPK){ mw0=mwl.x>>sh4; mw1=mwl.y>>sh4; asm volatile("":"+v"(mw0),"+v"(mw1)); } }while(0)
  #define MBIT(W,r) ((unsigned)__builtin_amdgcn_sbfe((int)(W),((r)&3)+8*((r)>>2),1))
  #define MAND(X,r,W) do{ if(TOPK){ X[r]=__uint_as_float(__float_as_uint(X[r])&MBIT(W,r)); } }while(0)
  MLOAD(0);
  #define CMASK(P0,P1,t) do{int jb_=(t)-(NT-4); if(jb_>=0)cmask(P0,P1,jb_,qrel,hi);}while(0)
  bool resc=false;
  #define START(P0,P1) do{ const float rm=rowmax(P0,P1); resc=false; \
    { const float dl=rm; mhat=fadd_s(mhat,dl); \
      _Pragma("unroll") for(int r=0;r<16;++r){P0[r]=fsub_s(P0[r],dl);P1[r]=fsub_s(P1[r],dl);} \
      if(!DV){ _Pragma("unroll") for(int r=0;r<16;++r)negm[r]=-mhat; asm volatile("":"+v"(negm)); } } \
    _Pragma("unroll") for(int r=0;r<16;++r)P0[r]=__builtin_amdgcn_exp2f(P0[r]); }while(0)
  #define RESC() do{ if(resc){ asm volatile("s_waitcnt lgkmcnt(0)":::"memory"); \
      _Pragma("unroll") for(int d_=0;d_<NO;++d_) _Pragma("unroll") for(int r=0;r<16;++r)o[d_][r]*=wsf[crow(r,hi)]; } }while(0)
  f32x16 pA0,pA1,pB0,pB1;
  int sl_prev=0,sl_cur=0,sl_next=SLOTB;
  #define ROT() do{sl_prev=sl_cur;sl_cur=sl_next;sl_next=(sl_next==(NSLOT-1)*SLOTB)?0:sl_next+SLOTB;}while(0)
  #define WAIT_BAR_KV() do{ if(DV){WAIT_BAR(3);}else{WAIT_BAR(2);} }while(0)
  #define WAIT_BAR_V() do{ if(DV){WAIT_BAR(2);}else{WAIT_BAR(1);} }while(0)
  DMA_K(2,2*SLOTB);
  WAIT_BAR(3);
  qkt(pA0,pA1,Kbase,qr,negm,r32,hi);    asm volatile("s_nop 15\n\ts_nop 7":"+v"(pA0),"+v"(pA1));CMASK(pA0,pA1,0);
  START(pA0,pA1);
  _Pragma("unroll") for(int r=0;r<16;++r)pA1[r]=__builtin_amdgcn_exp2f(pA1[r]);
  if(TOPK){ MSHIFT(); _Pragma("unroll") for(int r=0;r<16;++r){ MAND(pA0,r,mw0); MAND(pA1,r,mw1); } }
  WAIT_BAR(0);
  DMA_K(3,0);DMA_V(1,SLOTB);
  ROT();
  kload8(kf,kp0+sl_cur);
  WAIT_BAR_KV();
  s16x4 vlo[8],vhi[8]; u32x4 pw0,pw1,pw2,pw3;
  #define PKW(P,B) cvtpk_s(P[B],P[B+1])
  #define PAF(k) __builtin_bit_cast(bf16x8,pw##k)
  #define VFR(i) (bf16x8){vlo[i][0],vlo[i][1],vlo[i][2],vlo[i][3],vhi[i][0],vhi[i][1],vhi[i][2],vhi[i][3]}
  #define PIN(x) asm volatile("":"+v"(x))
  #define MX3(a,b,c) __builtin_fmaxf(__builtin_fmaxf((a),(b)),(c))
  #define GAPA(MF,A0,A1,A2,A3,W0,W1,PW) do{ MF; sacc2+=(f32x2_t){A0,A1}; sacc2+=(f32x2_t){A2,A3}; PIN(sacc2); W0; W1; PIN(PW); SBAR(); }while(0)
  #define EX(v) (DV?__builtin_amdgcn_exp2f((v)-mhat):__builtin_amdgcn_exp2f(v))
  #define QKC0 (DV?f32x16{}:negm)
  #define GAPB(MF,X,B,W) do{ MF; if(DV){ const f32x2_t t0_=(f32x2_t){X[B],X[B+1]}-(f32x2_t){mhat,mhat}, t1_=(f32x2_t){X[B+2],X[B+3]}-(f32x2_t){mhat,mhat}; X[B]=__builtin_amdgcn_exp2f(t0_.x); X[B+1]=__builtin_amdgcn_exp2f(t0_.y); X[B+2]=__builtin_amdgcn_exp2f(t1_.x); X[B+3]=__builtin_amdgcn_exp2f(t1_.y); } else { X[B]=EX(X[B]); X[B+1]=EX(X[B+1]); X[B+2]=EX(X[B+2]); X[B+3]=EX(X[B+3]); } MAND(X,B,W); MAND(X,B+1,W); MAND(X,B+2,W); MAND(X,B+3,W); PIN(X); SBAR(); }while(0)
  #define VRD(i) do{ vlo[i]=vtr(vp_+(((i)>>2)*4096+((i)&3)*1024)); vhi[i]=vtr(vp_+(((i)>>2)*4096+((i)&3)*1024+512)); }while(0)
  #define KRD(G,j) do{ if(G){ kload2(kf,kp0+sl_next,j); SBAR(); } }while(0)
  #define VRD2(i) do{ if(DV){ vlo[i]=vtr(vp_+(8192+((i)>>2)*4096+((i)&3)*1024)); vhi[i]=vtr(vp_+(8192+((i)>>2)*4096+((i)&3)*1024+512)); SBAR(); } }while(0)
  #define STEP(C0,C1,P0,P1,t,GK,GV,GL) do{ SBAR(); MLOAD(t); \
    const lds_cptr vp_=vp0+VSL*sl_prev; \
    VRD(0); SBAR(); f32x2_t sacc2={P0[0],P0[1]}; \
    GAPA(C0=__builtin_amdgcn_mfma_f32_32x32x16_bf16(kf[0],qr[0],QKC0,0,0,0), P0[2],P0[3],P0[4],P0[5],     pw0[0]=PKW(P0,0), pw0[1]=PKW(P0,2), pw0); \
    VRD(4); SBAR(); GAPA(C1=__builtin_amdgcn_mfma_f32_32x32x16_bf16(kf[1],qr[0],QKC0,0,0,0), P0[6],P0[7],P0[8],P0[9],     pw0[2]=PKW(P0,4), pw0[3]=PKW(P0,6), pw0); \
    VRD(1); SBAR(); GAPA(C0=__builtin_amdgcn_mfma_f32_32x32x16_bf16(kf[2],qr[1],C0,0,0,0),   P0[10],P0[11],P0[12],P0[13], pw1[0]=PKW(P0,8), pw1[1]=PKW(P0,10), pw1); \
    VRD(5); SBAR(); GAPA(C1=__builtin_amdgcn_mfma_f32_32x32x16_bf16(kf[3],qr[1],C1,0,0,0),   P0[14],P0[15],P1[0],P1[1],   pw1[2]=PKW(P0,12),pw1[3]=PKW(P0,14), pw1); \
    VRD(2); SBAR(); GAPA(C0=__builtin_amdgcn_mfma_f32_32x32x16_bf16(kf[4],qr[2],C0,0,0,0),   P1[2],P1[3],P1[4],P1[5],     pw2[0]=PKW(P1,0), pw2[1]=PKW(P1,2), pw2); \
    VRD(6); SBAR(); GAPA(C1=__builtin_amdgcn_mfma_f32_32x32x16_bf16(kf[5],qr[2],C1,0,0,0),   P1[6],P1[7],P1[8],P1[9],     pw2[2]=PKW(P1,4), pw2[3]=PKW(P1,6), pw2); \
    VRD(3); SBAR(); GAPA(C0=__builtin_amdgcn_mfma_f32_32x32x16_bf16(kf[6],qr[3],C0,0,0,0),   P1[10],P1[11],P1[12],P1[13], pw3[0]=PKW(P1,8), pw3[1]=PKW(P1,10), pw3); \
    VRD(7); SBAR(); GAPA(C1=__builtin_amdgcn_mfma_f32_32x32x16_bf16(kf[7],qr[3],C1,0,0,0),   P1[14],P1[15],0.f,0.f,       pw3[2]=PKW(P1,12),pw3[3]=PKW(P1,14), pw3); \
    l_reg+=sacc2.x+sacc2.y; \
    MSHIFT(); if(GK){DMA_K((t)+3,sl_cur);} if(GV){DMA_V((t)+1,sl_next);} \
    CMASK(C0,C1,t); \
    { float a=MX3(C0[0],C0[1],C1[0]),b=MX3(C0[2],C0[3],C1[1]); a=MX3(a,C1[2],C1[3]); \
      _Pragma("unroll") for(int r=4;r<16;r+=4){a=MX3(a,C0[r],C0[r+1]);b=MX3(b,C0[r+2],C0[r+3]);a=MX3(a,C1[r],C1[r+1]);b=MX3(b,C1[r+2],C1[r+3]);} \
      float rm=__builtin_fmaxf(a,b); { auto rr=__builtin_amdgcn_permlane32_swap(__float_as_uint(rm),__float_as_uint(rm),false,false); rm=__builtin_fmaxf(__uint_as_float(rr[0]),__uint_as_float(rr[1])); } \
      resc=false; \
      if(DV) rm-=mhat; \
      if(__builtin_expect(__any(rm>(float)THRL),0)){ const float dl=__builtin_fmaxf(rm,0.f); mhat+=dl; \
        if(!DV){ _Pragma("unroll") for(int r=0;r<16;++r){C0[r]-=dl;C1[r]-=dl;} \
        _Pragma("unroll") for(int r=0;r<16;++r)negm[r]=-mhat; asm volatile("":"+v"(negm)); } \
        const float f=__builtin_amdgcn_exp2f(-dl); l_reg*=f; if(hi==0)wsf[r32]=f; resc=true; } } \
    SBAR(); \
    GAPB(o[0]=__builtin_amdgcn_mfma_f32_32x32x16_bf16(PAF(0),VFR(0),o[0],0,0,0), C0,0,mw0); VRD2(0); \
    GAPB(o[1]=__builtin_amdgcn_mfma_f32_32x32x16_bf16(PAF(0),VFR(4),o[1],0,0,0), C0,4,mw0); VRD2(4); \
    KRD(GL,0); GAPB(o[0]=__builtin_amdgcn_mfma_f32_32x32x16_bf16(PAF(1),VFR(1),o[0],0,0,0), C0,8,mw0); VRD2(1); \
    KRD(GL,1); GAPB(o[1]=__builtin_amdgcn_mfma_f32_32x32x16_bf16(PAF(1),VFR(5),o[1],0,0,0), C0,12,mw0); VRD2(5); \
    KRD(GL,2); GAPB(o[0]=__builtin_amdgcn_mfma_f32_32x32x16_bf16(PAF(2),VFR(2),o[0],0,0,0), C1,0,mw1); VRD2(2); \
    KRD(GL,3); GAPB(o[1]=__builtin_amdgcn_mfma_f32_32x32x16_bf16(PAF(2),VFR(6),o[1],0,0,0), C1,4,mw1); VRD2(6); \
    GAPB(o[0]=__builtin_amdgcn_mfma_f32_32x32x16_bf16(PAF(3),VFR(3),o[0],0,0,0), C1,8,mw1); VRD2(3); \
    GAPB(o[1]=__builtin_amdgcn_mfma_f32_32x32x16_bf16(PAF(3),VFR(7),o[1],0,0,0), C1,12,mw1); VRD2(7); \
    if(DV){ \
      o[2]=__builtin_amdgcn_mfma_f32_32x32x16_bf16(PAF(0),VFR(0),o[2],0,0,0); o[3]=__builtin_amdgcn_mfma_f32_32x32x16_bf16(PAF(0),VFR(4),o[3],0,0,0); \
      o[2]=__builtin_amdgcn_mfma_f32_32x32x16_bf16(PAF(1),VFR(1),o[2],0,0,0); o[3]=__builtin_amdgcn_mfma_f32_32x32x16_bf16(PAF(1),VFR(5),o[3],0,0,0); \
      o[2]=__builtin_amdgcn_mfma_f32_32x32x16_bf16(PAF(2),VFR(2),o[2],0,0,0); o[3]=__builtin_amdgcn_mfma_f32_32x32x16_bf16(PAF(2),VFR(6),o[3],0,0,0); \
      o[2]=__builtin_amdgcn_mfma_f32_32x32x16_bf16(PAF(3),VFR(3),o[2],0,0,0); o[3]=__builtin_amdgcn_mfma_f32_32x32x16_bf16(PAF(3),VFR(7),o[3],0,0,0); SBAR(); } \
    }while(0)
  int t=1;
  #undef CMASK
  #define CMASK(P0,P1,t) do{}while(0)
  for(;t+5<NT;t+=2){
    STEP(pB0,pB1,pA0,pA1,t,true,true,true);     WAIT_BAR_KV(); RESC(); ROT();
    STEP(pA0,pA1,pB0,pB1,t+1,true,true,true);   WAIT_BAR_KV(); RESC(); ROT();
  }
  #undef CMASK
  #define CMASK(P0,P1,t) do{int jb_=(t)-(NT-4); if(jb_>=0)cmask(P0,P1,jb_,qrel,hi);}while(0)
  #define ENDW(tt) do{ if((tt)+3<NT){WAIT_BAR_KV();} else if((tt)+2<NT){WAIT_BAR_V();} else {WAIT_BAR(0);} }while(0)
  for(;t+3<NT;t+=2){
    STEP(pB0,pB1,pA0,pA1,t,(t+3<NT),(t+1<NT),(t+1<NT));       ENDW(t);   RESC(); ROT();
    STEP(pA0,pA1,pB0,pB1,t+1,(t+4<NT),(t+2<NT),(t+2<NT));     ENDW(t+1); RESC(); ROT();
  }
  STEP(pB0,pB1,pA0,pA1,NT-3,false,true,true);   ENDW(NT-3); RESC(); ROT();
  if(wid>=4){
    STEP(pA0,pA1,pB0,pB1,NT-2,false,true,true);   ENDW(NT-2); RESC(); ROT();
    if(wid>=6){ STEP(pB0,pB1,pA0,pA1,NT-1,false,false,false); RESC(); } else { pB0=pA0; pB1=pA1; sl_cur=sl_prev; }
  } else { DMA_V(NT-1,sl_next); ENDW(NT-2); ROT(); sl_cur=sl_next; }
  {
  { float sacc=pB0[0]+pB0[1]; _Pragma("unroll") for(int r=2;r<16;++r)sacc+=pB0[r]; _Pragma("unroll") for(int r=0;r<16;++r)sacc+=pB1[r]; l_reg+=sacc;
    pw0=(u32x4){PKW(pB0,0),PKW(pB0,2),PKW(pB0,4),PKW(pB0,6)};pw1=(u32x4){PKW(pB0,8),PKW(pB0,10),PKW(pB0,12),PKW(pB0,14)};pw2=(u32x4){PKW(pB1,0),PKW(pB1,2),PKW(pB1,4),PKW(pB1,6)};pw3=(u32x4){PKW(pB1,8),PKW(pB1,10),PKW(pB1,12),PKW(pB1,14)};
    SBAR(); pv<NO>(o,vb0+VSL*sl_cur,PAF(0),PAF(1),PAF(2),PAF(3)); }
  }
  #undef PKW
  #undef PAF
  #undef VFR
  #undef PIN
  #undef MX3
  #undef GAPA
  #undef GAPB
  #undef EX
  #undef QKC0
  #undef VRD
  #undef KRD
  #undef VRD2
  #undef STEP
  #undef ENDW
  {auto rr=__builtin_amdgcn_permlane32_swap(__float_as_uint(l_reg),__float_as_uint(l_reg),false,false);l_reg=__uint_as_float(rr[0])+__uint_as_float(rr[1]);}
  if(hi==0)wsf[32+r32]=l_reg;asm volatile("s_waitcnt lgkmcnt(0)":::"memory");
  float rli[16];
  #pragma unroll
  for(int r=0;r<16;++r)rli[r]=__builtin_amdgcn_rcpf(wsf[32+crow(r,hi)]);
  bf16*Ow=Oc+(rowbase+q0+wid*QBLK)*DM;
  if(DV&&cmb){
    bf16*stg=(bf16*)(shm+LO)+wid*2048; const bf16*Pw=Oprev+(rowbase+q0+wid*QBLK)*DM; const int ch=lane&7;
    float dd[2][4][8],ssq[4]={0.f,0.f,0.f,0.f},gg[2][8];
    #pragma unroll
    for(int hh=0;hh<2;++hh){ const float4 g0=*reinterpret_cast<const float4*>(subg+hh*64+ch*8),g1=*reinterpret_cast<const float4*>(subg+hh*64+ch*8+4);
      gg[hh][0]=g0.x*oscale;gg[hh][1]=g0.y*oscale;gg[hh][2]=g0.z*oscale;gg[hh][3]=g0.w*oscale;gg[hh][4]=g1.x*oscale;gg[hh][5]=g1.y*oscale;gg[hh][6]=g1.z*oscale;gg[hh][7]=g1.w*oscale; }
    #pragma unroll
    for(int hh=0;hh<2;++hh){
      u32x4 pv4[4];
      #pragma unroll
      for(int i=0;i<4;++i)pv4[i]=*reinterpret_cast<const u32x4*>(Pw+(long)(i*8+(lane>>3))*DM+hh*64+ch*8);
      #pragma unroll
      for(int r=0;r<16;++r){const int orow=crow(r,hi);
        #pragma unroll
        for(int d0=0;d0<2;++d0)stg[orow*64+d0*32+r32]=__float2bfloat16(o[2*hh+d0][r]*rli[r]);}
      asm volatile("s_waitcnt lgkmcnt(0)":::"memory");
      #pragma unroll
      for(int i=0;i<4;++i){const int row=i*8+(lane>>3); const u32x4 v=*(const u32x4*)(stg+row*64+ch*8); const u32x4 p=pv4[i];
        #pragma unroll
        for(int j=0;j<4;++j){ const float a0=__uint_as_float(p[j]<<16),a1=__uint_as_float(p[j]&0xffff0000u),b0=__uint_as_float(v[j]<<16),b1=__uint_as_float(v[j]&0xffff0000u);
          const float e0=a0-lam*b0,e1=a1-lam*b1; dd[hh][i][2*j]=e0; dd[hh][i][2*j+1]=e1; ssq[i]+=e0*e0+e1*e1; } }
      asm volatile("s_waitcnt lgkmcnt(0)":::"memory"); }
    #pragma unroll
    for(int i=0;i<4;++i){ float q=ssq[i];
      q+=__int_as_float(__builtin_amdgcn_ds_swizzle(__float_as_int(q),0x041F)); q+=__int_as_float(__builtin_amdgcn_ds_swizzle(__float_as_int(q),0x081F)); q+=__int_as_float(__builtin_amdgcn_ds_swizzle(__float_as_int(q),0x101F));
      const float rn=__builtin_amdgcn_rsqf(q*(1.0f/128.0f)+1e-6f); const int row=i*8+(lane>>3);
      #pragma unroll
      for(int hh=0;hh<2;++hh){ u32x4 w;
        #pragma unroll
        for(int j=0;j<4;++j)w[j]=cvtpk_s(dd[hh][i][2*j]*rn*gg[hh][2*j],dd[hh][i][2*j+1]*rn*gg[hh][2*j+1]);
        ATTN_STORE16(Ow+(long)row*DM+hh*64+ch*8,w); } }
  } else
  { bf16*stg=(bf16*)(shm+LO)+wid*2048;
    #pragma unroll
    for(int hh=0;hh<NO/2;++hh){
      #pragma unroll
      for(int r=0;r<16;++r){const int orow=crow(r,hi);
        #pragma unroll
        for(int d0=0;d0<2;++d0)stg[orow*64+d0*32+r32]=__float2bfloat16(o[2*hh+d0][r]*rli[r]);}
      asm volatile("s_waitcnt lgkmcnt(0)":::"memory");
      #pragma unroll
      for(int i=0;i<4;++i){const int row=i*8+(lane>>3),ch=lane&7; const u32x4 v=*(const u32x4*)(stg+row*64+ch*8); ATTN_STORE16(Ow+(long)row*DM+hh*64+ch*8,v);}
      asm volatile("s_waitcnt lgkmcnt(0)":::"memory"); } }
  asm volatile("s_waitcnt lgkmcnt(0)\n\ts_barrier":::"memory");
  #undef DMA_K
  #undef DMA_V
  #undef CMASK
  #undef START
  #undef RESC
  #undef ROT
  #undef WAIT_BAR_KV
  #undef WAIT_BAR_V
  #undef MLOAD
  #undef MSHIFT
  #undef MBIT
  #undef MAND
}
constexpr int ATTN_LDS_BYTES=LDS_BYTES;
#undef SBAR
#undef WAIT_BAR
}
#define GAS __attribute__((address_space(1)))
#define LAS __attribute__((address_space(3)))
typedef unsigned short bf16;
typedef unsigned v4u __attribute__((ext_vector_type(4)));
typedef float f32x4 __attribute__((ext_vector_type(4)));
typedef short bf16x8 __attribute__((ext_vector_type(8)));
typedef GAS unsigned gu32;
typedef GAS unsigned long long gu64;
#define RLX_AGENT __ATOMIC_RELAXED, __HIP_MEMORY_SCOPE_AGENT
#define LDS_WAIT() asm volatile("s_waitcnt lgkmcnt(0)" ::: "memory")
#define VM_WAIT() asm volatile("s_waitcnt vmcnt(0)" ::: "memory")
__device__ __forceinline__ unsigned long long rt() { return __builtin_amdgcn_s_memrealtime(); }
__device__ __forceinline__ unsigned f2bf(float f) { unsigned u = __builtin_bit_cast(unsigned, f); return (u + 0x7fffu + ((u >> 16) & 1u)) >> 16; }
__device__ __forceinline__ unsigned pk2(float lo, float hi) { return f2bf(lo) | (f2bf(hi) << 16); }

#define XB_TMO      128
#define XB_XCNT(j)  (256  + 64 * (j))
#define XB_XSUB(j)  (1280 + 64 * (j))
#define XB_XGEN(j)  (2304 + 64 * (j))
#define XB_TOP      3328
#define XB_TOPGEN   3392
#define XCD_BAR_WORDS 3456
#define XB_SPIN_CAP (1u << 18)

__device__ __forceinline__ unsigned xb_ld(unsigned* p)              { return __hip_atomic_load(p, __ATOMIC_RELAXED, __HIP_MEMORY_SCOPE_AGENT); }
__device__ __forceinline__ unsigned xb_add(unsigned* p, unsigned v) { return __hip_atomic_fetch_add(p, v, __ATOMIC_RELAXED, __HIP_MEMORY_SCOPE_AGENT); }
__device__ __forceinline__ unsigned xb_xcc_id() { return (unsigned)__builtin_amdgcn_s_getreg((3 << 11) | 20) & 0xFu; }
#define XB_SPIN(cond, bar) do { unsigned _sp = 0; while (cond) { __builtin_amdgcn_s_sleep(1); \
    if ((++_sp & 255u) == 0u) { if (xb_ld(&(bar)[XB_TMO])) break; if (_sp > XB_SPIN_CAP) { atomicAdd(&(bar)[XB_TMO], 1u); break; } } } } while (0)

struct XcdBarrier {
    unsigned* bar; unsigned x;
    volatile LAS unsigned* st;
};

__device__ __forceinline__ XcdBarrier xcd_barrier_post(unsigned* bar, volatile LAS unsigned* st) {
    XcdBarrier b; b.bar = bar; b.x = xb_xcc_id(); b.st = st;
    if (threadIdx.x == 0) (void)xb_add(&bar[XB_XCNT(b.x)], 1u);
    return b;
}
__device__ __forceinline__ void xcd_barrier_complete(unsigned* bar, unsigned x, unsigned& nloc, unsigned& nx) {
    const unsigned G = gridDim.x * gridDim.y * gridDim.z;
    unsigned sum, cnt, mine, sp = 0u;
    for (;;) {
        sum = 0u; cnt = 0u; mine = 0u;
#pragma unroll
        for (unsigned j = 0; j < 16; ++j) { const unsigned c = xb_ld(&bar[XB_XCNT(j)]); sum += c; cnt += (c > 0u) ? 1u : 0u; mine = (j == x) ? c : mine; }
        if (sum == G) break;
        __builtin_amdgcn_s_sleep(1);
        if ((++sp & 255u) == 0u) { if (xb_ld(&bar[XB_TMO])) break; if (sp > XB_SPIN_CAP) { atomicAdd(&bar[XB_TMO], 1u); break; } }
    }
    nloc = mine > 0u ? mine : 1u; nx = cnt > 0u ? cnt : 1u;
}

__device__ __forceinline__ void xcd_barrier(const XcdBarrier& b, const bool leader_thread  ) {
    asm volatile("s_waitcnt vmcnt(0)" ::: "memory");
    __syncthreads();
    if (leader_thread) {
        unsigned* bar = b.bar;
        __builtin_amdgcn_s_waitcnt(0);
        unsigned nloc = b.st[0], nx = b.st[1];
        if (nloc == 0u) { xcd_barrier_complete(bar, b.x, nloc, nx); b.st[0] = nloc; b.st[1] = nx; }
        const unsigned old = xb_add(&bar[XB_XSUB(b.x)], 1u);
        const unsigned gen = old / nloc;
        if (old + 1u == (gen + 1u) * nloc) {
            __builtin_amdgcn_fence(__ATOMIC_RELEASE, "agent");
            asm volatile("s_waitcnt vmcnt(0)" ::: "memory");
            const unsigned og = xb_add(&bar[XB_TOP], 1u);
            const unsigned tg = og / nx;
            if (og + 1u == (tg + 1u) * nx) xb_add(&bar[XB_TOPGEN], 1u);
            else XB_SPIN(xb_ld(&bar[XB_TOPGEN]) == tg, bar);
            __builtin_amdgcn_fence(__ATOMIC_ACQUIRE, "agent");
            xb_add(&bar[XB_XGEN(b.x)], 1u);
            asm volatile("s_waitcnt vmcnt(0)" ::: "memory");
        } else {
            XB_SPIN(xb_ld(&bar[XB_XGEN(b.x)]) == gen, bar);
            __builtin_amdgcn_fence(__ATOMIC_ACQUIRE, "agent");
            asm volatile("s_waitcnt vmcnt(0)" ::: "memory");
        }
    }
    __syncthreads();
}
namespace topk {
#define TK_LAS __attribute__((address_space(3)))
typedef short bf16x8 __attribute__((ext_vector_type(8)));
typedef float f32x16 __attribute__((ext_vector_type(16)));
typedef float f32x4 __attribute__((ext_vector_type(4)));
typedef float f32x2 __attribute__((ext_vector_type(2)));
__device__ __forceinline__ unsigned fkey(float s) { const unsigned uu = __float_as_uint(s); return uu ^ ((unsigned)((int)uu >> 31) | 0x80000000u); }
__device__ __forceinline__ float kfloat(unsigned k) { return __uint_as_float((k & 0x80000000u) ? (k ^ 0x80000000u) : ~k); }
typedef unsigned u32x4 __attribute__((ext_vector_type(4)));
typedef unsigned short bf16_t;
constexpr int KSEL = 256;
__device__ __forceinline__ int crow0(int r) { return (r & 3) + 8 * (r >> 2); }
__device__ __forceinline__ unsigned half_sum(unsigned c) { auto rr = __builtin_amdgcn_permlane32_swap(c, c, false, false); return rr[0] + rr[1]; }
__device__ __forceinline__ unsigned half_or(unsigned c) { auto rr = __builtin_amdgcn_permlane32_swap(c, c, false, false); return rr[0] | rr[1]; }

__device__ __forceinline__ void unit(int b, int g, const bf16_t* __restrict__ IQ, const bf16_t* __restrict__ IK, const float* __restrict__ IW, unsigned* __restrict__ MASK, TK_LAS unsigned char* lds, const int wave_in) {
    int lane_; asm volatile("v_mbcnt_lo_u32_b32 %0, -1, 0\n\tv_mbcnt_hi_u32_b32 %0, -1, %0" : "=v"(lane_));
    const int lane = lane_, r32 = lane & 31, hi = lane >> 5;
    const int w = wave_in, tid = w * 64 + lane;
    const int nt = g / 2 + 1;
    const int ntb = 4 * (g / 8) + 4;
    const int q = 32 * g + r32;
    const size_t rowq = (size_t)b * 2048 + q;
    const bool dotopk = (g >= 8);
    TK_LAS unsigned* cnt = (TK_LAS unsigned*)lds;
    TK_LAS unsigned* flag = (TK_LAS unsigned*)(lds + 2048);
    f32x2 sc[4][2][8];
    unsigned T = 0u, X = 2047u;
    if (dotopk) {
        if (tid == 0) flag[0] = 0u;
        const f32x4 wq = *(const f32x4*)(IW + rowq * 4);
        TK_LAS unsigned char* qlds = lds + 4096;
        { const bf16_t* qg = IQ + ((size_t)b * 2048 + 32 * g) * 256;
#pragma unroll
          for (int i = 0; i < 2; ++i) { const int pc = tid + 512 * i, row = pc >> 5, c16 = pc & 31; const u32x4 v = *(const u32x4*)(qg + row * 256 + c16 * 8); *(TK_LAS u32x4*)(qlds + row * 528 + c16 * 16) = v; } }
        __syncthreads();
        const TK_LAS unsigned char* qrd = qlds + r32 * 528 + hi * 16;
        const bf16_t* kbase = IK + (size_t)b * (2048 * 64) + lane * 8;
        bf16x8 kf[2][4];
        if (w < nt) {
#pragma unroll
            for (int d0 = 0; d0 < 4; ++d0) kf[0][d0] = *(const bf16x8*)(kbase + (size_t)(2 * w) * 2048 + d0 * 512);
        }
#pragma unroll
        for (int st = 0; st < 8; ++st) {
            const int jj = st >> 1, p = st & 1, tile = w + 8 * jj;
            if (st + 1 < 8) { const int jn = (st + 1) >> 1, pn = (st + 1) & 1, tn = w + 8 * jn;
                if (tn < nt) {
#pragma unroll
                    for (int d0 = 0; d0 < 4; ++d0) kf[(st + 1) & 1][d0] = *(const bf16x8*)(kbase + (size_t)(2 * tn + pn) * 2048 + d0 * 512);
                } }
            if (tile < nt) {
                f32x16 s = {0.f, 0.f, 0.f, 0.f, 0.f, 0.f, 0.f, 0.f, 0.f, 0.f, 0.f, 0.f, 0.f, 0.f, 0.f, 0.f};
#pragma unroll
                for (int h = 0; h < 4; ++h) {
                    f32x16 pp = {0.f, 0.f, 0.f, 0.f, 0.f, 0.f, 0.f, 0.f, 0.f, 0.f, 0.f, 0.f, 0.f, 0.f, 0.f, 0.f};
#pragma unroll
                    for (int d0 = 0; d0 < 4; ++d0) { const bf16x8 qf = *(const TK_LAS bf16x8*)(qrd + h * 128 + d0 * 32); pp = __builtin_amdgcn_mfma_f32_32x32x16_bf16(kf[st & 1][d0], qf, pp, 0, 0, 0); }
                    const float wh = wq[h];
#pragma unroll
                    for (int r = 0; r < 16; ++r) s[r] = __builtin_fmaf(wh, __builtin_fmaxf(pp[r], 0.f), s[r]);
                }
#pragma unroll
                for (int r = 0; r < 8; ++r) {
                    const float kp0 = (float)(64 * tile + 32 * p + crow0(2 * r) + 4 * hi + 1) * -0x1p-100f, kp1 = (float)(64 * tile + 32 * p + crow0(2 * r + 1) + 4 * hi + 1) * -0x1p-100f;
                    sc[jj][p][r] = (f32x2){s[2 * r] == 0.f ? kp0 : s[2 * r], s[2 * r + 1] == 0.f ? kp1 : s[2 * r + 1]}; }
                if (tile == nt - 1) {
#pragma unroll
                    for (int r = 0; r < 16; ++r) { const int kpos = 64 * tile + 32 * p + crow0(r) + 4 * hi; if (kpos > q) sc[jj][p][r >> 1][r & 1] = -INFINITY; }
                }
            } else {
#pragma unroll
                for (int r = 0; r < 8; ++r) sc[jj][p][r] = (f32x2){-INFINITY, -INFINITY};
            }
        }
        int par = 0;
        unsigned prefix = 0u, ge = 0u;
#define TK_REDUCE(c, tot) do { const unsigned c_ = half_sum(c); if (hi == 0) cnt[par * 256 + r32 * 8 + w] = c_; __syncthreads(); \
            const u32x4 a_ = *(const TK_LAS u32x4*)(cnt + par * 256 + r32 * 8), b_ = *(const TK_LAS u32x4*)(cnt + par * 256 + r32 * 8 + 4); \
            tot = ((a_.x + a_.y) + (a_.z + a_.w)) + ((b_.x + b_.y) + (b_.z + b_.w)); par ^= 1; } while (0)
        const f32x2 big2 = {0x1p100f, 0x1p100f};
        for (int bit = 31; bit >= 0; --bit) {
            const unsigned cand = prefix | (1u << bit);
            const float addend = (cand == 0x80000000u) ? 1.0f : -kfloat(cand - 1u) * 0x1p100f;
            const f32x2 add2 = {addend, addend};
            f32x2 c2 = {0.f, 0.f}, c3 = {0.f, 0.f};
#pragma unroll
            for (int jj = 0; jj < 4; ++jj) if (w + 8 * jj < nt) {
#pragma unroll
                for (int p = 0; p < 2; ++p)
#pragma unroll
                    for (int r = 0; r < 8; r += 2) { f32x2 i0, i1;
                        asm("v_pk_fma_f32 %2, %4, %6, %7 op_sel_hi:[1,0,0] clamp\n\tv_pk_fma_f32 %3, %5, %6, %7 op_sel_hi:[1,0,0] clamp\n\tv_pk_add_f32 %0, %0, %2\n\tv_pk_add_f32 %1, %1, %3"
                            : "+v"(c2), "+v"(c3), "=&v"(i0), "=&v"(i1) : "v"(sc[jj][p][r]), "v"(sc[jj][p][r + 1]), "v"(big2), "v"(add2)); }
            }
            c2 += c3;
            const unsigned c = (unsigned)(c2.x + c2.y);
            unsigned tot; TK_REDUCE(c, tot);
            if (tot >= (unsigned)KSEL) { prefix = cand; ge = tot; }
            if (__all(ge == (unsigned)KSEL)) break;
        }
        T = prefix;
#pragma unroll
        for (int jj = 0; jj < 4; ++jj) if (w + 8 * jj < nt) {
#pragma unroll
            for (int p = 0; p < 2; ++p)
#pragma unroll
                for (int r = 0; r < 8; ++r) { f32x2 v = sc[jj][p][r]; v.x = __uint_as_float(fkey(v.x)); v.y = __uint_as_float(fkey(v.y)); sc[jj][p][r] = v; }
        }
#define TK_KEY(jj, p, r) __float_as_uint(sc[jj][p][(r) >> 1][(r) & 1])
        if (ge != (unsigned)KSEL) flag[0] = 1u;
        __syncthreads();
        const bool tie = flag[0] != 0u;
        if (tie) {
            unsigned c = 0u;
#pragma unroll
            for (int jj = 0; jj < 4; ++jj) if (w + 8 * jj < nt) {
#pragma unroll
                for (int p = 0; p < 2; ++p)
#pragma unroll
                    for (int r = 0; r < 16; ++r) c += (TK_KEY(jj, p, r) == T) ? 1u : 0u;
            }
            unsigned ceq; TK_REDUCE(c, ceq);
            const unsigned need = (unsigned)KSEL - (ge - ceq);
            unsigned px = 0u;
            for (int bit = 10; bit >= 0; --bit) {
                const unsigned cand = px | (1u << bit);
                unsigned c2 = 0u;
#pragma unroll
                for (int jj = 0; jj < 4; ++jj) if (w + 8 * jj < nt) {
#pragma unroll
                    for (int p = 0; p < 2; ++p)
#pragma unroll
                        for (int r = 0; r < 16; ++r) { const unsigned kpos = (unsigned)(64 * (w + 8 * jj) + 32 * p + crow0(r) + 4 * hi); c2 += (TK_KEY(jj, p, r) == T && kpos < cand) ? 1u : 0u; }
                }
                unsigned tot; TK_REDUCE(c2, tot);
                if (tot < need) px = cand;
            }
            X = px;
        }
#undef TK_REDUCE
    }
#pragma unroll
    for (int jj = 0; jj < 4; ++jj) {
        const int tile = w + 8 * jj;
        if (tile < ntb) {
            unsigned w0 = 0u, w1 = 0u;
            if (tile < nt) {
#pragma unroll
                for (int r = 0; r < 16; ++r) {
                    const int kpos = 64 * tile + crow0(r) + 4 * hi;
                    bool s0, s1;
                    if (dotopk) { const unsigned k0 = TK_KEY(jj, 0, r), k1 = TK_KEY(jj, 1, r);
                        s0 = (k0 > T) || (k0 == T && (unsigned)kpos <= X); s1 = (k1 > T) || (k1 == T && (unsigned)(kpos + 32) <= X); }
                    else { s0 = kpos <= q; s1 = kpos + 32 <= q; }
                    w0 |= (s0 ? 1u : 0u) << crow0(r); w1 |= (s1 ? 1u : 0u) << crow0(r);
                }
                w0 <<= 4 * hi; w1 <<= 4 * hi;
                w0 = half_or(w0); w1 = half_or(w1);
            }
            if (hi == 0) *(uint2*)(MASK + (((size_t)(b * 64 + g) * 32 + tile) * 64 + r32 * 2)) = make_uint2(w0, w1);
        }
    }
    __syncthreads();
}
#undef TK_LAS
#undef TK_KEY
}
constexpr int NB = 32, SEQ = 2048, DMODEL = 1024, M = NB * SEQ;
constexpr int NIN = 5632;
constexpr int DIN = 5444;
constexpr int FF = 2816, NF1 = 2 * FF;
constexpr int NLAYER = 2, NPHASE = 1 + 8 * NLAYER;
constexpr float LAM_INIT0 = 0.2f, LAM_INIT1 = 0.35550906759096934f;
#ifndef MK_PER_PHASE
#define MK_PER_PHASE 0
#endif

constexpr size_t MiB = 1u << 20;
constexpr size_t WS_CTL = 0, CTL_ZERO_BYTES = 64 * 1024;
constexpr size_t WS_W = 2 * MiB, W_LAYER = 32 * MiB;
constexpr size_t OFF_IN = 0, OFF_UA = 11 * MiB, OFF_UB = 12 * MiB, OFF_O = 13 * MiB, OFF_F1 = 15 * MiB, OFF_F2 = 26 * MiB;
constexpr size_t WS_SS = 66 * MiB;
constexpr size_t WS_ROPE = 74 * MiB;
constexpr size_t WS_MASK = 90 * MiB, MASK_LAYER = 16 * MiB;
constexpr size_t WS_IW = 122 * MiB, WS_IK = 124 * MiB, WS_IQ = 132 * MiB;
constexpr size_t WS_XB = 164 * MiB;
constexpr size_t WS_AQ = 292 * MiB, WS_AK = 356 * MiB, WS_AV = 420 * MiB, WS_BQ = 484 * MiB, WS_BK = 548 * MiB, WS_BV = 612 * MiB, WS_G = 676 * MiB, WS_END = 932 * MiB;
constexpr size_t WS_YA = WS_AQ, WS_YB = WS_BQ, WS_TMP = WS_AK, WS_MRG = WS_BK, WS_ACT = WS_AQ;
static_assert(WS_ACT + (size_t)M * FF * 2 <= WS_G, "ACT overlay must stay clear of the gates");

constexpr int NWAVES = 8;
constexpr int RING_BYTES = 131072, LDSCTL_OFF = RING_BYTES, MISC_OFF = LDSCTL_OFF + 320, LDS_BYTES = 147456;
constexpr int CW_BAR = 4096;
constexpr int SCL_OFF = 131072 + 1024 + 256;

struct TrItem { const float* W; const float* gain; bf16* WT; int Nsrc, k0, c0, nv, K, p0; };
__device__ __forceinline__ void tr_load(const TrItem& t, f32x4 (&v)[8], float (&gk)[8], int lane) {
    const int c4 = lane & 7, r8 = lane >> 3; const bool ok = 4 * c4 < t.nv;
#pragma unroll
    for (int i = 0; i < 8; ++i) { const int kk = 8 * i + r8; v[i] = (f32x4){0.f, 0.f, 0.f, 0.f};
        if (ok) v[i] = *(const GAS f32x4*)(t.W + (size_t)(t.k0 + kk) * t.Nsrc + t.c0 + 4 * c4);
        gk[i] = t.gain ? t.gain[t.k0 + kk] : 1.0f; }
}
__device__ __forceinline__ void tr_store(const TrItem& t, const f32x4 (&v)[8], const float (&gk)[8], LAS float* scr, int lane) {
    const int c4 = lane & 7, r8 = lane >> 3;
#pragma unroll
    for (int i = 0; i < 8; ++i) { const int kk = 8 * i + r8; LAS float* s_ = scr + kk * 33 + 4 * c4; s_[0] = v[i].x * gk[i]; s_[1] = v[i].y * gk[i]; s_[2] = v[i].z * gk[i]; s_[3] = v[i].w * gk[i]; }
    LDS_WAIT(); asm volatile("" ::: "memory");
    const int c = lane & 7;
#pragma unroll
    for (int jj = 0; jj < 4; ++jj) { const int n = (lane >> 3) + 8 * jj; const LAS float* s = scr + (8 * c) * 33 + n;
        v4u o; o.x = pk2(s[0 * 33], s[1 * 33]); o.y = pk2(s[2 * 33], s[3 * 33]); o.z = pk2(s[4 * 33], s[5 * 33]); o.w = pk2(s[6 * 33], s[7 * 33]);
        *(GAS v4u*)(t.WT + (size_t)(t.p0 + n) * t.K + t.k0 + 8 * c) = o; }
    LDS_WAIT(); asm volatile("" ::: "memory");
}
__device__ __forceinline__ void src_in(int tile, int s, int bj, int& c0, int& nv) {
    const int d0 = 32 * bj; nv = 32;
    if (tile < 2) c0 = (tile * 4 + s) * 64 + d0;
    else if (tile < 4) c0 = 512 + ((tile - 2) * 4 + s) * 64 + d0;
    else if (tile < 6) c0 = 1024 + ((tile - 4) * 4 + s) * 64 + d0;
    else if (tile == 6) c0 = 1536 + s * 64 + d0;
    else if (tile == 7) { if (s == 0) c0 = 1792 + d0; else if (s == 1 && bj == 0) { c0 = 1856; nv = 4; } else { c0 = 0; nv = 0; } }
    else if (tile < 10) c0 = 1860 + ((tile - 8) * 4 + s) * 64 + d0;
    else if (tile < 12) c0 = 2372 + ((tile - 10) * 4 + s) * 64 + d0;
    else if (tile < 14) c0 = 2884 + ((tile - 12) * 4 + s) * 64 + d0;
    else c0 = 3396 + ((tile - 14) * 4 + s) * 64 + d0;
}
__device__ __forceinline__ float wave_sum(float v) {
    v += __int_as_float(__builtin_amdgcn_ds_swizzle(__float_as_int(v), 0x041F)); v += __int_as_float(__builtin_amdgcn_ds_swizzle(__float_as_int(v), 0x081F));
    v += __int_as_float(__builtin_amdgcn_ds_swizzle(__float_as_int(v), 0x101F)); v += __int_as_float(__builtin_amdgcn_ds_swizzle(__float_as_int(v), 0x201F));
    v += __int_as_float(__builtin_amdgcn_ds_swizzle(__float_as_int(v), 0x401F)); return epi::sum_halves(v);
}
__device__ __forceinline__ int lane_id_asm() { int l; asm volatile("v_mbcnt_lo_u32_b32 %0, -1, 0\n\tv_mbcnt_hi_u32_b32 %0, -1, %0" : "=v"(l)); return l; }
__constant__ double INV_FREQ[32] = {1.0, 0.7498942093324559, 0.5623413251903491, 0.4216965034285822, 0.31622776601683794, 0.23713737056616552, 0.1778279410038923, 0.1333521432163324, 0.1, 0.07498942093324558,
    0.05623413251903491, 0.042169650342858224, 0.03162277660168379, 0.023713737056616554, 0.01778279410038923, 0.01333521432163324, 0.01, 0.007498942093324558, 0.005623413251903491, 0.004216965034285823,
    0.0031622776601683794, 0.0023713737056616554, 0.0017782794100389228, 0.001333521432163324, 0.001, 0.0007498942093324559, 0.0005623413251903491, 0.00042169650342858224, 0.00031622776601683794,
    0.00023713737056616554, 0.00017782794100389227, 0.0001333521432163324};
__device__ __forceinline__ void sincos_d(double x, float& c, float& s) {
    const double n = __builtin_rint(x * 0.15915494309189535);
    double r = __builtin_fma(-n, 6.283185307179586, x); r = __builtin_fma(-n, 2.4492935982947064e-16, r);
    const double r2 = r * r;
    double ts = r, ss = r, tc = 1.0, cc = 1.0;
#pragma unroll
    for (int k = 1; k <= 14; ++k) { ts *= r2 * (-1.0 / (double)((2 * k) * (2 * k + 1))); ss += ts; tc *= r2 * (-1.0 / (double)((2 * k - 1) * (2 * k))); cc += tc; }
    c = (float)cc; s = (float)ss;
}

struct Args { const float* in[18]; float* out; unsigned char* ws; int ph_lo, ph_hi; };

__device__ __forceinline__ void p0_prologue(unsigned char* ws, LAS unsigned char* ldsb, int vcu, int G, int wave, int lane) {
    LAS float* scr = (LAS float*)(ldsb + wave * 16384);
    const int gw = vcu * NWAVES + wave, NGW = G * NWAVES;
    constexpr int I_IN = 16 * 176, I_U = 8 * 32, I_O = 16 * 32, I_F1 = 16 * 176, I_F2 = 44 * 32, I_L = I_IN + 2 * I_U + I_O + I_F1 + I_F2;
    for (int ph_ = 0; ph_ < 2; ++ph_) {
    if (((ph_ ^ (wave >> 2)) & 1) == 0) {
    auto decode = [&](int it, TrItem& t) {
        const int l = it / I_L; int r = it - l * I_L;
        unsigned char* wl = ws + WS_W + (size_t)l * W_LAYER;
        if (r < I_IN) { const int kb = r / 176, pb = r - kb * 176, tile = pb >> 3, wb = pb & 7; int c0, nv; src_in(tile, wb & 3, wb >> 2, c0, nv);
            t = TrItem{epi::lds_inptr(ldsb, 3) + (size_t)l * DMODEL * DIN, epi::lds_inptr(ldsb, 2) + l * DMODEL, (bf16*)(wl + OFF_IN), DIN, 64 * kb, c0, nv, DMODEL, 32 * pb}; return; }
        r -= I_IN;
        if (r < I_U) { const int kb = r >> 5, nb = r & 31; t = TrItem{epi::lds_inptr(ldsb, 12) + (size_t)l * 512 * 1024, nullptr, (bf16*)(wl + OFF_UA), 1024, 64 * kb, 32 * nb, 32, 512, 32 * nb}; return; }
        r -= I_U;
        if (r < I_U) { const int kb = r >> 5, nb = r & 31; t = TrItem{epi::lds_inptr(ldsb, 13) + (size_t)l * 512 * 1024, nullptr, (bf16*)(wl + OFF_UB), 1024, 64 * kb, 32 * nb, 32, 512, 32 * nb}; return; }
        r -= I_U;
        if (r < I_O) { const int kb = r >> 5, nb = r & 31; t = TrItem{epi::lds_inptr(ldsb, 14) + (size_t)l * 1024 * 1024, nullptr, (bf16*)(wl + OFF_O), 1024, 64 * kb, 32 * nb, 32, 1024, 32 * nb}; return; }
        r -= I_O;
        if (r < I_F1) { const int kb = r / 176, pb = r - kb * 176, tile = pb >> 3, wb = pb & 7; const int c0 = 128 * tile + 32 * (wb & 3) + ((wb >> 2) ? FF : 0);
            t = TrItem{epi::lds_inptr(ldsb, 16) + (size_t)l * DMODEL * NF1, epi::lds_inptr(ldsb, 15) + l * DMODEL, (bf16*)(wl + OFF_F1), NF1, 64 * kb, c0, 32, DMODEL, 32 * pb}; return; }
        r -= I_F1;
        { const int kb = r >> 5, nb = r & 31; t = TrItem{epi::lds_inptr(ldsb, 17) + (size_t)l * FF * 1024, nullptr, (bf16*)(wl + OFF_F2), 1024, 64 * kb, 32 * nb, 32, FF, 32 * nb}; }
    };
    { TrItem cur, nxt; f32x4 va[8], vb[8]; float ga[8], gb[8];
      int it = gw; if (it < NLAYER * I_L) { decode(it, cur); tr_load(cur, va, ga, lane); }
      for (; it < NLAYER * I_L; it += NGW) { const bool hn = it + NGW < NLAYER * I_L;
          if (hn) { decode(it + NGW, nxt); tr_load(nxt, vb, gb, lane); }
          tr_store(cur, va, ga, scr, lane);
          if (hn) { cur = nxt;
#pragma unroll
              for (int i = 0; i < 8; ++i) { va[i] = vb[i]; ga[i] = gb[i]; } } } }
#if defined(DBG_FILL)
    { unsigned* fp = (unsigned*)(ws + DBG_FILL); for (size_t i = (size_t)gw * 64 + lane; i < (size_t)32 * MiB; i += (size_t)NGW * 64) fp[i] = 0x3f803f80u + ((unsigned)i & 0x3fu) * 0x00010001u; }
#endif
    } else {
    const float* x = epi::lds_inptr(ldsb, 0); const int* pos = (const int*)epi::lds_inptr(ldsb, 1);
    bf16* XB = (bf16*)(ws + WS_XB); float* SS0 = (float*)(ws + WS_SS); float* ROPE = (float*)(ws + WS_ROPE);
    for (int m0 = gw; m0 < M; m0 += 4 * NGW) {
        f32x4 v[4][4]; float s[4];
#pragma unroll
        for (int u = 0; u < 4; ++u) { const int m = m0 + u * NGW; const GAS f32x4* xr = (const GAS f32x4*)(x + (size_t)(m < M ? m : gw) * DMODEL) + lane;
#pragma unroll
            for (int j = 0; j < 4; ++j) v[u][j] = xr[64 * j]; }
#pragma unroll
        for (int u = 0; u < 4; ++u) { float t = 0.f;
#pragma unroll
            for (int j = 0; j < 4; ++j) t += (v[u][j].x * v[u][j].x + v[u][j].y * v[u][j].y) + (v[u][j].z * v[u][j].z + v[u][j].w * v[u][j].w);
            s[u] = wave_sum(t); }
#pragma unroll
        for (int u = 0; u < 4; ++u) { const int m = m0 + u * NGW; if (m < M) {
            GAS unsigned long long* o8 = (GAS unsigned long long*)(XB + (size_t)m * DMODEL) + lane;
#pragma unroll
            for (int j = 0; j < 4; ++j) o8[64 * j] = (unsigned long long)pk2(v[u][j].x, v[u][j].y) | ((unsigned long long)pk2(v[u][j].z, v[u][j].w) << 32);
            if (lane < 16) SS0[(size_t)m * 16 + lane] = (lane == 0) ? s[u] : 0.f; } }
    }
    { const int fi = lane & 31; int m = gw + (lane >> 5) * NGW; int pn_ = (m < M) ? pos[m] : 0;
      for (; m - (lane >> 5) * NGW < M; m += 2 * NGW) { const int pc = pn_; const int mn = m + 2 * NGW; if (mn < M) pn_ = pos[mn];
        if (m < M) { const double ang = (double)pc * INV_FREQ[fi]; float c, sn; sincos_d(ang, c, sn); const epi::h16x2 hh = {(_Float16)c, (_Float16)sn}; ((unsigned*)ROPE)[(size_t)m * 32 + fi] = __builtin_bit_cast(unsigned, hh); } } }
    }
    }
}
static_assert(epi::EI_SS == WS_SS && epi::EI_ROPE == WS_ROPE && epi::EI_IW == WS_IW && epi::EI_IK == WS_IK && epi::EI_IQ == WS_IQ && epi::EI_AQ == WS_AQ && epi::EI_AK == WS_AK && epi::EI_AV == WS_AV && epi::EI_BQ == WS_BQ && epi::EI_BK == WS_BK && epi::EI_BV == WS_BV && epi::EI_G == WS_G && epi::PTR_OFF >= MISC_OFF + 128 && epi::PTR_OFF + 18 * 8 <= SCL_OFF && SCL_OFF + 64 <= epi::RSTD_OFF && epi::RSTD_OFF + 64 + epi::RSTD_SLOTS * 1024 <= LDS_BYTES, "EpiIn offsets vs the d_ws / LDS map");
#define VNATB(b_, h_) ((long)((b_) * 4 + (h_)) * (2048 * 128) - (long)(b_) * 2048 * 512)
#define KNAT(b_, hs_) ((long)((b_) * 8 + (hs_)) * (2048 * 64) - (long)(b_) * 2048 * 512)
__global__ void __launch_bounds__(NWAVES * 64, 2) mega_fwd(Args args) {
    extern __shared__ __attribute__((aligned(16))) unsigned char lds[];
    LAS unsigned char* ldsb = (LAS unsigned char*)lds;
    volatile LAS unsigned* MISC = (volatile LAS unsigned*)(ldsb + MISC_OFF);
    const int tid = threadIdx.x; int wave_ = __builtin_amdgcn_readfirstlane(tid >> 6); asm volatile("" : "+s"(wave_)); const int wave = wave_;
    const int G = gridDim.x; const int bx = blockIdx.x;
    const int vcu = (G % 8 == 0) ? (bx % 8) * (G / 8) + bx / 8 : bx;
    unsigned char* ws = args.ws;
    gu32* ctl = (gu32*)(ws + WS_CTL);
    for (int u = tid; u < (LDS_BYTES - LDSCTL_OFF) / 4; u += NWAVES * 64) ((LAS unsigned*)(ldsb + LDSCTL_OFF))[u] = 0u;
    __syncthreads();
    if (!MK_PER_PHASE) (void)xcd_barrier_post((unsigned*)(ctl + CW_BAR), MISC + 8);
#define GRID_BAR() do { if (!MK_PER_PHASE) { XcdBarrier b_; b_.bar = (unsigned*)(SCLP(0) + WS_CTL + (size_t)CW_BAR * 4); b_.x = xb_xcc_id(); b_.st = MISC + 8; xcd_barrier(b_, wave == 0 && lane_id_asm() == 0); } } while (0)
    if (tid == 0) { LAS unsigned* sw = (LAS unsigned*)(ldsb + SCL_OFF); const unsigned long long pw = (unsigned long long)args.ws, po = (unsigned long long)args.out;
        sw[0] = (unsigned)pw; sw[1] = (unsigned)(pw >> 32); sw[2] = (unsigned)po; sw[3] = (unsigned)(po >> 32); sw[4] = (unsigned)G; sw[5] = (unsigned)bx; sw[6] = (unsigned)vcu; sw[7] = (unsigned)args.ph_lo; sw[8] = (unsigned)args.ph_hi; }
#define SCL(i) ((int)__builtin_amdgcn_readfirstlane(((const LAS unsigned*)(ldsb + SCL_OFF))[i]))
#define SCLP(i) ((unsigned char*)(GAS unsigned char*)(((unsigned long long)(unsigned)SCL((i) + 1) << 32) | (unsigned)SCL(i)))
#ifndef PH_EN
#define PH_EN 0x1ff
#endif
#define PHT(k) ((k) == 0 ? 0 : (((k) - 1) & 7) + 1)
#define IN(k) (((PH_EN >> PHT(k)) & 1) && SCL(7) <= (k) && (k) < SCL(8))
#define BOTH(k) (IN(k) && IN((k) + 1))
#ifndef DBG_REP
#define DBG_REP 0
#endif
#define NREP(t) (((DBG_REP >> (t)) & 1) ? 2 : 1)

    if (tid < 18) { const unsigned long long p = (unsigned long long)args.in[tid]; ((LAS unsigned*)(ldsb + epi::PTR_OFF))[2 * tid] = (unsigned)p; ((LAS unsigned*)(ldsb + epi::PTR_OFF))[2 * tid + 1] = (unsigned)(p >> 32); }
    __syncthreads();
#define INP(i) epi::lds_inptr(ldsb, (i))
#define WSL() unsigned char* wsl = SCLP(0); float* const outp = (float*)SCLP(2); const int Gp = SCL(4), bxp = SCL(5), vcup = SCL(6); const int wavep = wave; (void)outp; (void)Gp; (void)bxp; (void)vcup

    if (IN(0)) { for (int rep_ = 0; rep_ < NREP(0); ++rep_) { int l_ = lane_id_asm(); p0_prologue(SCLP(0), ldsb, SCL(6), SCL(4), wave, l_); } if (BOTH(0)) GRID_BAR(); }

#pragma unroll
    for (int l = 0; l < NLAYER; ++l) {
        const int pb = 1 + 8 * l;
        if (IN(pb + 0)) {
for (int rep_ = 0; rep_ < NREP(1); ++rep_) {
            WSL();
            pg8::Gemm g{(const bf16*)(wsl + WS_XB), (const bf16*)(wsl + WS_W + (size_t)l * W_LAYER + OFF_IN), M, NIN, DMODEL}; pg8::StaticOrder S; S.init(M, NIN, Gp, bxp);
            epi::rstd_prepass(ldsb, S, (const float*)(wsl + WS_SS), wavep * 64 + lane_id_asm());
            epi::EpiIn E{wsl, ldsb, l};
            pg8::gemm_phase<epi::EpiIn, pg8::StaticOrder, true, true>(ldsb, g, S, E, wavep);
}
            if (BOTH(pb + 0)) GRID_BAR();
        }
        if (IN(pb + 1)) {
{
            WSL();
            const bf16* IQ = (const bf16*)(wsl + WS_IQ); const bf16* IK = (const bf16*)(wsl + WS_IK); const float* IW = (const float*)(wsl + WS_IW); unsigned* MASK = (unsigned*)(wsl + WS_MASK + (size_t)l * MASK_LAYER);
            for (int i0 = 0;; ++i0) { const int i = (NREP(2) == 2) ? (i0 >> 1) : i0; const int L = i * Gp + vcup; if (L >= NB * 64) break;
                const int v = L & 255, ii = L >> 8, b = v >> 3, j = v & 7, g = 16 * (ii >> 1) + ((ii & 1) ? 15 - j : j);
                topk::unit(b, g, IQ, IK, IW, MASK, ldsb, wavep); }
}
            if (BOTH(pb + 1)) GRID_BAR();
        }
        if (IN(pb + 2)) {
#if !defined(NO_A)
            { WSL();
              const attn_body::bf16 *AQ = (const attn_body::bf16*)(wsl + WS_AQ), *AK = (const attn_body::bf16*)(wsl + WS_AK), *AV = (const attn_body::bf16*)(wsl + WS_AV); attn_body::bf16* YA = (attn_body::bf16*)(wsl + WS_YA);
              const unsigned* MASK = (const unsigned*)(wsl + WS_MASK + (size_t)l * MASK_LAYER);
              for (int i = 0;; ++i) { const int L = i * Gp + vcup; if (L >= NB * 64) break;
                const int v = L & 255, he = L >> 8, b = v >> 3, qb = ((v & 7) + he) & 7;
#if defined(DBG_PROBEA)
                attn_body::attn_unit<8, true, false>(b, qb, AQ + he * 64, AK + he * 64, AV + he * 64, (attn_body::bf16*)outp + he * 64, MASK, (char*)lds, wavep);
#endif
                attn_body::attn_unit<8, true, false>(b, qb, AQ + he * 64, AK + KNAT(b, he), AV + KNAT(b, he), YA + he * 64, MASK, (char*)lds, wavep); } }
#endif
#if !defined(NO_B)
for (int rep_ = 0; rep_ < NREP(3); ++rep_) {
            { WSL();
              const attn_body::bf16 *BQ = (const attn_body::bf16*)(wsl + WS_BQ), *BK = (const attn_body::bf16*)(wsl + WS_BK), *BV = (const attn_body::bf16*)(wsl + WS_BV); attn_body::bf16* OB = (attn_body::bf16*)outp;
              const float* dl = INP(10) + l * 256; const float lam_init = (l == 0) ? LAM_INIT0 : LAM_INIT1; const int ln_ = lane_id_asm();
              const float lam = expf(wave_sum(dl[ln_] * dl[64 + ln_])) - expf(wave_sum(dl[128 + ln_] * dl[192 + ln_])) + lam_init;
              const float* sub = INP(11) + l * 128; attn_body::bf16* YBp = (attn_body::bf16*)(wsl + WS_YB);
              for (int i = 0;; ++i) { const int L = i * Gp + vcup; if (L >= NB * 64) break;
                const int v = L & 255, e = L >> 8, b = v >> 3, h = e >> 1, c = e & 1, qb = (h & 1) ? 7 - (v & 7) : (v & 7);
                if (c == 0) attn_body::attn_unit<8, false, true>(b, qb, BQ + (2 * h) * 64, BK + KNAT(b, 2 * h), BV + VNATB(b, h), OB + h * 128, nullptr, (char*)lds, wavep);
                else        attn_body::attn_unit<8, false, true>(b, qb, BQ + (2 * h + 1) * 64, BK + KNAT(b, 2 * h + 1), BV + VNATB(b, h), YBp + h * 128, nullptr, (char*)lds, wavep, true, OB + h * 128, sub, lam, 1.0f - lam_init); } }
}
#endif
            if (BOTH(pb + 2)) GRID_BAR();
        }
        if (IN(pb + 4)) {
for (int rep_ = 0; rep_ < NREP(5); ++rep_) {
            { WSL(); pg8::Gemm g{(const bf16*)(wsl + WS_YA), (const bf16*)(wsl + WS_W + (size_t)l * W_LAYER + OFF_UA), M, 2 * DMODEL, 512, (const bf16*)(wsl + WS_YB), 4}; pg8::PairOrder S; S.init(M, DMODEL, Gp, bxp);
              epi::EpiGateFused E{(const unsigned char*)(wsl + WS_G), (bf16*)(wsl + WS_MRG)}; pg8::gemm_phase<epi::EpiGateFused, pg8::PairOrder, true, true>(ldsb, g, S, E, wavep); }
}
            if (BOTH(pb + 4)) GRID_BAR();
        }
        if (IN(pb + 5)) {
            WSL();
            pg8::Gemm g{(const bf16*)(wsl + WS_MRG), (const bf16*)(wsl + WS_W + (size_t)l * W_LAYER + OFF_O), M, DMODEL, DMODEL}; pg8::StaticOrder S; S.init(M, DMODEL, Gp, bxp);
#if defined(DBG_PROBE6)
            { epi::EpiProbe<0> E0{nullptr}; pg8::gemm_phase<epi::EpiProbe<0>, pg8::StaticOrder, true, true>(ldsb, g, S, E0, wavep); }
#endif
#if defined(DBG_PROBE6E)
            { epi::EpiRes E0{(bf16*)(wsl + WS_XB), (float*)(wsl + WS_G + 128 * MiB), nullptr, (bf16*)(wsl + WS_G)}; pg8::gemm_phase<epi::EpiRes, pg8::StaticOrder, true, true>(ldsb, g, S, E0, wavep); }
#endif
            epi::EpiRes E{(bf16*)(wsl + WS_XB), (float*)(wsl + WS_SS + 4 * MiB), nullptr, (bf16*)(wsl + WS_XB)};
            pg8::gemm_phase<epi::EpiRes, pg8::StaticOrder, true, true>(ldsb, g, S, E, wavep);
            if (BOTH(pb + 5)) GRID_BAR();
        }
        if (IN(pb + 6)) {
for (int rep_ = 0; rep_ < NREP(7); ++rep_) {
            WSL();
            pg8::Gemm g{(const bf16*)(wsl + WS_XB), (const bf16*)(wsl + WS_W + (size_t)l * W_LAYER + OFF_F1), M, NF1, DMODEL}; pg8::StaticOrder S; S.init(M, NF1, Gp, bxp);
#if defined(DBG_PROBE7)
            if (rep_ == 0) { epi::EpiProbe<DBG_PROBE7> E0{(bf16*)(wsl + WS_ACT)}; pg8::gemm_phase<epi::EpiProbe<DBG_PROBE7>, pg8::StaticOrder, true, true>(ldsb, g, S, E0, wavep); continue; }
#endif
            epi::rstd_prepass(ldsb, S, (const float*)(wsl + WS_SS + 4 * MiB), wavep * 64 + lane_id_asm());
            epi::EpiSwiglu E{ldsb, (bf16*)(wsl + WS_ACT)};
            pg8::gemm_phase<epi::EpiSwiglu, pg8::StaticOrder, true, true>(ldsb, g, S, E, wavep);
}
            if (BOTH(pb + 6)) GRID_BAR();
        }
        if (IN(pb + 7)) {
            WSL();
            pg8::Gemm g{(const bf16*)(wsl + WS_ACT), (const bf16*)(wsl + WS_W + (size_t)l * W_LAYER + OFF_F2), M, DMODEL, FF}; pg8::StaticOrder S; S.init(M, DMODEL, Gp, bxp);
#if defined(DBG_PROBE8)
            { epi::EpiProbe<0> E0{nullptr}; pg8::gemm_phase<epi::EpiProbe<0>, pg8::StaticOrder, true, true>(ldsb, g, S, E0, wavep); }
#endif
#if defined(DBG_PROBE8E)
            { epi::EpiRes E0{(bf16*)(wsl + WS_XB), (float*)(wsl + WS_G + 128 * MiB), nullptr, (bf16*)(wsl + WS_G)}; pg8::gemm_phase<epi::EpiRes, pg8::StaticOrder, true, true>(ldsb, g, S, E0, wavep); }
#endif
            epi::EpiRes E{(bf16*)(wsl + WS_XB), (float*)(wsl + WS_SS), (l == NLAYER - 1) ? outp : nullptr, (bf16*)(wsl + WS_XB)};
            pg8::gemm_phase<epi::EpiRes, pg8::StaticOrder, true, true>(ldsb, g, S, E, wavep);
            if (BOTH(pb + 7)) GRID_BAR();
        }
    }
#undef INP
#undef WSL
#undef IN
#undef BOTH
#undef GRID_BAR
}


#if defined(DBG_STOP)
struct DumpArgs { const unsigned short* p[16]; unsigned long long n[16]; float* out; int nb; int pad; };
__global__ void dbg_dump(DumpArgs d) {
    const size_t i0 = (size_t)blockIdx.x * blockDim.x + threadIdx.x, stride = (size_t)gridDim.x * blockDim.x;
    for (size_t i = i0; i < (size_t)M * DMODEL; i += stride) { float s = 0.f;
        for (int b = 0; b < d.nb; ++b) { const unsigned short w = d.p[b][i % d.n[b]]; float f = __uint_as_float((unsigned)w << 16); if (!(f == f) || fabsf(f) > 1e30f) f = 12345.f; s += f; }
        d.out[i] = s; }
}
#endif
extern "C" void kernel_launch(void* const* d_in, const int* in_sizes, int n_in, void* d_out, int out_size, void* d_ws, size_t ws_size, hipStream_t stream) {
    static int grid = 0;
    if (grid == 0) {
        if (n_in != 18 || in_sizes[0] != M * DMODEL || out_size != M * DMODEL || ws_size < WS_END) { fprintf(stderr, "kernel_launch: unexpected shapes (n_in %d, in0 %d, out %d, ws %zu)\n", n_in, n_in > 0 ? in_sizes[0] : -1, out_size, ws_size); grid = -1; return; }
        int dev = 0, cus = 0, per_cu = 0;
        if (hipGetDevice(&dev) != hipSuccess || hipDeviceGetAttribute(&cus, hipDeviceAttributeMultiprocessorCount, dev) != hipSuccess) { grid = -1; return; }
        if (hipFuncSetAttribute((const void*)mega_fwd, hipFuncAttributeMaxDynamicSharedMemorySize, LDS_BYTES) != hipSuccess) { fprintf(stderr, "kernel_launch: hipFuncSetAttribute failed\n"); grid = -1; return; }
        if (hipOccupancyMaxActiveBlocksPerMultiprocessor(&per_cu, (const void*)mega_fwd, NWAVES * 64, LDS_BYTES) != hipSuccess || per_cu < 1) fprintf(stderr, "kernel_launch: occupancy query reports %d\n", per_cu);
        (void)hipGetLastError();
        grid = cus;
    }
    if (grid < 0) return;
    if (hipMemsetAsync((char*)d_ws + WS_CTL, 0, CTL_ZERO_BYTES, stream) != hipSuccess) return;
    Args a{};
    for (int i = 0; i < 18; ++i) a.in[i] = (const float*)d_in[i];
    a.out = (float*)d_out; a.ws = (unsigned char*)d_ws;
#if defined(DBG_STOP)
    for (int p = 0; p < DBG_STOP; ++p) { a.ph_lo = p; a.ph_hi = p + 1; hipLaunchKernelGGL(mega_fwd, dim3(grid), dim3(NWAVES * 64), LDS_BYTES, stream, a); }
    { DumpArgs d{}; unsigned char* w = (unsigned char*)d_ws; int n = 0;
      const size_t offs[] = {DBG_BUFS}; const size_t lens[] = {DBG_LENS};
      for (size_t q = 0; q < sizeof(offs) / sizeof(offs[0]); ++q) { d.p[n] = (const unsigned short*)(w + offs[q]); d.n[n] = lens[q] / 2; ++n; }
      d.out = (float*)d_out; d.nb = n; hipLaunchKernelGGL(dbg_dump, dim3(2048), dim3(256), 0, stream, d); }
#elif MK_PER_PHASE
    for (int p = 0; p < NPHASE; ++p) { a.ph_lo = p; a.ph_hi = p + 1; hipLaunchKernelGGL(mega_fwd, dim3(grid), dim3(NWAVES * 64), LDS_BYTES, stream, a); }
#else
    a.ph_lo = 0; a.ph_hi = NPHASE;
    hipLaunchKernelGGL(mega_fwd, dim3(grid), dim3(NWAVES * 64), LDS_BYTES, stream, a);
#endif
    const hipError_t le = hipPeekAtLastError();
    if (le != hipSuccess) fprintf(stderr, "kernel_launch: launch failed: %s\n", hipGetErrorName(le));
}
```
